# Optimizing an MI355X kernel written in HIP

```python
import math
import jax, jax.numpy as jnp
from jax import lax
import numpy as np

D_MODEL = 2048
BATCH = 8
SEQ = 2048
DEPTH = 2

HEAD_DIM = 64
BLOCK_Q = 128
EPS = 1e-6
NEG = -1e30
BIG = 1e4
N_BUCKETS = 32
MAX_DISTANCE = 128
A_HEADS = 16
A_KV_HEADS = 2
A_WINDOW = 128
B_HEADS = 16
B_KV_GROUPS = 2
CMP_BLOCK = 32
CMP_STRIDE = 16
CMP_HIDDEN = 256
SLC_BLOCK = 64
SLC_TOPK = 8
B_WINDOW = 512
N_GATES = 3
BIAS_HEADS = A_HEADS + B_HEADS
A_Q = A_HEADS * HEAD_DIM
A_KV = A_KV_HEADS * HEAD_DIM
B_Q = B_HEADS * HEAD_DIM
B_KV = B_KV_GROUPS * HEAD_DIM
EVEN_SPLITS = [A_Q, A_KV, A_KV, B_Q, B_KV, B_KV, B_KV, B_KV, B_KV, B_KV, B_HEADS * N_GATES]
EVEN_IN = sum(EVEN_SPLITS)
EVEN_OUT = A_Q + B_Q
C_HEADS = 16
Q_LORA = 768
KV_LORA = 512
NOPE_DIM = 128
ROPE_DIM = 64
V_DIM = 128
ROPE_THETA = 10000.0
ODD_IN = Q_LORA + KV_LORA + ROPE_DIM
ODD_OUT = C_HEADS * V_DIM
D_FF = 4 * D_MODEL

kernel_name = "hybrid_swa_nsa_mla_block"


def rmsnorm(x, g):
    xf = x.astype(jnp.float32)
    y = xf * lax.rsqrt(jnp.mean(xf * xf, axis=-1, keepdims=True) + EPS)
    return (y * g.astype(jnp.float32)).astype(x.dtype)


def t5_bucket(dist):
    dist = jnp.maximum(dist, 0)
    max_exact = N_BUCKETS // 2
    d = jnp.maximum(dist, 1).astype(jnp.float32)
    large = max_exact + (jnp.log(d / max_exact) / math.log(MAX_DISTANCE / max_exact)
                         * (N_BUCKETS - max_exact)).astype(jnp.int32)
    large = jnp.minimum(large, N_BUCKETS - 1)
    return jnp.where(dist < max_exact, dist, large)


def softmax_f32(logits):
    return jax.nn.softmax(logits.astype(jnp.float32), axis=-1)


def band_keys(k, n_prev):
    b, s, g, d = k.shape
    nb = s // BLOCK_Q
    kb = k.reshape(b, nb, BLOCK_Q, g, d)
    kp = jnp.pad(kb, ((0, 0), (n_prev, 0), (0, 0), (0, 0), (0, 0)))
    return jnp.concatenate([kp[:, j:j + nb] for j in range(n_prev + 1)], axis=2)


def banded_gqa(q, k, v, window, bias_table, sinks=None):
    b, s, h, d = q.shape
    g = k.shape[2]
    hpg = h // g
    nb = s // BLOCK_Q
    n_prev = (window - 1 + BLOCK_Q - 1) // BLOCK_Q
    kl = (n_prev + 1) * BLOCK_Q
    kb = band_keys(k, n_prev)
    vb = band_keys(v, n_prev)
    qb = q.reshape(b, nb, BLOCK_Q, g, hpg, d)
    logits = jnp.einsum('bnqgjd,bnkgd->bngjqk', qb, kb).astype(jnp.float32) * (d ** -0.5)
    qpos = jnp.arange(nb)[:, None] * BLOCK_Q + jnp.arange(BLOCK_Q)[None]
    kpos = (jnp.arange(nb)[:, None] - n_prev) * BLOCK_Q + jnp.arange(kl)[None]
    dist = qpos[:, :, None] - kpos[:, None, :]
    valid = (dist >= 0) & (dist < window) & (kpos[:, None, :] >= 0)
    bias = bias_table[t5_bucket(dist)].astype(jnp.float32)
    bias = bias.reshape(nb, BLOCK_Q, kl, g, hpg).transpose(0, 3, 4, 1, 2)
    logits = jnp.where(valid[:, None, None], logits + bias, NEG)
    if sinks is not None:
        sink = sinks.astype(jnp.float32).reshape(g, hpg)[None, None, :, :, None, None]
        sink = jnp.broadcast_to(sink, logits.shape[:-1] + (1,))
        p = softmax_f32(jnp.concatenate([logits, sink], axis=-1))[..., :-1]
    else:
        p = softmax_f32(logits)
    out = jnp.einsum('bngjqk,bnkgd->bnqgjd', p.astype(v.dtype), vb)
    return out.reshape(b, s, h, d)


def compress_blocks(k, pos_emb, w1, w2):
    b, s, g, d = k.shape
    nc = (s - CMP_BLOCK) // CMP_STRIDE + 1
    idx = jnp.arange(nc)[:, None] * CMP_STRIDE + jnp.arange(CMP_BLOCK)[None]
    blocks = k[:, idx] + pos_emb[:, None, :]
    blocks = blocks.transpose(0, 1, 3, 2, 4).reshape(b, nc, g, CMP_BLOCK * d)
    return jax.nn.gelu(blocks @ w1) @ w2


def nsa_attention(q, kc_raw, vc_raw, ks, vs, kw, vw, gates, bias_table,
                  cmp_pos_k, cmp_pos_v, cmp_k_w1, cmp_k_w2, cmp_v_w1, cmp_v_w2):
    b, s, h, d = q.shape
    g = kc_raw.shape[2]
    hpg = h // g
    scale = d ** -0.5
    tpos = jnp.arange(s)
    kc = compress_blocks(kc_raw, cmp_pos_k, cmp_k_w1, cmp_k_w2)
    vc = compress_blocks(vc_raw, cmp_pos_v, cmp_v_w1, cmp_v_w2)
    nc = kc.shape[1]
    qg = q.reshape(b, s, g, hpg, d)
    logits = jnp.einsum('bsgjd,bcgd->bgjsc', qg, kc).astype(jnp.float32) * scale
    cend = jnp.arange(nc) * CMP_STRIDE + CMP_BLOCK - 1
    cdist = tpos[:, None] - cend[None, :]
    cbias = bias_table[t5_bucket(cdist)].astype(jnp.float32)
    cbias = cbias.reshape(s, nc, g, hpg).transpose(2, 3, 0, 1)
    logits = jnp.where(cdist >= 0, logits + cbias, NEG)
    any_visible = (tpos >= CMP_BLOCK - 1).astype(jnp.float32)[:, None]
    p_cmp = softmax_f32(logits) * any_visible
    o_cmp = jnp.einsum('bgjsc,bcgd->bsgjd', p_cmp.astype(vc.dtype), vc).reshape(b, s, h, d)
    ns = s // SLC_BLOCK
    c_start = np.arange(nc) * CMP_STRIDE
    s_start = np.arange(ns) * SLC_BLOCK
    overlap = ((c_start[:, None] <= s_start[None] + SLC_BLOCK - 1) &
               (c_start[:, None] + CMP_BLOCK - 1 >= s_start[None])).astype(np.float32)
    p_slc = jnp.einsum('bgsc,cn->bgsn', p_cmp.sum(axis=2), jnp.asarray(overlap))
    blk = jnp.arange(ns)[None, :]
    cur = tpos[:, None] // SLC_BLOCK
    forced = (blk == 0) | (blk == cur) | (blk == cur - 1)
    future = blk * SLC_BLOCK > tpos[:, None]
    score = jnp.where(future, NEG, jnp.where(forced, BIG, p_slc))
    k_eff = min(SLC_TOPK, ns)
    _, sel = lax.top_k(score, k_eff)
    kblk = ks.reshape(b, ns, SLC_BLOCK, g, d).transpose(0, 3, 1, 2, 4)
    vblk = vs.reshape(b, ns, SLC_BLOCK, g, d).transpose(0, 3, 1, 2, 4)
    bi = jnp.arange(b)[:, None, None, None]
    gi = jnp.arange(g)[None, :, None, None]
    table_g = bias_table.reshape(N_BUCKETS, g, hpg)
    nb = s // BLOCK_Q

    def slc_chunk(args):
        qc, selc, qpos = args
        kg = kblk[bi, gi, selc]
        vg = vblk[bi, gi, selc]
        lg = jnp.einsum('bqgjd,bgqkld->bgjqkl', qc, kg).astype(jnp.float32) * scale
        kpos = selc[..., None] * SLC_BLOCK + jnp.arange(SLC_BLOCK)
        dist = qpos[None, None, :, None, None] - kpos
        bias = table_g[t5_bucket(dist), gi[..., None]].astype(jnp.float32)
        bias = bias.transpose(0, 1, 5, 2, 3, 4)
        lg = jnp.where((dist >= 0)[:, :, None], lg + bias, NEG)
        shp = lg.shape
        p = softmax_f32(lg.reshape(shp[:4] + (shp[4] * shp[5],))).reshape(shp)
        return jnp.einsum('bgjqkl,bgqkld->bqgjd', p.astype(vg.dtype), vg)

    q_chunks = qg.reshape(b, nb, BLOCK_Q, g, hpg, d).transpose(1, 0, 2, 3, 4, 5)
    sel_chunks = sel.reshape(b, g, nb, BLOCK_Q, k_eff).transpose(2, 0, 1, 3, 4)
    pos_chunks = tpos.reshape(nb, BLOCK_Q)
    o_slc = lax.map(slc_chunk, (q_chunks, sel_chunks, pos_chunks))
    o_slc = o_slc.transpose(1, 0, 2, 3, 4, 5).reshape(b, s, h, d)
    o_win = banded_gqa(q, kw, vw, B_WINDOW, bias_table)
    gt = jax.nn.sigmoid(gates.astype(jnp.float32)).astype(q.dtype)
    return gt[..., 0:1] * o_cmp + gt[..., 1:2] * o_slc + gt[..., 2:3] * o_win


def even_mixer(h, w_in, sinks, rel_bias, cmp_pos_k, cmp_pos_v, cmp_k_w1, cmp_k_w2,
               cmp_v_w1, cmp_v_w2, w_out):
    b, s, _ = h.shape
    proj = h @ w_in
    cuts = [int(c) for c in np.cumsum(EVEN_SPLITS)[:-1]]
    qa, ka, va, qb, kcb, vcb, ksb, vsb, kwb, vwb, gate = jnp.split(proj, cuts, axis=-1)
    heads = lambda t, n: t.reshape(b, s, n, HEAD_DIM)
    o_a = banded_gqa(heads(qa, A_HEADS), heads(ka, A_KV_HEADS), heads(va, A_KV_HEADS),
                     A_WINDOW, rel_bias[:, :A_HEADS], sinks)
    o_b = nsa_attention(heads(qb, B_HEADS), heads(kcb, B_KV_GROUPS), heads(vcb, B_KV_GROUPS),
                        heads(ksb, B_KV_GROUPS), heads(vsb, B_KV_GROUPS),
                        heads(kwb, B_KV_GROUPS), heads(vwb, B_KV_GROUPS),
                        gate.reshape(b, s, B_HEADS, N_GATES), rel_bias[:, A_HEADS:],
                        cmp_pos_k, cmp_pos_v, cmp_k_w1, cmp_k_w2, cmp_v_w1, cmp_v_w2)
    o = jnp.concatenate([o_a.reshape(b, s, A_Q), o_b.reshape(b, s, B_Q)], axis=-1)
    return o @ w_out


def apply_rope(x, cos, sin):
    half = x.shape[-1] // 2
    x1, x2 = x[..., :half], x[..., half:]
    return jnp.concatenate([x1 * cos - x2 * sin, x2 * cos + x1 * sin], axis=-1).astype(x.dtype)


def odd_mixer(h, w_in, q_norm, w_q_up, kv_norm, w_kv_up, w_out):
    b, s, _ = h.shape
    proj = h @ w_in
    cq, ckv, k_rope = jnp.split(proj, [Q_LORA, Q_LORA + KV_LORA], axis=-1)
    q = (rmsnorm(cq, q_norm) @ w_q_up).reshape(b, s, C_HEADS, NOPE_DIM + ROPE_DIM)
    q_nope, q_rope = q[..., :NOPE_DIM], q[..., NOPE_DIM:]
    kv = (rmsnorm(ckv, kv_norm) @ w_kv_up).reshape(b, s, C_HEADS, NOPE_DIM + V_DIM)
    k_nope, v = kv[..., :NOPE_DIM], kv[..., NOPE_DIM:]
    inv = 1.0 / (ROPE_THETA ** (jnp.arange(0, ROPE_DIM, 2, dtype=jnp.float32) / ROPE_DIM))
    ang = jnp.arange(s, dtype=jnp.float32)[:, None] * inv[None]
    cos, sin = jnp.cos(ang), jnp.sin(ang)
    q_rope = apply_rope(q_rope, cos[None, :, None, :], sin[None, :, None, :])
    k_rope = apply_rope(k_rope, cos[None], sin[None])
    scale = (NOPE_DIM + ROPE_DIM) ** -0.5
    kpos = jnp.arange(s)
    nb = s // BLOCK_Q

    def att_chunk(args):
        qn, qr, qpos = args
        lg = (jnp.einsum('bqhd,bkhd->bhqk', qn, k_nope) +
              jnp.einsum('bqhr,bkr->bhqk', qr, k_rope)).astype(jnp.float32) * scale
        lg = jnp.where(kpos[None, :] <= qpos[:, None], lg, NEG)
        p = softmax_f32(lg)
        return jnp.einsum('bhqk,bkhd->bqhd', p.astype(v.dtype), v)

    qn_c = q_nope.reshape(b, nb, BLOCK_Q, C_HEADS, NOPE_DIM).transpose(1, 0, 2, 3, 4)
    qr_c = q_rope.reshape(b, nb, BLOCK_Q, C_HEADS, ROPE_DIM).transpose(1, 0, 2, 3, 4)
    o = lax.map(att_chunk, (qn_c, qr_c, kpos.reshape(nb, BLOCK_Q)))
    o = o.transpose(1, 0, 2, 3, 4).reshape(b, s, ODD_OUT)
    return o @ w_out


def sqrelu_mlp(h, w_up, w_down):
    return jnp.square(jax.nn.relu(h @ w_up)) @ w_down


def setup_inputs(seed: int = 0) -> dict:
    key = jax.random.key(seed)
    ks = iter(jax.random.split(key, 40))
    ne = (DEPTH + 1) // 2
    no = DEPTH // 2
    f32 = jnp.float32

    def nrm(shape, fan_in):
        return jax.random.normal(next(ks), shape, f32) * (fan_in ** -0.5)

    def gain(shape):
        return 1.0 + 0.02 * jax.random.normal(next(ks), shape, f32)

    def small(shape, s):
        return s * jax.random.normal(next(ks), shape, f32)

    return {
        "x": jax.random.normal(next(ks), (BATCH, SEQ, D_MODEL), f32),
        "rel_bias": small((N_BUCKETS, BIAS_HEADS), 0.5),
        "norm_mix_e": gain((ne, D_MODEL)),
        "w_in_e": nrm((ne, D_MODEL, EVEN_IN), D_MODEL),
        "sinks": small((ne, A_HEADS), 0.5),
        "cmp_pos_k": small((ne, CMP_BLOCK, HEAD_DIM), 0.1),
        "cmp_pos_v": small((ne, CMP_BLOCK, HEAD_DIM), 0.1),
        "cmp_k_w1": nrm((ne, CMP_BLOCK * HEAD_DIM, CMP_HIDDEN), CMP_BLOCK * HEAD_DIM),
        "cmp_k_w2": nrm((ne, CMP_HIDDEN, HEAD_DIM), CMP_HIDDEN),
        "cmp_v_w1": nrm((ne, CMP_BLOCK * HEAD_DIM, CMP_HIDDEN), CMP_BLOCK * HEAD_DIM),
        "cmp_v_w2": nrm((ne, CMP_HIDDEN, HEAD_DIM), CMP_HIDDEN),
        "w_out_e": nrm((ne, EVEN_OUT, D_MODEL), EVEN_OUT),
        "norm_mix_o": gain((no, D_MODEL)),
        "w_in_o": nrm((no, D_MODEL, ODD_IN), D_MODEL),
        "q_norm": gain((no, Q_LORA)),
        "w_q_up": nrm((no, Q_LORA, C_HEADS * (NOPE_DIM + ROPE_DIM)), Q_LORA),
        "kv_norm": gain((no, KV_LORA)),
        "w_kv_up": nrm((no, KV_LORA, C_HEADS * (NOPE_DIM + V_DIM)), KV_LORA),
        "w_out_o": nrm((no, ODD_OUT, D_MODEL), ODD_OUT),
        "norm_mlp": gain((DEPTH, D_MODEL)),
        "w_up": nrm((DEPTH, D_MODEL, D_FF), D_MODEL),
        "w_down": nrm((DEPTH, D_FF, D_MODEL), D_FF),
        "norm_final": gain((D_MODEL,)),
    }


def reference(x, rel_bias, norm_mix_e, w_in_e, sinks, cmp_pos_k, cmp_pos_v, cmp_k_w1,
              cmp_k_w2, cmp_v_w1, cmp_v_w2, w_out_e, norm_mix_o, w_in_o, q_norm, w_q_up,
              kv_norm, w_kv_up, w_out_o, norm_mlp, w_up, w_down, norm_final):
    for layer in range(DEPTH):
        i = layer // 2
        if layer % 2 == 0:
            h = rmsnorm(x, norm_mix_e[i])
            x = x + even_mixer(h, w_in_e[i], sinks[i], rel_bias, cmp_pos_k[i], cmp_pos_v[i],
                               cmp_k_w1[i], cmp_k_w2[i], cmp_v_w1[i], cmp_v_w2[i], w_out_e[i])
        else:
            h = rmsnorm(x, norm_mix_o[i])
            x = x + odd_mixer(h, w_in_o[i], q_norm[i], w_q_up[i], kv_norm[i], w_kv_up[i],
                              w_out_o[i])
        x = x + sqrelu_mlp(rmsnorm(x, norm_mlp[layer]), w_up[layer], w_down[layer])
    return rmsnorm(x, norm_final)
```

```cpp
#include <hip/hip_runtime.h>
#include <hip/hip_cooperative_groups.h>
#include <cstdio>
#include <cstdint>
namespace cg = cooperative_groups;

#define DI __device__ __forceinline__
#define LAS __attribute__((address_space(3)))
typedef unsigned short bf16_t;
typedef short bf16x8 __attribute__((ext_vector_type(8)));
typedef short s16x4 __attribute__((ext_vector_type(4)));
typedef float f32x4 __attribute__((ext_vector_type(4)));
typedef float f32x2 __attribute__((ext_vector_type(2)));
typedef float f32x16 __attribute__((ext_vector_type(16)));
typedef unsigned u32x4 __attribute__((ext_vector_type(4)));
typedef unsigned u32x2 __attribute__((ext_vector_type(2)));
typedef __bf16 bf16v2 __attribute__((ext_vector_type(2)));

DI unsigned pk2(float lo, float hi) { bf16v2 v = {(__bf16)lo, (__bf16)hi}; return __builtin_bit_cast(unsigned, v); }
DI int fresh_lane() { int l; asm volatile("v_mbcnt_lo_u32_b32 %0, -1, 0\n\tv_mbcnt_hi_u32_b32 %0, -1, %0" : "=v"(l)); return l; }
DI float shflx(float v, int lane, int k) { return __int_as_float(__builtin_amdgcn_ds_bpermute((lane ^ k) << 2, __float_as_int(v))); }
DI unsigned shflxu(unsigned v, int lane, int k) { return (unsigned)__builtin_amdgcn_ds_bpermute((lane ^ k) << 2, (int)v); }
DI float bflo(unsigned u) { return __uint_as_float(u << 16); }
DI float bfhi(unsigned u) { return __uint_as_float(u & 0xffff0000u); }
DI float bf2f(bf16_t v) { return __uint_as_float(((unsigned)v) << 16); }

constexpr int DM = 2048, SEQ = 2048, NBATCH = 8, MTOK = NBATCH * SEQ, FF = 8192;
constexpr int EIN = 3120, EINP = 3328, OIN = 1344, OINP = 1536, QUP = 3072, KVUP = 4096;
constexpr float EPS = 1e-6f, LOG2E = 1.4426950408889634f, NEGBIG = -1e30f;
constexpr int NTHR = 512;

constexpr size_t al256(size_t x) { return (x + 255) & ~(size_t)255; }
constexpr size_t WS_CTL = 0;
constexpr size_t WS_BAR = 1024;
constexpr size_t WS_PART = 16384;
constexpr size_t WS_PART2 = WS_PART + (size_t)MTOK * 32 * 4;
constexpr size_t WS_BIAS = WS_PART2 + (size_t)MTOK * 32 * 4;
constexpr size_t WS_COS = WS_BIAS + 32 * 128 * 4;
constexpr size_t WS_SIN = WS_COS + 2048 * 32 * 4;
constexpr size_t WS_KC = WS_SIN + 2048 * 32 * 4;
constexpr size_t WS_VC = WS_KC + 8 * 128 * 128 * 2;
constexpr size_t WS_KR = WS_VC + 8 * 128 * 128 * 2;
constexpr size_t WS_WINE = WS_KR + (size_t)MTOK * 64 * 2;
constexpr size_t WS_WOUTE = WS_WINE + (size_t)EINP * DM * 2;
constexpr size_t WS_WINO = WS_WOUTE + (size_t)DM * DM * 2;
constexpr size_t WS_WQUP = WS_WINO + (size_t)OINP * DM * 2;
constexpr size_t WS_WKVUP = WS_WQUP + (size_t)QUP * 768 * 2;
constexpr size_t WS_WOUTO = WS_WKVUP + (size_t)KVUP * 512 * 2;
constexpr size_t WS_WUP = WS_WOUTO + (size_t)DM * DM * 2;
constexpr size_t WS_WDN = WS_WUP + (size_t)FF * DM * 2;
constexpr size_t WS_CW1K = WS_WDN + (size_t)DM * FF * 2;
constexpr size_t WS_CW1V = WS_CW1K + 256 * 2048 * 2;
constexpr size_t WS_CW2K = WS_CW1V + 256 * 2048 * 2;
constexpr size_t WS_CW2V = WS_CW2K + 64 * 256 * 2;
constexpr size_t WS_XB = WS_CW2V + 64 * 256 * 2;
constexpr size_t WS_R = WS_XB + (size_t)MTOK * DM * 2;
constexpr size_t WS_P0 = WS_R, WS_OB0 = WS_R + (size_t)MTOK * EINP * 2;
constexpr size_t WS_P1 = WS_R, WS_OB1 = WS_R, WS_Q1 = WS_R + (size_t)MTOK * DM * 2, WS_KV1 = WS_Q1 + (size_t)MTOK * QUP * 2;
constexpr size_t WS_HB = WS_R;
constexpr size_t WS_END = WS_KV1 + (size_t)MTOK * KVUP * 2;
static_assert(WS_R + (size_t)MTOK * FF * 2 <= WS_END, "HB fits");

namespace pg8 {
#define PG8_LAS __attribute__((address_space(3)))
constexpr int BM = 256, BK = 64, HALF = 128, HTB = HALF * BK * 2  , STAGE_BYTES = 8 * HTB, NXCD = 8, WGM = 8;
__host__ __device__ __forceinline__ int lds_byte(int r, int c) { const int st = (r >> 4) * 2 + (c >> 5), rr = r & 15, cc = c & 31, ob = rr * 64 + cc * 2; return st * 1024 + (ob ^ (((ob >> 9) & 1) << 5)); }
__host__ __device__ __forceinline__ void stage_rc(int b, int& R, int& C) { const int st = b / 1024, sb = b % 1024, swz = sb ^ (((sb >> 9) & 1) << 5); R = (st >> 1) * 16 + swz / 64; C = (st & 1) * 32 + (swz % 64) / 2; }
__host__ __device__ __forceinline__ int perm32(int rho) { const int n = rho >> 4, i = rho & 15; return 8 * (i >> 2) + 4 * n + (i & 3); }
struct Unit { int pm, pn; };
struct Gemm { const bf16_t* A; const bf16_t* Bt; int M, N, K, lda; };
struct StaticOrder {
    int nM, nN, nwg, G, c;
    __host__ __device__ void init(int M, int N, int G_, int c_) { nM = M / BM; nN = N / BM; nwg = nM * nN; G = G_; c = c_; }
    __host__ __device__ bool next(int i, Unit& u) const {
        const long L = (long)i * G + c; if (L >= nwg) return false;
        int wgid = (int)L; { const int q = nwg / NXCD, r = nwg % NXCD, xcd = wgid % NXCD, off = wgid / NXCD; wgid = (xcd < r ? xcd * (q + 1) : r * (q + 1) + (xcd - r) * q) + off; }
        const int nig = WGM * nN, gid = wgid / nig, fm = gid * WGM, gsz = (nM - fm) < WGM ? (nM - fm) : WGM;
        u.pm = fm + ((wgid % nig) % gsz); u.pn = (wgid % nig) / gsz; return true;
    }
    __device__ __forceinline__ void a_ready(const Unit&) const {}
    __device__ __forceinline__ void done(const Unit&) const {}
};
struct TailOrder {
    int c, pn;
    __host__ __device__ bool next(int i, Unit& u) const { if (i > 0 || c >= 64) return false; u.pm = c; u.pn = pn; return true; }
    __device__ __forceinline__ void a_ready(const Unit&) const {}
    __device__ __forceinline__ void done(const Unit&) const {}
};
template <int FIRST4, int CNT4> __device__ __forceinline__ float row_rs(const float* part, int row, int fq, int lane, float inv_dim) {
    const f32x4* p = (const f32x4*)(part + (size_t)row * 32) + FIRST4; float s = 0.f;
#pragma unroll
    for (int i = 0; i < (CNT4 + 3) / 4; ++i) { const int k = fq + 4 * i; if (k < CNT4) { const f32x4 v = p[k]; s += (v[0] + v[1]) + (v[2] + v[3]); } }
    s += shflx(s, lane, 16); s += shflx(s, lane, 32);
    return __builtin_amdgcn_rsqf(s * inv_dim + EPS);
}
template <int MODE> struct EpiScale {
    static constexpr bool PERM = true, AFTER_DRAIN = false;
    bf16_t* O; int ldc; const float* part; float* part_out; bf16_t* kr; const float* cosT; const float* sinT;
    __device__ __forceinline__ void operator()(const f32x4 (&acc)[2][2][4][2], const Unit& u, int wr, int wc, int fr, int fq) const {
        const int row0 = u.pm * BM + wr * 64 + fr; const int col0 = u.pn * BM + wc * 32 + 8 * fq;
#pragma unroll
        for (int ai = 0; ai < 2; ++ai)
#pragma unroll
            for (int m = 0; m < 4; ++m) {
                const int row = row0 + ai * HALF + m * 16;
                float rs;
                if (MODE == 0 || MODE == 1 || MODE == 2) rs = row_rs<0, 8>(part, row, fq, fr + 16 * fq, 1.0f / 2048.0f);
                else if (MODE == 3) rs = row_rs<0, 3>(part, row, fq, fr + 16 * fq, 1.0f / 768.0f);
                else rs = row_rs<3, 2>(part, row, fq, fr + 16 * fq, 1.0f / 512.0f);
                bf16_t* rowp = O + (size_t)row * ldc + col0;
                float ss = 0.f;
#pragma unroll
                for (int bj = 0; bj < 2; ++bj) {
                    f32x4 v0 = acc[ai][bj][m][0] * rs, v1 = acc[ai][bj][m][1] * rs;
                    const int col = col0 + bj * HALF;
                    if (MODE == 1) {
#pragma unroll
                        for (int e = 0; e < 4; ++e) { float a = fmaxf(v0[e], 0.f), b = fmaxf(v1[e], 0.f); v0[e] = a * a; v1[e] = b * b; }
                    }
                    if (MODE == 2) {
#pragma unroll
                        for (int e = 0; e < 4; ++e) ss += v0[e] * v0[e] + v1[e] * v1[e];
                    }
                    bool rope = false; int ri = 0;
                    if (MODE == 2) { rope = (col >= 1280 && col < 1344); ri = (col - 1280) >> 1; }
                    if (MODE == 3) { const int j = col % 192; rope = j >= 128; ri = (j - 128) >> 1; }
                    if ((MODE == 2 || MODE == 3) && rope) {
                        const int s = row & (SEQ - 1);
                        const f32x4 cs = *(const f32x4*)(cosT + s * 32 + ri), sn = *(const f32x4*)(sinT + s * 32 + ri);
                        f32x4 w0, w1;
                        w0[0] = v0[0] * cs[0] - v0[1] * sn[0]; w0[1] = v0[1] * cs[0] + v0[0] * sn[0];
                        w0[2] = v0[2] * cs[1] - v0[3] * sn[1]; w0[3] = v0[3] * cs[1] + v0[2] * sn[1];
                        w1[0] = v1[0] * cs[2] - v1[1] * sn[2]; w1[1] = v1[1] * cs[2] + v1[0] * sn[2];
                        w1[2] = v1[2] * cs[3] - v1[3] * sn[3]; w1[3] = v1[3] * cs[3] + v1[2] * sn[3];
                        v0 = w0; v1 = w1;
                    }
                    u32x4 w; w.x = pk2(v0[0], v0[1]); w.y = pk2(v0[2], v0[3]); w.z = pk2(v1[0], v1[1]); w.w = pk2(v1[2], v1[3]);
                    if (MODE == 2 && rope) *(u32x4*)(kr + (size_t)row * 64 + (col - 1280)) = w;
                    *(u32x4*)(rowp + bj * HALF) = w;
                }
                if (MODE == 2) {
                    ss += shflx(ss, fr + 16 * fq, 16); ss += shflx(ss, fr + 16 * fq, 32);
                    if (fq == 0) part_out[(size_t)row * 32 + u.pn * 4 + wc] = ss;
                }
                asm volatile("" ::: "memory");
            }
    }
};
template <bool LAST> struct EpiResidual {
    static constexpr bool PERM = false, AFTER_DRAIN = false;
    const float* base; float* out; bf16_t* xb; float* part_out;
    __device__ __forceinline__ void operator()(const f32x4 (&acc)[2][2][4][2], const Unit& u, int wr, int wc, int fr, int fq) const {
        const int row0 = u.pm * BM + wr * 64 + fr; const int col0 = u.pn * BM + wc * 32 + 4 * fq;
#pragma unroll
        for (int ai = 0; ai < 2; ++ai)
#pragma unroll
            for (int m = 0; m < 4; ++m) {
                const int row = row0 + ai * HALF + m * 16; const size_t off = (size_t)row * DM + col0; float ss = 0.f;
#pragma unroll
                for (int bj = 0; bj < 2; ++bj)
#pragma unroll
                    for (int n = 0; n < 2; ++n) {
                        const size_t o = off + bj * HALF + n * 16;
                        const f32x4 v = *(const f32x4*)(base + o) + acc[ai][bj][m][n];
                        if (!LAST) *(f32x4*)(out + o) = v;
                        u32x2 w; w.x = pk2(v[0], v[1]); w.y = pk2(v[2], v[3]); *(u32x2*)(xb + o) = w;
                        ss += (v[0] * v[0] + v[1] * v[1]) + (v[2] * v[2] + v[3] * v[3]);
                    }
                ss += shflx(ss, fr + 16 * fq, 16); ss += shflx(ss, fr + 16 * fq, 32);
                if (fq == 0) part_out[(size_t)row * 32 + u.pn * 4 + wc] = ss;
                asm volatile("" ::: "memory");
            }
    }
};
template <class Epi, class Sched, bool ALIGN_EPI = false, bool SP2 = false>
__device__ __forceinline__ void gemm_phase(PG8_LAS unsigned char* lds, const Gemm g, const Sched& S, const Epi& E, const int wid_in) {
    const int lane_ = fresh_lane();
    const int wid = wid_in, lane = lane_, tid = wid * 64 + lane, wr = wid >> 2, wc = wid & 3, fr = lane & 15, fq = lane >> 4;
    const int K = g.K, nt = K / BK;
    unsigned voffA[2], voffB[2];
#pragma unroll
    for (int i = 0; i < 2; ++i) { int R, C; stage_rc(tid * 16 + i * 8192, R, C); const int Rb = Epi::PERM ? ((R & ~31) + perm32(R & 31)) : R;
        voffA[i] = (unsigned)(R * g.lda + C) * 2u; voffB[i] = (unsigned)(Rb * K + C) * 2u; }
    const size_t kstep = (size_t)(BK * 2);
    const size_t hstep = (size_t)HALF * K * 2;
    const size_t tstep = 2 * hstep; const size_t hstepA = (size_t)HALF * g.lda * 2, tstepA = 2 * hstepA;
    const unsigned ldsw = (unsigned)wid * 1024u;
    const int aoff = lds_byte(wr * 64 + fr, fq * 8), boff = lds_byte(wc * 32 + fr, fq * 8);
#define PG8_SA(b, h) (((b) * 2 + (h)) * HTB)
#define PG8_SB(b, h) ((4 + (b) * 2 + (h)) * HTB)
#define PG8_STAGE(bufoff, gbase, voff) do { _Pragma("unroll") for (int _i = 0; _i < 2; ++_i) \
        __builtin_amdgcn_global_load_lds((const unsigned*)((const char*)(gbase) + (voff)[_i]), (PG8_LAS unsigned*)(lds + (bufoff) + ldsw + _i * 8192), 16, 0, 0); } while (0)
#define PG8_LDA(dst, b, h) do { _Pragma("unroll") for (int m = 0; m < 4; ++m) _Pragma("unroll") for (int k = 0; k < 2; ++k) dst[m][k] = *(const PG8_LAS bf16x8*)(lds + PG8_SA(b, h) + aoff + m * 2048 + k * 1024); } while (0)
#define PG8_LDB(dst, b, h) do { _Pragma("unroll") for (int n = 0; n < 2; ++n) _Pragma("unroll") for (int k = 0; k < 2; ++k) dst[n][k] = *(const PG8_LAS bf16x8*)(lds + PG8_SB(b, h) + boff + n * 2048 + k * 1024); } while (0)
#define PG8_MMA(ai, bj, At, Bt) do { __builtin_amdgcn_s_setprio(1); _Pragma("unroll") for (int m = 0; m < 4; ++m) _Pragma("unroll") for (int n = 0; n < 2; ++n) _Pragma("unroll") for (int k = 0; k < 2; ++k) \
        acc[ai][bj][m][n] = __builtin_amdgcn_mfma_f32_16x16x32_bf16(Bt[n][k], At[m][k], acc[ai][bj][m][n], 0, 0, 0); __builtin_amdgcn_s_setprio(0); } while (0)
#define PG8_WAIT_V(n) asm volatile("s_waitcnt vmcnt(" #n ")" ::: "memory")
#define PG8_WAIT_L(n) asm volatile("s_waitcnt lgkmcnt(" #n ")" ::: "memory")
#define PG8_BAR __builtin_amdgcn_s_barrier()
#define PG8_SCHED __builtin_amdgcn_sched_barrier(0)
    Unit cur, nxt; int ui = 0;
    if (!S.next(0, cur)) return;
    f32x4 acc[2][2][4][2];
#pragma unroll
    for (int a = 0; a < 2; ++a)
#pragma unroll
        for (int b = 0; b < 2; ++b)
#pragma unroll
            for (int m = 0; m < 4; ++m)
#pragma unroll
                for (int n = 0; n < 2; ++n) acc[a][b][m][n] = (f32x4){0.f, 0.f, 0.f, 0.f};
    bf16x8 At[4][2], B0[2][2], B1[2][2];
    const char* cA = (const char*)g.A + (size_t)cur.pm * tstepA; const char* cB = (const char*)g.Bt + (size_t)cur.pn * tstep;
    S.a_ready(cur);
    if constexpr (SP2) {
        PG8_STAGE(PG8_SB(0, 0), cB, voffB); PG8_STAGE(PG8_SB(0, 1), cB + hstep, voffB); PG8_STAGE(PG8_SA(0, 0), cA, voffA); PG8_STAGE(PG8_SA(0, 1), cA + hstepA, voffA);
        if (wr == 1) PG8_BAR;
        PG8_WAIT_V(2); PG8_BAR;
        PG8_STAGE(PG8_SB(1, 0), cB + kstep, voffB); PG8_STAGE(PG8_SA(1, 0), cA + kstep, voffA); PG8_STAGE(PG8_SB(1, 1), cB + hstep + kstep, voffB);
        PG8_WAIT_V(6); PG8_BAR;
    } else {
        PG8_STAGE(PG8_SB(0, 0), cB, voffB); PG8_STAGE(PG8_SA(0, 0), cA, voffA); PG8_STAGE(PG8_SB(0, 1), cB + hstep, voffB); PG8_STAGE(PG8_SA(0, 1), cA + hstepA, voffA);
        if (wr == 1) PG8_BAR;
        PG8_WAIT_V(4); PG8_BAR;
        PG8_STAGE(PG8_SB(1, 0), cB + kstep, voffB); PG8_STAGE(PG8_SA(1, 0), cA + kstep, voffA); PG8_STAGE(PG8_SB(1, 1), cB + hstep + kstep, voffB);
        PG8_WAIT_V(6); PG8_BAR;
    }
    for (;;) {
        const bool has_next = S.next(ui + 1, nxt);
        const char* nA = has_next ? (const char*)g.A + (size_t)nxt.pm * tstepA : cA; const char* nB = has_next ? (const char*)g.Bt + (size_t)nxt.pn * tstep : cB;
        for (int t = 0; t < nt; t += 2) {
            const bool last = (t == nt - 2);
            const char* a1 = cA + (size_t)(t + 1) * kstep;
            const char* a2 = last ? nA : cA + (size_t)(t + 2) * kstep; const char* b2 = last ? nB : cB + (size_t)(t + 2) * kstep;
            const char* a3 = a2 + kstep; const char* b3 = b2 + kstep;
            if (last && has_next) S.a_ready(nxt);
            if constexpr (SP2) {
            PG8_LDB(B0, 0, 0); PG8_LDB(B1, 0, 1); PG8_SCHED; PG8_LDA(At, 0, 0); PG8_STAGE(PG8_SA(1, 1), a1 + hstepA, voffA);
            PG8_WAIT_V(8); PG8_WAIT_L(0); PG8_BAR; PG8_MMA(0, 0, At, B0); PG8_MMA(0, 1, At, B1); PG8_BAR; PG8_SCHED;
            PG8_LDA(At, 0, 1); PG8_STAGE(PG8_SB(0, 0), b2, voffB); PG8_STAGE(PG8_SB(0, 1), b2 + hstep, voffB); PG8_STAGE(PG8_SA(0, 0), a2, voffA);
            PG8_WAIT_V(8); PG8_WAIT_L(0); PG8_BAR; PG8_MMA(1, 0, At, B0); PG8_MMA(1, 1, At, B1); PG8_BAR; PG8_SCHED;
            PG8_LDB(B0, 1, 0); PG8_LDB(B1, 1, 1); PG8_SCHED; PG8_LDA(At, 1, 0); PG8_STAGE(PG8_SA(0, 1), a2 + hstepA, voffA);
            PG8_WAIT_V(8); PG8_WAIT_L(0); PG8_BAR; PG8_MMA(0, 0, At, B0); PG8_MMA(0, 1, At, B1); PG8_BAR; PG8_SCHED;
            PG8_LDA(At, 1, 1); PG8_STAGE(PG8_SB(1, 0), b3, voffB); PG8_STAGE(PG8_SB(1, 1), b3 + hstep, voffB); PG8_STAGE(PG8_SA(1, 0), a3, voffA);
            PG8_WAIT_V(8); PG8_WAIT_L(0); PG8_BAR; PG8_MMA(1, 0, At, B0); PG8_MMA(1, 1, At, B1); PG8_BAR; PG8_SCHED;
            } else {
            PG8_LDB(B0, 0, 0); PG8_SCHED; PG8_LDA(At, 0, 0); PG8_STAGE(PG8_SA(1, 1), a1 + hstepA, voffA);
            PG8_WAIT_L(8); PG8_BAR; PG8_WAIT_L(0); PG8_MMA(0, 0, At, B0); PG8_BAR; PG8_SCHED;
            PG8_LDB(B1, 0, 1); PG8_STAGE(PG8_SB(0, 0), b2, voffB);
            PG8_BAR; PG8_WAIT_L(0); PG8_MMA(0, 1, At, B1); PG8_BAR;
            PG8_LDA(At, 0, 1); PG8_STAGE(PG8_SA(0, 0), a2, voffA);
            PG8_BAR; PG8_WAIT_L(0); PG8_MMA(1, 0, At, B0); PG8_BAR; PG8_SCHED;
            PG8_STAGE(PG8_SB(0, 1), b2 + hstep, voffB);
            PG8_WAIT_V(6); PG8_BAR; PG8_MMA(1, 1, At, B1); PG8_BAR;
            PG8_LDB(B0, 1, 0); PG8_SCHED; PG8_LDA(At, 1, 0); PG8_STAGE(PG8_SA(0, 1), a2 + hstepA, voffA);
            PG8_WAIT_L(8); PG8_BAR; PG8_WAIT_L(0); PG8_MMA(0, 0, At, B0); PG8_BAR; PG8_SCHED;
            PG8_LDB(B1, 1, 1); PG8_STAGE(PG8_SB(1, 0), b3, voffB);
            PG8_BAR; PG8_WAIT_L(0); PG8_MMA(0, 1, At, B1); PG8_BAR;
            PG8_LDA(At, 1, 1); PG8_STAGE(PG8_SA(1, 0), a3, voffA);
            PG8_BAR; PG8_WAIT_L(0); PG8_MMA(1, 0, At, B0); PG8_BAR; PG8_SCHED;
            PG8_STAGE(PG8_SB(1, 1), b3 + hstep, voffB);
            PG8_WAIT_V(6); PG8_BAR; PG8_MMA(1, 1, At, B1); PG8_BAR;
            }
        }
        if constexpr (ALIGN_EPI) { if (wr == 0) PG8_BAR; }
        if constexpr (!Epi::AFTER_DRAIN) { E(acc, cur, wr, wc, fr, fq); S.done(cur); }
        if (!has_next) break;
#pragma unroll
        for (int a = 0; a < 2; ++a)
#pragma unroll
            for (int b = 0; b < 2; ++b)
#pragma unroll
                for (int m = 0; m < 4; ++m)
#pragma unroll
                    for (int n = 0; n < 2; ++n) acc[a][b][m][n] = (f32x4){0.f, 0.f, 0.f, 0.f};
        cur = nxt; cA = nA; cB = nB; ++ui;
        if constexpr (ALIGN_EPI) { if (wr == 1) PG8_BAR; }
    }
    PG8_WAIT_V(0);
    if constexpr (!ALIGN_EPI) { if (wr == 0) PG8_BAR; }
    PG8_BAR;
    if constexpr (Epi::AFTER_DRAIN) { E.fused(acc, cur, wr, wc, fr, fq, lds, wid, lane); S.done(cur); }
#undef PG8_SA
#undef PG8_SB
#undef PG8_STAGE
#undef PG8_LDA
#undef PG8_LDB
#undef PG8_MMA
#undef PG8_WAIT_V
#undef PG8_WAIT_L
#undef PG8_BAR
#undef PG8_SCHED
}
}

#define MFMA32(a, b, c) __builtin_amdgcn_mfma_f32_32x32x16_bf16((a), (b), (c), 0, 0, 0)
DI int crow(int reg, int h) { return (reg & 3) + 8 * (reg >> 2) + 4 * h; }
DI float fexp2(float x) { return __builtin_amdgcn_exp2f(x); }
DI bf16x8 pack8(const f32x16& x, int s) {
    u32x4 p; p.x = pk2(x[8 * s + 0], x[8 * s + 1]); p.y = pk2(x[8 * s + 2], x[8 * s + 3]); p.z = pk2(x[8 * s + 4], x[8 * s + 5]); p.w = pk2(x[8 * s + 6], x[8 * s + 7]);
    return __builtin_bit_cast(bf16x8, p);
}
DI bf16x8 tr_pair(LAS const unsigned char* p0, LAS const unsigned char* p1) {
    const s16x4 lo = __builtin_amdgcn_ds_read_tr16_b64_v4i16((LAS s16x4*)p0);
    const s16x4 hi = __builtin_amdgcn_ds_read_tr16_b64_v4i16((LAS s16x4*)p1);
    return __builtin_shufflevector(lo, hi, 0, 1, 2, 3, 4, 5, 6, 7);
}
template <int DQK, int KSTR> DI f32x16 st_block(const bf16x8 (&qf)[DQK / 16], LAS const unsigned char* Kt, int kb, int r, int h) {
    f32x16 s;
#pragma unroll
    for (int i = 0; i < 16; ++i) s[i] = 0.f;
    LAS const unsigned char* kp = Kt + (32 * kb + r) * KSTR + 16 * h;
#pragma unroll
    for (int kk = 0; kk < DQK / 16; ++kk) { const bf16x8 kf = *(LAS const bf16x8*)(kp + 32 * kk); s = MFMA32(kf, qf[kk], s); }
    return s;
}
template <int DV, int VSTR> DI void pv_block(f32x16 (&o)[DV / 32], const f32x16& p, LAS const unsigned char* Vt, int kb, int vlane) {
#pragma unroll
    for (int st = 0; st < 2; ++st) {
        const bf16x8 pf = pack8(p, st);
        LAS const unsigned char* vp = Vt + vlane + (32 * kb + 16 * st) * VSTR;
#pragma unroll
        for (int db = 0; db < DV / 32; ++db) { const bf16x8 vf = tr_pair(vp + 64 * db, vp + 8 * VSTR + 64 * db); o[db] = MFMA32(vf, pf, o[db]); }
    }
}
#define SCHED_FENCE() __builtin_amdgcn_sched_barrier(0)
#ifndef TC_CUT
#define TC_CUT 0
#endif
template <int DQK, int DV, int KSTR, int VSTR, int EARLYV>
DI void tile_qk(const bf16x8 (&qf)[DQK / 16], LAS const unsigned char* Kt, LAS const unsigned char* Vt, int r, int h, int vlane, f32x16& s0, f32x16& s1, bf16x8 (&vf0)[DV / 32]) {
    constexpr int NKK = DQK / 16, KC = 2, NCH = NKK / KC, NDB = DV / 32;
    static_assert(NKK % KC == 0, "chunking");
#pragma unroll
    for (int i = 0; i < 16; ++i) { s0[i] = 0.f; s1[i] = 0.f; }
    LAS const unsigned char* kp = Kt + r * KSTR + 16 * h;
    bf16x8 ka[2][KC], kb[2][KC];
#pragma unroll
    for (int kk = 0; kk < KC; ++kk) { ka[0][kk] = *(LAS const bf16x8*)(kp + 32 * kk); kb[0][kk] = *(LAS const bf16x8*)(kp + 32 * KSTR + 32 * kk); }
    LAS const unsigned char* vp = Vt + vlane;
    if (EARLYV >= 2) {
#pragma unroll
        for (int db = 0; db < NDB; ++db) vf0[db] = tr_pair(vp + 64 * db, vp + 8 * VSTR + 64 * db);
    }
#pragma unroll
    for (int c = 0; c < NCH; ++c) {
        if (c + 1 < NCH) {
#pragma unroll
            for (int kk = 0; kk < KC; ++kk) { ka[(c + 1) & 1][kk] = *(LAS const bf16x8*)(kp + 32 * ((c + 1) * KC + kk)); kb[(c + 1) & 1][kk] = *(LAS const bf16x8*)(kp + 32 * KSTR + 32 * ((c + 1) * KC + kk)); }
        }
        SCHED_FENCE();
#pragma unroll
        for (int kk = 0; kk < KC; ++kk) { s0 = MFMA32(ka[c & 1][kk], qf[c * KC + kk], s0); s1 = MFMA32(kb[c & 1][kk], qf[c * KC + kk], s1); }
        SCHED_FENCE();
    }
}
template <int DV, int VSTR, bool PLAINB, int EARLYV, class Fix>
DI void tile_sv(LAS const unsigned char* Vt, f32x16& s0, f32x16& s1, bf16x8 (&vf0)[DV / 32], f32x16 (&o)[DV / 32], float& m, float& l, int r, int h, int vlane, const Fix& fix, const bool plain, const float pb) {
    constexpr int NDB = DV / 32;
    LAS const unsigned char* vp = Vt + vlane;
    bf16x8 vf1[NDB];
    if (EARLYV < 2) {
#pragma unroll
        for (int db = 0; db < NDB; ++db) vf0[db] = tr_pair(vp + 64 * db, vp + 8 * VSTR + 64 * db);
    }
    if (EARLYV >= 1) {
#pragma unroll
        for (int db = 0; db < NDB; ++db) vf1[db] = tr_pair(vp + 16 * VSTR + 64 * db, vp + 24 * VSTR + 64 * db);
    }
    if (plain) {
        if (PLAINB) {
#pragma unroll
            for (int i = 0; i < 16; ++i) { s0[i] += pb; s1[i] += pb; }
        }
    } else {
#pragma unroll
        for (int i = 0; i < 16; ++i) s0[i] = fix(s0[i], crow(i, h));
        SCHED_FENCE();
#pragma unroll
        for (int i = 0; i < 16; ++i) s1[i] = fix(s1[i], 32 + crow(i, h));
        SCHED_FENCE();
    }
    float mx = NEGBIG;
#pragma unroll
    for (int i = 0; i < 16; ++i) mx = fmaxf(mx, fmaxf(s0[i], s1[i]));
    mx = fmaxf(mx, shflx(mx, r + 32 * h, 32));
    const float m_old = m, mn = fmaxf(m, mx), alpha = fexp2(m - mn);
    float rs = 0.f;
#pragma unroll
    for (int i = 0; i < 16; ++i) { s0[i] = fexp2(s0[i] - mn); s1[i] = fexp2(s1[i] - mn); rs += s0[i] + s1[i]; }
    rs += shflx(rs, r + 32 * h, 32);
    l = l * alpha + rs; m = mn;
    if (__any(mx > m_old)) {
#pragma unroll
        for (int db = 0; db < NDB; ++db) o[db] = o[db] * alpha;
    }
    SCHED_FENCE();
    if (EARLYV < 1) {
#pragma unroll
        for (int db = 0; db < NDB; ++db) vf1[db] = tr_pair(vp + 16 * VSTR + 64 * db, vp + 24 * VSTR + 64 * db);
    }
    {   const bf16x8 pf = pack8(s0, 0); SCHED_FENCE();
#pragma unroll
        for (int db = 0; db < NDB; ++db) o[db] = MFMA32(vf0[db], pf, o[db]);
#pragma unroll
        for (int db = 0; db < NDB; ++db) vf0[db] = tr_pair(vp + 32 * VSTR + 64 * db, vp + 40 * VSTR + 64 * db);
        SCHED_FENCE(); }
    {   const bf16x8 pf = pack8(s0, 1); SCHED_FENCE();
#pragma unroll
        for (int db = 0; db < NDB; ++db) o[db] = MFMA32(vf1[db], pf, o[db]);
#pragma unroll
        for (int db = 0; db < NDB; ++db) vf1[db] = tr_pair(vp + 48 * VSTR + 64 * db, vp + 56 * VSTR + 64 * db);
        SCHED_FENCE(); }
    {   const bf16x8 pf = pack8(s1, 0); SCHED_FENCE();
#pragma unroll
        for (int db = 0; db < NDB; ++db) o[db] = MFMA32(vf0[db], pf, o[db]);
        SCHED_FENCE(); }
    {   const bf16x8 pf = pack8(s1, 1); SCHED_FENCE();
#pragma unroll
        for (int db = 0; db < NDB; ++db) o[db] = MFMA32(vf1[db], pf, o[db]);
        SCHED_FENCE(); }
}
template <int DQK, int DV, int KSTR, int VSTR, bool PLAINB, int EARLYV, class Fix>
DI void tile_compute(const bf16x8 (&qf)[DQK / 16], LAS const unsigned char* Kt, LAS const unsigned char* Vt, f32x16 (&o)[DV / 32], float& m, float& l, int r, int h, int vlane, const Fix& fix, const bool plain, const float pb) {
    f32x16 s0, s1; bf16x8 vf0[DV / 32];
    tile_qk<DQK, DV, KSTR, VSTR, EARLYV>(qf, Kt, Vt, r, h, vlane, s0, s1, vf0);
    tile_sv<DV, VSTR, PLAINB, EARLYV>(Vt, s0, s1, vf0, o, m, l, r, h, vlane, fix, plain, pb);
}

constexpr int L0_KSTR = 144, L0_VSTR = 192, L0_KSZ = 64 * L0_KSTR, L0_BUF = L0_KSZ + 64 * L0_VSTR;
constexpr int OFIN_OFF = 2 * L0_BUF, MISC_OFF = 110592, BT_OFF = MISC_OFF, PSUM_OFF = MISC_OFF + 4096, PSLC_OFF = PSUM_OFF + 16384, SEL_OFF = PSLC_OFF + 32 * 33 * 4, SLOT_OFF = SEL_OFF + 128;
constexpr int LDS_BYTES = 139264;
static_assert(OFIN_OFF + 65536 <= MISC_OFF && SLOT_OFF + 4 <= LDS_BYTES - 16 && 8 * 16640 - 768 <= LDS_BYTES - 16, "LDS map");
struct KVSrc { const bf16_t* k; const bf16_t* v; int stride; };

template <int MODE> struct Fix0 {
    int tq, kpos0, W; LAS const float* bt; bool far, selbit; float bfar;
    DI float operator()(float s, int kl) const {
        if (MODE == 2) { const int c = kpos0 + kl, cd = tq - (16 * c + 31); const bool ok = cd >= 0 && c < 127; const int dd = cd < 0 ? 0 : (cd > 127 ? 127 : cd); return ok ? s + bt[dd] : NEGBIG; }
        const int dist = tq - (kpos0 + kl);
        const bool ok = MODE == 0 ? ((unsigned)dist < (unsigned)W) : (selbit && dist >= 0);
        float b = bfar; if (!far) { const int dd = dist < 0 ? 0 : (dist > 127 ? 127 : dist); b = bt[dd]; }
        return ok ? s + b : NEGBIG;
    }
};
struct FixPlain { float b; DI float operator()(float s, int) const { return s + b; } };
struct FixNone { DI float operator()(float s, int) const { return s; } };
DI u32x4 ldg16(const bf16_t* p) { return *(const u32x4*)p; }
template <int MODE, int EARLYV> DI void l0_run(unsigned tiles, const KVSrc src, LAS unsigned char* lds, const bf16x8 (&qf)[4], f32x16 (&o)[2], float& m, float& l,
                                   int tq, int t0, int W, unsigned selmask, LAS const float* bt, int tid, int r, int h, int vlane) {
    if (tiles == 0u) return;
    const int lrow = tid >> 3, lch = tid & 7; const unsigned goff = (unsigned)(lrow * src.stride + lch * 8) * 2u;
#define L0_LD(base, j) (*(const u32x4*)((const char*)((base) + (size_t)(64 * (j)) * src.stride) + goff))
    int jn = __builtin_ctz(tiles); tiles &= tiles - 1;
    {
        const u32x4 kreg = L0_LD(src.k, jn), vreg = L0_LD(src.v, jn);
        *(LAS u32x4*)(lds + lrow * L0_KSTR + lch * 16) = kreg; *(LAS u32x4*)(lds + L0_KSZ + lrow * L0_VSTR + lch * 16) = vreg;
    }
    __syncthreads();
    int buf = 0;
    for (;;) {
        const int j = jn; const bool more = tiles != 0u;
        u32x4 kreg, vreg;
        if (more) { jn = __builtin_ctz(tiles); tiles &= tiles - 1;
            kreg = L0_LD(src.k, jn); vreg = L0_LD(src.v, jn); }
        Fix0<MODE> fx; fx.tq = tq; fx.kpos0 = 64 * j; fx.W = W; fx.bt = bt; fx.bfar = bt[127];
        fx.far = (MODE != 2) && (t0 - (64 * j + 63) >= 113); fx.selbit = (selmask >> j) & 1u;
        LAS unsigned char* B = lds + buf * L0_BUF;
        bool plain = false;
        if (MODE == 0) plain = fx.far && (t0 + 31 - 64 * j < W);
        if (MODE == 1) plain = fx.far && __all(fx.selbit);
        tile_compute<64, 64, L0_KSTR, L0_VSTR, true, EARLYV>(qf, B, B + L0_KSZ, o, m, l, r, h, vlane, fx, plain, fx.bfar);
        if (more) { LAS unsigned char* Bn = lds + (buf ^ 1) * L0_BUF; *(LAS u32x4*)(Bn + lrow * L0_KSTR + lch * 16) = kreg; *(LAS u32x4*)(Bn + L0_KSZ + lrow * L0_VSTR + lch * 16) = vreg; }
        __syncthreads();
        if (!more) break;
        buf ^= 1;
    }
#undef L0_LD
}
DI int next_item(unsigned* ctr, LAS int* slot, int wave) {
    __syncthreads();
    if (wave == 0 && fresh_lane() == 0) *slot = (int)atomicAdd(ctr, 1u);
    __syncthreads();
    return *slot;
}
DI unsigned band_mask(int t0, int W) { const int lo = (t0 - W + 1 < 0 ? 0 : t0 - W + 1) >> 6, hi = (t0 + 31) >> 6; return (hi == 31 ? 0xffffffffu : ((1u << (hi + 1)) - 1u)) & ~((1u << lo) - 1u); }
template <int NDB> DI void store_o(const f32x16 (&o)[NDB], bf16_t* orow, int h) {
#pragma unroll
    for (int db = 0; db < NDB; ++db)
#pragma unroll
        for (int g = 0; g < 4; ++g) { u32x2 w; w.x = pk2(o[db][4 * g], o[db][4 * g + 1]); w.y = pk2(o[db][4 * g + 2], o[db][4 * g + 3]); *(u32x2*)(orow + 32 * db + 8 * g + 4 * h) = w; }
}

struct Ptrs {
    const float* in[23]; float* out; unsigned char* ws;
};
DI float sigmoidf_(float x) { return 1.0f / (1.0f + __expf(-x)); }

DI void mixerA_item(int item, unsigned char* ws, const float* sinks, LAS unsigned char* lds, int tid, int wave, int lane) {
    lane = fresh_lane(); tid = wave * 64 + lane;
    const int tt = item & 63, bg = item >> 6, b = bg >> 1, g = bg & 1, t0 = 32 * tt, hq = g * 8 + wave, r = lane & 31, h = lane >> 5, tq = t0 + r;
    const bf16_t* P0 = (const bf16_t*)(ws + WS_P0); const float* biasT = (const float*)(ws + WS_BIAS);
    LAS float* bt = (LAS float*)(lds + BT_OFF) + wave * 128; bt[lane] = biasT[hq * 128 + lane]; bt[lane + 64] = biasT[hq * 128 + lane + 64];
    const int i16 = lane & 15, vlane = ((i16 >> 2) + 4 * h) * L0_VSTR + 32 * ((lane >> 4) & 1) + 8 * (i16 & 3);
    const size_t rowb = (size_t)(b * SEQ + tq);
    bf16x8 qf[4];
#pragma unroll
    for (int kk = 0; kk < 4; ++kk) qf[kk] = __builtin_bit_cast(bf16x8, ldg16(P0 + rowb * EINP + hq * 64 + 16 * kk + 8 * h));
    f32x16 o[2];
#pragma unroll
    for (int i = 0; i < 16; ++i) { o[0][i] = 0.f; o[1][i] = 0.f; }
    float m = sinks[hq] * LOG2E, l = 1.0f;
    KVSrc src; src.k = P0 + (size_t)b * SEQ * EINP + 1024 + g * 64; src.v = P0 + (size_t)b * SEQ * EINP + 1152 + g * 64; src.stride = EINP;
    l0_run<0, 2>(band_mask(t0, 128), src, lds, qf, o, m, l, tq, t0, 128, 0u, bt, tid, r, h, vlane);
    const float inv = 1.0f / l; o[0] = o[0] * inv; o[1] = o[1] * inv;
    store_o<2>(o, (bf16_t*)(ws + WS_OB0) + rowb * DM + hq * 64, h);
}

DI void mixerB_item(int item, unsigned char* ws, LAS unsigned char* lds, int tid, int wave, int lane) {
    lane = fresh_lane(); tid = wave * 64 + lane;
    const int tt = 63 - (item >> 4), bg = item & 15, b = bg >> 1, g = bg & 1, t0 = 32 * tt, hq = g * 8 + wave, r = lane & 31, h = lane >> 5, tq = t0 + r;
    const bf16_t* P0 = (const bf16_t*)(ws + WS_P0); const float* biasT = (const float*)(ws + WS_BIAS);
    LAS float* bt = (LAS float*)(lds + BT_OFF) + wave * 128; bt[lane] = biasT[(16 + hq) * 128 + lane]; bt[lane + 64] = biasT[(16 + hq) * 128 + lane + 64];
    LAS unsigned* psum = (LAS unsigned*)(lds + PSUM_OFF); LAS unsigned* pslc = (LAS unsigned*)(lds + PSLC_OFF); LAS unsigned* sel = (LAS unsigned*)(lds + SEL_OFF);
    for (int i = tid; i < 4096; i += NTHR) psum[i] = 0u;
    const int i16 = lane & 15, vlane = ((i16 >> 2) + 4 * h) * L0_VSTR + 32 * ((lane >> 4) & 1) + 8 * (i16 & 3);
    const size_t rowb = (size_t)(b * SEQ + tq);
    bf16x8 qf[4];
#pragma unroll
    for (int kk = 0; kk < 4; ++kk) qf[kk] = __builtin_bit_cast(bf16x8, ldg16(P0 + rowb * EINP + 1280 + hq * 64 + 16 * kk + 8 * h));
    const bf16_t* gp = P0 + rowb * EINP + 3072 + hq * 3;
    f32x16 o[2];
    LAS float* OF = (LAS float*)(lds + OFIN_OFF) + tid;
    {
        const bf16_t* KC = (const bf16_t*)(ws + WS_KC); const bf16_t* VC = (const bf16_t*)(ws + WS_VC);
        const int lrow = tid >> 3, lch = tid & 7;
#pragma unroll
        for (int jt = 0; jt < 2; ++jt) {
            const size_t off = ((size_t)(b * 128 + 64 * jt + lrow) * 2 + g) * 64 + lch * 8;
            LAS unsigned char* B = lds + jt * L0_BUF;
            *(LAS u32x4*)(B + lrow * L0_KSTR + lch * 16) = ldg16(KC + off); *(LAS u32x4*)(B + L0_KSZ + lrow * L0_VSTR + lch * 16) = ldg16(VC + off);
        }
        __syncthreads();
#pragma unroll
        for (int i = 0; i < 16; ++i) { o[0][i] = 0.f; o[1][i] = 0.f; }
        float m = NEGBIG, l = 0.f;
        Fix0<2> fx; fx.tq = tq; fx.W = 0; fx.bt = bt; fx.far = false; fx.selbit = false; fx.bfar = 0.f;
        fx.kpos0 = 0;  tile_compute<64, 64, L0_KSTR, L0_VSTR, false, 0>(qf, lds, lds + L0_KSZ, o, m, l, r, h, vlane, fx, false, 0.f);
        fx.kpos0 = 64; tile_compute<64, 64, L0_KSTR, L0_VSTR, false, 0>(qf, lds + L0_BUF, lds + L0_BUF + L0_KSZ, o, m, l, r, h, vlane, fx, false, 0.f);
        const float inv = (tq >= 31 ? 1.0f : 0.0f) / l;
#pragma unroll 1
        for (int q = 0; q < 4; ++q) {
            f32x16 s = st_block<64, L0_KSTR>(qf, lds + (q >> 1) * L0_BUF, q & 1, r, h);
            fx.kpos0 = 64 * (q >> 1);
            LAS unsigned* pr = psum + r * 128 + 32 * q + 4 * h;
#pragma unroll
            for (int i = 0; i < 16; ++i) { const float p = fexp2(fx(s[i], 32 * (q & 1) + crow(i, h)) - m) * inv;
                __hip_atomic_fetch_add(pr + (i & 3) + 8 * (i >> 2), (unsigned)(p * 268435456.0f + 0.5f), __ATOMIC_RELAXED, __HIP_MEMORY_SCOPE_WORKGROUP); }
        }
        o[0] = o[0] * inv; o[1] = o[1] * inv;
        const float g0 = sigmoidf_(bf2f(gp[0]));
#pragma unroll
        for (int i = 0; i < 16; ++i) { OF[i * NTHR] = o[0][i] * g0; OF[(16 + i) * NTHR] = o[1][i] * g0; }
        asm volatile("" ::: "memory");
    }
    __syncthreads();
    {
        const int tok = tid >> 4, nn = tid & 15;
#pragma unroll
        for (int e = 0; e < 2; ++e) { const int n = nn + 16 * e; const int c0 = (4 * n - 1 < 0) ? 0 : 4 * n - 1, c1 = (4 * n + 3 > 126) ? 126 : 4 * n + 3; unsigned v = 0u;
            for (int c = c0; c <= c1; ++c) v += psum[tok * 128 + c];
            pslc[tok * 33 + n] = v; }
        __syncthreads();
        const int t = t0 + tok, cur = t >> 6, quota = 8 - (cur == 0 ? 1 : (cur == 1 ? 2 : 3));
        bool sb[2];
#pragma unroll
        for (int e = 0; e < 2; ++e) { const int n = nn + 16 * e;
            const bool forced = (n == 0) || (n == cur) || (n == cur - 1), cand = (n >= 1) && (n <= cur - 2);
            const unsigned v = pslc[tok * 33 + n]; int rank = 0;
            _Pragma("unroll 1") for (int n2 = 1; n2 <= cur - 2; ++n2) { const unsigned v2 = pslc[tok * 33 + n2]; rank += (v2 > v || (v2 == v && n2 < n)) ? 1 : 0; }
            sb[e] = forced || (cand && rank < quota); }
        const unsigned long long b0 = __ballot(sb[0]), b1 = __ballot(sb[1]);
        const int k = (lane >> 4);
        if (nn == 0) sel[tok] = (unsigned)((b0 >> (16 * k)) & 0xffffull) | ((unsigned)((b1 >> (16 * k)) & 0xffffull) << 16);
        __syncthreads();
    }
    const unsigned selm = sel[r];
    unsigned U = selm;
#pragma unroll
    for (int d = 1; d < 32; d <<= 1) U |= shflxu(U, lane, d);
    U = (unsigned)__builtin_amdgcn_readfirstlane((int)U);
    const size_t bbase = (size_t)b * SEQ * EINP;
    {
#pragma unroll
        for (int i = 0; i < 16; ++i) { o[0][i] = 0.f; o[1][i] = 0.f; }
        float m = NEGBIG, l = 0.f;
        KVSrc src; src.k = P0 + bbase + 2560 + g * 64; src.v = P0 + bbase + 2688 + g * 64; src.stride = EINP;
        l0_run<1, 0>(U, src, lds, qf, o, m, l, tq, t0, 0, selm, bt, tid, r, h, vlane);
        const float sc = sigmoidf_(bf2f(gp[1])) / l;
#pragma unroll
        for (int i = 0; i < 16; ++i) { OF[i * NTHR] += o[0][i] * sc; OF[(16 + i) * NTHR] += o[1][i] * sc; }
        asm volatile("" ::: "memory");
    }
    {
#pragma unroll
        for (int i = 0; i < 16; ++i) { o[0][i] = 0.f; o[1][i] = 0.f; }
        float m = NEGBIG, l = 0.f;
        KVSrc src; src.k = P0 + bbase + 2816 + g * 64; src.v = P0 + bbase + 2944 + g * 64; src.stride = EINP;
        l0_run<0, 0>(band_mask(t0, 512), src, lds, qf, o, m, l, tq, t0, 512, 0u, bt, tid, r, h, vlane);
        const float sc = sigmoidf_(bf2f(gp[2])) / l;
#pragma unroll
        for (int i = 0; i < 16; ++i) { o[0][i] = OF[i * NTHR] + o[0][i] * sc; o[1][i] = OF[(16 + i) * NTHR] + o[1][i] * sc; }
    }
    store_o<2>(o, (bf16_t*)(ws + WS_OB0) + rowb * DM + 1024 + hq * 64, h);
}

DI float gelu_tanh(float x) { const float u = 0.7978845608028654f * (x + 0.044715f * x * x * x); return 0.5f * x * (1.0f + tanhf(u)); }
DI void compress_item(int item, unsigned char* ws, const float* pos_k, const float* pos_v, LAS unsigned char* lds, int tid, int wave, int lane) {
    lane = fresh_lane(); tid = wave * 64 + lane;
    const int kv = item >> 6, rb = item & 63, r = lane & 31, h = lane >> 5;
    const bf16_t* P0 = (const bf16_t*)(ws + WS_P0);
    const float* pos = kv ? pos_v : pos_k;
    const bf16_t* w1t = (const bf16_t*)(ws + (kv ? WS_CW1V : WS_CW1K)); const bf16_t* w2t = (const bf16_t*)(ws + (kv ? WS_CW2V : WS_CW2K));
    bf16_t* dst = (bf16_t*)(ws + (kv ? WS_VC : WS_KC));
    int rho = 32 * rb + r; if (rho > 2031) rho = 2031;
    const int b = rho / 254, rem = rho % 254, c = rem >> 1, g = rem & 1;
    const bf16_t* src = P0 + (size_t)(b * SEQ + 16 * c) * EINP + (kv ? 2432 : 2304) + g * 64 + 8 * h;
    const bf16_t* wrow = w1t + (size_t)(32 * wave + r) * 2048 + 8 * h;
    const float* prow = pos + 8 * h;
    f32x16 acc;
#pragma unroll
    for (int i = 0; i < 16; ++i) acc[i] = 0.f;
#pragma unroll 4
    for (int kk = 0; kk < 128; ++kk) {
        const int l = kk >> 2, d = 16 * (kk & 3);
        const u32x4 a = ldg16(src + (size_t)l * EINP + d); const f32x4 p0 = *(const f32x4*)(prow + l * 64 + d), p1 = *(const f32x4*)(prow + l * 64 + d + 4);
        u32x4 aa; aa.x = pk2(bflo(a.x) + p0[0], bfhi(a.x) + p0[1]); aa.y = pk2(bflo(a.y) + p0[2], bfhi(a.y) + p0[3]);
        aa.z = pk2(bflo(a.z) + p1[0], bfhi(a.z) + p1[1]); aa.w = pk2(bflo(a.w) + p1[2], bfhi(a.w) + p1[3]);
        const bf16x8 bf = __builtin_bit_cast(bf16x8, ldg16(wrow + 16 * kk));
        acc = MFMA32(__builtin_bit_cast(bf16x8, aa), bf, acc);
    }
    LAS bf16_t* Hs = (LAS bf16_t*)lds;
#pragma unroll
    for (int i = 0; i < 16; ++i) { const float v = gelu_tanh(acc[i]); Hs[crow(i, h) * 264 + 32 * wave + r] = (bf16_t)(pk2(v, 0.f) & 0xffffu); }
    __syncthreads();
    if (wave < 2) {
        f32x16 a2;
#pragma unroll
        for (int i = 0; i < 16; ++i) a2[i] = 0.f;
#pragma unroll
        for (int kk = 0; kk < 16; ++kk) {
            const bf16x8 af = *(LAS const bf16x8*)(Hs + r * 264 + 16 * kk + 8 * h);
            const bf16x8 bf = __builtin_bit_cast(bf16x8, ldg16(w2t + (size_t)(32 * wave + r) * 256 + 16 * kk + 8 * h));
            a2 = MFMA32(af, bf, a2);
        }
#pragma unroll
        for (int i = 0; i < 16; ++i) { const int rr = 32 * rb + crow(i, h);
            if (rr < 2032) { const int b2 = rr / 254, rem2 = rr % 254; dst[((size_t)(b2 * 128 + (rem2 >> 1)) * 2 + (rem2 & 1)) * 64 + 32 * wave + r] = (bf16_t)(pk2(a2[i], 0.f) & 0xffffu); } }
    }
    __syncthreads();
}

constexpr int C_KSTR = 400, C_VSTR = 320, C_KSZ = 64 * C_KSTR, C_BUF = C_KSZ + 64 * C_VSTR;
struct FixC { int tq, kpos0; DI float operator()(float s, int kl) const { return (kpos0 + kl) <= tq ? s : NEGBIG; } };
template <int VAR> DI void mla_item(int item, unsigned char* ws, LAS unsigned char* lds, int tid, int wave, int lane) {
    lane = fresh_lane(); tid = wave * 64 + lane;
    const int qb = 7 - (item >> 7), bh = item & 127, b = bh >> 4, hh = bh & 15, r = lane & 31, h = lane >> 5, tq = qb * 256 + 32 * wave + r;
    const bf16_t* Q1 = (const bf16_t*)(ws + WS_Q1); const bf16_t* KV1 = (const bf16_t*)(ws + WS_KV1); const bf16_t* KR = (const bf16_t*)(ws + WS_KR);
    const int i16 = lane & 15, vlane = ((i16 >> 2) + 4 * h) * C_VSTR + 32 * ((lane >> 4) & 1) + 8 * (i16 & 3);
    const size_t rowb = (size_t)(b * SEQ + tq);
    bf16x8 qf[12];
#pragma unroll
    for (int kk = 0; kk < 12; ++kk) qf[kk] = __builtin_bit_cast(bf16x8, ldg16(Q1 + rowb * QUP + hh * 192 + 16 * kk + 8 * h));
    f32x16 o[4];
#pragma unroll
    for (int d = 0; d < 4; ++d)
#pragma unroll
        for (int i = 0; i < 16; ++i) o[d][i] = 0.f;
    float m = NEGBIG, l = 0.f;
    const int ntile = 4 * qb + 4;
    const bf16_t* kvb = KV1 + (size_t)b * SEQ * KVUP + hh * 256; const bf16_t* krb = KR + (size_t)b * SEQ * 64;
    const int vrow0 = tid >> 4, vch = tid & 15, rrow = tid >> 3, rch = tid & 7;
    const unsigned kvoff = (unsigned)(vrow0 * KVUP + vch * 8) * 2u, kroff = (unsigned)(rrow * 64 + rch * 8) * 2u;
    u32x4 kreg[3], vreg[2];
#define MLA_LOAD(j) do { const char* tb_ = (const char*)(kvb + (size_t)(64 * (j)) * KVUP); const char* rb_ = (const char*)(krb + (size_t)(64 * (j)) * 64); \
        kreg[0] = *(const u32x4*)(tb_ + kvoff); kreg[1] = *(const u32x4*)(tb_ + kvoff + 32u * KVUP * 2u); kreg[2] = *(const u32x4*)(rb_ + kroff); \
        vreg[0] = *(const u32x4*)(tb_ + kvoff + 256u); vreg[1] = *(const u32x4*)(tb_ + kvoff + 32u * KVUP * 2u + 256u); } while (0)
#define MLA_STORE(B) do { *(LAS u32x4*)((B) + vrow0 * C_KSTR + vch * 16) = kreg[0]; *(LAS u32x4*)((B) + (vrow0 + 32) * C_KSTR + vch * 16) = kreg[1]; *(LAS u32x4*)((B) + rrow * C_KSTR + 256 + rch * 16) = kreg[2]; \
        *(LAS u32x4*)((B) + C_KSZ + vrow0 * C_VSTR + vch * 16) = vreg[0]; *(LAS u32x4*)((B) + C_KSZ + (vrow0 + 32) * C_VSTR + vch * 16) = vreg[1]; } while (0)
    MLA_LOAD(0); MLA_STORE(lds);
    __syncthreads();
    const int tqmax = qb * 256 + 32 * wave + 31;
    for (int j = 0; j < ntile; ++j) {
        const bool more = (j + 1 < ntile);
        if (more) MLA_LOAD(j + 1);
        LAS unsigned char* B = lds + (j & 1) * C_BUF;
        if (64 * j <= tqmax) {
            FixC fx; fx.tq = tq; fx.kpos0 = 64 * j;
            tile_compute<192, 128, C_KSTR, C_VSTR, false, 1>(qf, B, B + C_KSZ, o, m, l, r, h, vlane, fx, 64 * j + 63 <= tqmax - 31  , 0.f);
        }
        if (more) { LAS unsigned char* Bn = lds + ((j + 1) & 1) * C_BUF; MLA_STORE(Bn); }
        __syncthreads();
    }
#undef MLA_LOAD
#undef MLA_STORE
    const float inv = 1.0f / l;
#pragma unroll
    for (int d = 0; d < 4; ++d) o[d] = o[d] * inv;
    store_o<4>(o, (bf16_t*)(ws + WS_OB1) + rowb * DM + hh * 128, h);
}

DI float wave_sum(float v, int lane) {
#pragma unroll
    for (int o = 1; o < 64; o <<= 1) v += shflx(v, lane, o);
    return v;
}
DI void wt_item(const float* W, int K, int N, int nblk, bf16_t* WT, const float* gk, int mode, LAS float* scr, int item, int lane) {
    const int kb = item / nblk, nb = item % nblk, k0 = 64 * kb, n0 = 64 * nb;
    const int lr = lane >> 4, lc = 4 * (lane & 15);
    const bool cvalid = (n0 + lc) < N;
    const float* wp = W + (size_t)(k0 + lr) * N + n0 + lc;
    f32x4 v[16];
#pragma unroll
    for (int r = 0; r < 16; ++r) v[r] = cvalid ? *(const f32x4*)(wp + (size_t)(4 * r) * N) : (f32x4){0.f, 0.f, 0.f, 0.f};
    if (gk) {
#pragma unroll
        for (int r = 0; r < 16; ++r) v[r] = v[r] * gk[k0 + 4 * r + lr];
    }
#pragma unroll
    for (int r = 0; r < 16; ++r) { LAS float* q = scr + (4 * r + lr) * 65 + lc; q[0] = v[r][0]; q[1] = v[r][1]; q[2] = v[r][2]; q[3] = v[r][3]; }
    const int nl = lane >> 3, c = lane & 7;
#pragma unroll
    for (int i = 0; i < 8; ++i) {
        const int ln = 8 * i + nl, n = n0 + ln; int srcl = ln; float scale = 1.0f;
        if (mode == 1) { if (n < 1024 || (n >= 1280 && n < 2304)) scale = 0.125f * LOG2E; }
        else if (mode == 2) { if (n >= 1280 && n < 1344) srcl = (ln >> 1) + 32 * (ln & 1); }
        else if (mode == 3) { if ((n % 192) >= 128) srcl = (ln >> 1) + 32 * (ln & 1); scale = 0.07216878364870322f * LOG2E; }
        const LAS float* sp = scr + (8 * c) * 65 + srcl;
        u32x4 o; o.x = pk2(sp[0 * 65] * scale, sp[1 * 65] * scale); o.y = pk2(sp[2 * 65] * scale, sp[3 * 65] * scale);
        o.z = pk2(sp[4 * 65] * scale, sp[5 * 65] * scale); o.w = pk2(sp[6 * 65] * scale, sp[7 * 65] * scale);
        *(u32x4*)(WT + (size_t)n * K + k0 + 8 * c) = o;
    }
}
#define WT_JOB(W_, K_, N_, NPAD_, DST_, GK_, MODE_) do { const int nblk_ = (NPAD_) / 64, cnt_ = ((K_) / 64) * nblk_; int first_ = (gw - wt_base) % ngw; if (first_ < 0) first_ += ngw; \
    for (int it_ = first_; it_ < cnt_; it_ += ngw) wt_item((W_), (K_), (N_), nblk_, (bf16_t*)(ws + (DST_)), (GK_), (MODE_), scr, it_, lane); wt_base = (wt_base + cnt_) % ngw; } while (0)
DI int t5_bucket(int d) {
    if (d < 16) return d;
    const int v = 16 + (int)(logf((float)d / 16.0f) / 2.0794415416798357f * 16.0f);
    return v > 31 ? 31 : v;
}

#define CAS __attribute__((address_space(4)))
DI const float* inp(int i) { const CAS char* ka = (const CAS char*)__builtin_amdgcn_kernarg_segment_ptr(); asm volatile("" : "+s"(ka)); return ((const float* const CAS*)ka)[i]; }
DI unsigned xcc_id() { return (unsigned)__builtin_amdgcn_s_getreg((3 << 11) | 20) & 7u; }
#ifndef REP_P0
#define REP_P0 0
#endif
#ifndef REP_A
#define REP_A 0
#endif
#ifndef REP_B
#define REP_B 0
#endif
#ifndef REP_C
#define REP_C 0
#endif
#ifndef REP_UP
#define REP_UP 0
#endif
#ifndef EN_PRO
#define EN_PRO 1
#endif
#ifndef EN_GEMM
#define EN_GEMM 1
#endif
#ifndef EN_A
#define EN_A 1
#endif
#ifndef EN_B
#define EN_B 1
#endif
#ifndef EN_C
#define EN_C 1
#endif
#define XB_TMO      128
#define XB_XCNT(j)  (256  + 64 * (j))
#define XB_XSUB(j)  (1280 + 64 * (j))
#define XB_XGEN(j)  (2304 + 64 * (j))
#define XB_TOP      3328
#define XB_TOPGEN   3392
#define XCD_BAR_WORDS 3456
#define XB_SPIN_CAP (1u << 18)

__device__ __forceinline__ unsigned xb_ld(unsigned* p)              { return __hip_atomic_load(p, __ATOMIC_RELAXED, __HIP_MEMORY_SCOPE_AGENT); }
__device__ __forceinline__ unsigned xb_add(unsigned* p, unsigned v) { return __hip_atomic_fetch_add(p, v, __ATOMIC_RELAXED, __HIP_MEMORY_SCOPE_AGENT); }
__device__ __forceinline__ unsigned xb_xcc_id() { return (unsigned)__builtin_amdgcn_s_getreg((3 << 11) | 20) & 0xFu; }
#define XB_SPIN(cond, bar) do { unsigned _sp = 0; while (cond) { __builtin_amdgcn_s_sleep(1); \
    if ((++_sp & 255u) == 0u) { if (xb_ld(&(bar)[XB_TMO])) break; if (_sp > XB_SPIN_CAP) { atomicAdd(&(bar)[XB_TMO], 1u); break; } } } } while (0)

struct XcdBarrier {
    unsigned* bar; unsigned x;
    volatile LAS unsigned* st;
};

__device__ __forceinline__ XcdBarrier xcd_barrier_post(unsigned* bar, volatile LAS unsigned* st, int wave) {
    XcdBarrier b; b.bar = bar; b.x = xb_xcc_id(); b.st = st;
    if (wave == 0 && fresh_lane() == 0) (void)xb_add(&bar[XB_XCNT(b.x)], 1u);
    return b;
}
__device__ __forceinline__ void xcd_barrier_complete(unsigned* bar, unsigned x, unsigned& nloc, unsigned& nx) {
    const unsigned G = gridDim.x * gridDim.y * gridDim.z;
    unsigned sum, cnt, mine, sp = 0u;
    for (;;) {
        sum = 0u; cnt = 0u; mine = 0u;
#pragma unroll
        for (unsigned j = 0; j < 16; ++j) { const unsigned c = xb_ld(&bar[XB_XCNT(j)]); sum += c; cnt += (c > 0u) ? 1u : 0u; mine = (j == x) ? c : mine; }
        if (sum == G) break;
        __builtin_amdgcn_s_sleep(1);
        if ((++sp & 255u) == 0u) { if (xb_ld(&bar[XB_TMO])) break; if (sp > XB_SPIN_CAP) { atomicAdd(&bar[XB_TMO], 1u); break; } }
    }
    nloc = mine > 0u ? mine : 1u; nx = cnt > 0u ? cnt : 1u;
}

__device__ __forceinline__ void xcd_barrier(const XcdBarrier& b, int wave) {
    asm volatile("s_waitcnt vmcnt(0)" ::: "memory");
    __syncthreads();
    if (wave == 0 && fresh_lane() == 0) {
        unsigned* bar = b.bar;
        __builtin_amdgcn_s_waitcnt(0);
        unsigned nloc = b.st[0], nx = b.st[1];
        if (nloc == 0u) { xcd_barrier_complete(bar, b.x, nloc, nx); b.st[0] = nloc; b.st[1] = nx; }
        const unsigned old = xb_add(&bar[XB_XSUB(b.x)], 1u);
        const unsigned gen = old / nloc;
        if (old + 1u == (gen + 1u) * nloc) {
            __builtin_amdgcn_fence(__ATOMIC_RELEASE, "agent");
            asm volatile("s_waitcnt vmcnt(0)" ::: "memory");
            const unsigned og = xb_add(&bar[XB_TOP], 1u);
            const unsigned tg = og / nx;
            if (og + 1u == (tg + 1u) * nx) xb_add(&bar[XB_TOPGEN], 1u);
            else XB_SPIN(xb_ld(&bar[XB_TOPGEN]) == tg, bar);
            __builtin_amdgcn_fence(__ATOMIC_ACQUIRE, "agent");
            xb_add(&bar[XB_XGEN(b.x)], 1u);
            asm volatile("s_waitcnt vmcnt(0)" ::: "memory");
        } else {
            XB_SPIN(xb_ld(&bar[XB_XGEN(b.x)]) == gen, bar);
            __builtin_amdgcn_fence(__ATOMIC_ACQUIRE, "agent");
            asm volatile("s_waitcnt vmcnt(0)" ::: "memory");
        }
    }
    __syncthreads();
}

__global__ void __launch_bounds__(NTHR, 2) fwd_kernel(Ptrs P) {
    extern __shared__ __attribute__((aligned(16))) unsigned char lds_raw[];
    LAS unsigned char* lds = (LAS unsigned char*)lds_raw;
    const int wave = __builtin_amdgcn_readfirstlane((int)threadIdx.x >> 6);
    int lane, tid;
#define FRESH_TID() do { lane = fresh_lane(); tid = wave * 64 + lane; } while (0)
    FRESH_TID();
    if (tid < 4) ((volatile LAS unsigned*)(lds + LDS_BYTES - 16))[tid] = 0u;
    __syncthreads();
    const int G = gridDim.x, bx = blockIdx.x, gw = bx * 8 + wave, ngw = G * 8;
    unsigned char* ws = (unsigned char*)inp(24);
    unsigned* ctl = (unsigned*)(ws + WS_CTL);
    const XcdBarrier xbar = xcd_barrier_post((unsigned*)(ws + WS_BAR), (volatile LAS unsigned*)(lds + LDS_BYTES - 16), wave);
    float* part = (float*)(ws + WS_PART); float* part2 = (float*)(ws + WS_PART2);
    bf16_t* XB = (bf16_t*)(ws + WS_XB);
    LAS float* scr = (LAS float*)(lds + wave * 17408);
    LAS int* slot = (LAS int*)(lds + SLOT_OFF);

    for (int rep_ = 0; rep_ <= REP_P0; ++rep_) {
    if (rep_) xcd_barrier(xbar, wave);
        if (bx == 0 && tid < 64) ctl[tid] = 0u;
        int wt_base = 0;
        WT_JOB(inp(3), DM, EIN, EINP, WS_WINE, inp(2), 1); WT_JOB(inp(11), DM, DM, DM, WS_WOUTE, (const float*)nullptr, 0); WT_JOB(inp(13), DM, OIN, OINP, WS_WINO, inp(12), 2);
        WT_JOB(inp(15), 768, QUP, QUP, WS_WQUP, inp(14), 3); WT_JOB(inp(17), 512, KVUP, KVUP, WS_WKVUP, inp(16), 0); WT_JOB(inp(18), DM, DM, DM, WS_WOUTO, (const float*)nullptr, 0);
        WT_JOB(inp(20), DM, FF, FF, WS_WUP, inp(19), 0); WT_JOB(inp(21), FF, DM, DM, WS_WDN, (const float*)nullptr, 0);
        WT_JOB(inp(7), 2048, 256, 256, WS_CW1K, (const float*)nullptr, 0); WT_JOB(inp(9), 2048, 256, 256, WS_CW1V, (const float*)nullptr, 0);
        WT_JOB(inp(8), 256, 64, 64, WS_CW2K, (const float*)nullptr, 0); WT_JOB(inp(10), 256, 64, 64, WS_CW2V, (const float*)nullptr, 0);
        const float* x = inp(0);
        for (int row = gw; row < MTOK; row += ngw) {
            const f32x4* xr = (const f32x4*)(x + (size_t)row * DM) + lane; u32x2* xo = (u32x2*)(XB + (size_t)row * DM) + lane; float s = 0.f;
#pragma unroll
            for (int j = 0; j < 8; ++j) { const f32x4 v = xr[64 * j]; s += (v[0] * v[0] + v[1] * v[1]) + (v[2] * v[2] + v[3] * v[3]); u32x2 w; w.x = pk2(v[0], v[1]); w.y = pk2(v[2], v[3]); xo[64 * j] = w; }
            s = wave_sum(s, lane);
            if (lane < 32) part[(size_t)row * 32 + lane] = lane == 0 ? s : 0.f;
        }
        const int gt = bx * NTHR + tid, ngt = G * NTHR;
        float* biasT = (float*)(ws + WS_BIAS); float* cosT = (float*)(ws + WS_COS); float* sinT = (float*)(ws + WS_SIN);
        { const float* rb = inp(1); for (int i = gt; i < 32 * 128; i += ngt) { const int hd = i >> 7, d = i & 127; biasT[i] = rb[t5_bucket(d) * 32 + hd] * LOG2E; } }
        for (int i = gt; i < 2048 * 32; i += ngt) { const int s = i >> 5, ii = i & 31; const float inv = 1.0f / powf(10000.0f, (float)(2 * ii) / 64.0f); const float ang = (float)s * inv; cosT[i] = cosf(ang); sinT[i] = sinf(ang); }
        bf16_t* KC = (bf16_t*)(ws + WS_KC); bf16_t* VC = (bf16_t*)(ws + WS_VC);
        for (int i = gt; i < 8 * 128; i += ngt) { const int b = i >> 7, e = i & 127; KC[(size_t)(b * 128 + 127) * 128 + e] = 0; VC[(size_t)(b * 128 + 127) * 128 + e] = 0; }
    }
    if (gridDim.y == 0x7fffu) cg::this_grid().sync();
    xcd_barrier(xbar, wave);
    {
        pg8::Gemm g{XB, (const bf16_t*)(ws + WS_WINE), MTOK, EINP, DM, DM}; pg8::StaticOrder S; S.init(MTOK, 3072, G, bx);
        pg8::EpiScale<0> E{(bf16_t*)(ws + WS_P0), EINP, part, nullptr, nullptr, nullptr, nullptr};
        if (EN_GEMM) pg8::gemm_phase<pg8::EpiScale<0>, pg8::StaticOrder, true, true>(lds, g, S, E, wave);
    }
    xcd_barrier(xbar, wave);
    FRESH_TID();
    {
        pg8::Gemm g{XB, (const bf16_t*)(ws + WS_WINE), MTOK, EINP, DM, DM}; pg8::TailOrder T{bx, 12};
        pg8::EpiScale<0> E{(bf16_t*)(ws + WS_P0), EINP, part, nullptr, nullptr, nullptr, nullptr};
        pg8::gemm_phase<pg8::EpiScale<0>, pg8::TailOrder, true, true>(lds, g, T, E, wave);
        __syncthreads();
        FRESH_TID();
    }
    {
        const float* pk_ = inp(5); const float* pv_ = inp(6); const float* sk_ = inp(4);
        for (;;) { const int it = next_item(ctl + 0, slot, wave); if (it >= 128) break; compress_item(it, ws, pk_, pv_, lds, tid, wave, lane); }
        const unsigned x0 = xcc_id();
        for (int s = 0; s < 8; ++s) { const int xq = (int)((x0 + s) & 7u);
            for (;;) { const int k = next_item(ctl + 16 + xq, slot, wave); if (k >= 128) break; mixerA_item((xq + 8 * (k & 1)) * 64 + (k >> 1), ws, sk_, lds, tid, wave, lane); } }
    }
    xcd_barrier(xbar, wave);
    FRESH_TID();
    {
        const unsigned x0 = xcc_id();
        for (int s = 0; s < 8; ++s) { const int xq = (int)((x0 + s) & 7u);
            for (;;) { const int k = next_item(ctl + 32 + xq, slot, wave); if (k >= 128) break; mixerB_item(((k >> 1) << 4) | (xq + 8 * (k & 1)), ws, lds, tid, wave, lane); } }
    }
    xcd_barrier(xbar, wave);
    {
        pg8::Gemm g{(const bf16_t*)(ws + WS_OB0), (const bf16_t*)(ws + WS_WOUTE), MTOK, DM, DM, DM}; pg8::StaticOrder S; S.init(MTOK, DM, G, bx);
        pg8::EpiResidual<false> E{inp(0), (float*)inp(23), XB, part};
        if (EN_GEMM) pg8::gemm_phase<pg8::EpiResidual<false>, pg8::StaticOrder, true, true>(lds, g, S, E, wave);
    }
    xcd_barrier(xbar, wave);
    {
        for (int rep_ = 0; rep_ <= REP_UP; ++rep_) {
            if (rep_) xcd_barrier(xbar, wave);
            pg8::Gemm g{XB, (const bf16_t*)(ws + WS_WUP), MTOK, FF, DM, DM}; pg8::StaticOrder S; S.init(MTOK, FF, G, bx);
            pg8::EpiScale<1> E{(bf16_t*)(ws + WS_HB), FF, part, nullptr, nullptr, nullptr, nullptr};
            if (EN_GEMM) pg8::gemm_phase<pg8::EpiScale<1>, pg8::StaticOrder, true, true>(lds, g, S, E, wave);
        }
        xcd_barrier(xbar, wave);
        {
            pg8::Gemm g{(const bf16_t*)(ws + WS_HB), (const bf16_t*)(ws + WS_WDN), MTOK, DM, FF, FF}; pg8::StaticOrder S; S.init(MTOK, DM, G, bx);
            float* outp = (float*)inp(23); pg8::EpiResidual<false> E{outp, outp, XB, part};
            if (EN_GEMM) pg8::gemm_phase<pg8::EpiResidual<false>, pg8::StaticOrder, true, true>(lds, g, S, E, wave);
        }
        xcd_barrier(xbar, wave);
    }
    {
            FRESH_TID();
            int wt_base = 0;
            WT_JOB(inp(20) + (size_t)DM * FF, DM, FF, FF, WS_WUP, inp(19) + DM, 0); WT_JOB(inp(21) + (size_t)FF * DM, FF, DM, DM, WS_WDN, (const float*)nullptr, 0);
            __syncthreads();
            {
                pg8::Gemm g{XB, (const bf16_t*)(ws + WS_WINO), MTOK, OINP, DM, DM}; pg8::StaticOrder S; S.init(MTOK, OINP, G, bx);
                pg8::EpiScale<2> E{(bf16_t*)(ws + WS_P1), OINP, part, part2, (bf16_t*)(ws + WS_KR), (const float*)(ws + WS_COS), (const float*)(ws + WS_SIN)};
                if (EN_GEMM) pg8::gemm_phase<pg8::EpiScale<2>, pg8::StaticOrder, true, true>(lds, g, S, E, wave);
            }
            xcd_barrier(xbar, wave);
            {
                pg8::Gemm g{(const bf16_t*)(ws + WS_P1), (const bf16_t*)(ws + WS_WQUP), MTOK, QUP, 768, OINP}; pg8::StaticOrder S; S.init(MTOK, QUP, G, bx);
                pg8::EpiScale<3> E{(bf16_t*)(ws + WS_Q1), QUP, part2, nullptr, nullptr, (const float*)(ws + WS_COS), (const float*)(ws + WS_SIN)};
                if (EN_GEMM) pg8::gemm_phase<pg8::EpiScale<3>, pg8::StaticOrder, true, true>(lds, g, S, E, wave);
            }
            {
                pg8::Gemm g{(const bf16_t*)(ws + WS_P1) + 768, (const bf16_t*)(ws + WS_WKVUP), MTOK, KVUP, 512, OINP}; pg8::StaticOrder S; S.init(MTOK, KVUP, G, bx);
                pg8::EpiScale<4> E{(bf16_t*)(ws + WS_KV1), KVUP, part2, nullptr, nullptr, nullptr, nullptr};
                if (EN_GEMM) pg8::gemm_phase<pg8::EpiScale<4>, pg8::StaticOrder, true, true>(lds, g, S, E, wave);
            }
            xcd_barrier(xbar, wave);
            FRESH_TID();
#ifndef MLA_PROBE
#define MLA_PROBE 0
#endif
            if (MLA_PROBE) {
                const unsigned x0 = xcc_id();
                for (int s = 0; s < 8; ++s) { const int xq = (int)((x0 + s) & 7u);
                    for (;;) { const int k = next_item(ctl + 56 + xq, slot, wave); if (k >= 128) break;
                        const int bh = ((k >> 5) * 4 + (k & 3)) * 8 + xq, q7 = (k & 31) >> 2;
                        mla_item<MLA_PROBE>((q7 << 7) | bh, ws, lds, tid, wave, lane); } }
                xcd_barrier(xbar, wave);
            }
            {
                const unsigned x0 = xcc_id();
                for (int s = 0; s < 8; ++s) { const int xq = (int)((x0 + s) & 7u);
                    for (;;) { const int k = next_item(ctl + 48 + xq, slot, wave); if (k >= 128) break;
                        const int bh = ((k >> 5) * 4 + (k & 3)) * 8 + xq, q7 = (k & 31) >> 2;
                        mla_item<0>((q7 << 7) | bh, ws, lds, tid, wave, lane); } }
            }
            xcd_barrier(xbar, wave);
            {
                pg8::Gemm g{(const bf16_t*)(ws + WS_OB1), (const bf16_t*)(ws + WS_WOUTO), MTOK, DM, DM, DM}; pg8::StaticOrder S; S.init(MTOK, DM, G, bx);
                float* outp = (float*)inp(23); pg8::EpiResidual<false> E{outp, outp, XB, part};
                if (EN_GEMM) pg8::gemm_phase<pg8::EpiResidual<false>, pg8::StaticOrder, true, true>(lds, g, S, E, wave);
            }
            xcd_barrier(xbar, wave);
    }
    {
        for (int rep_ = 0; rep_ <= REP_UP; ++rep_) {
            if (rep_) xcd_barrier(xbar, wave);
            pg8::Gemm g{XB, (const bf16_t*)(ws + WS_WUP), MTOK, FF, DM, DM}; pg8::StaticOrder S; S.init(MTOK, FF, G, bx);
            pg8::EpiScale<1> E{(bf16_t*)(ws + WS_HB), FF, part, nullptr, nullptr, nullptr, nullptr};
            if (EN_GEMM) pg8::gemm_phase<pg8::EpiScale<1>, pg8::StaticOrder, true, true>(lds, g, S, E, wave);
        }
        xcd_barrier(xbar, wave);
        {
            pg8::Gemm g{(const bf16_t*)(ws + WS_HB), (const bf16_t*)(ws + WS_WDN), MTOK, DM, FF, FF}; pg8::StaticOrder S; S.init(MTOK, DM, G, bx);
            float* outp = (float*)inp(23); pg8::EpiResidual<true> E{outp, outp, XB, part};
            if (EN_GEMM) pg8::gemm_phase<pg8::EpiResidual<true>, pg8::StaticOrder, true, true>(lds, g, S, E, wave);
        }
        xcd_barrier(xbar, wave);
    }
    FRESH_TID();
    {
        const float* gf = inp(22); float* outp = (float*)inp(23);
        for (int row = gw; row < MTOK; row += ngw) {
            const f32x4* pr = (const f32x4*)(part + (size_t)row * 32); float s = 0.f;
#pragma unroll
            for (int i = 0; i < 8; ++i) { const f32x4 v = pr[i]; s += (v[0] + v[1]) + (v[2] + v[3]); }
            const float rs = __builtin_amdgcn_rsqf(s * (1.0f / 2048.0f) + EPS);
            f32x4* xr = (f32x4*)(outp + (size_t)row * DM) + lane; const f32x4* gr = (const f32x4*)gf + lane; const u32x2* xb = (const u32x2*)(XB + (size_t)row * DM) + lane;
#pragma unroll
            for (int j = 0; j < 8; ++j) { const u32x2 w = xb[64 * j]; const f32x4 gg = gr[64 * j]; f32x4 v; v[0] = bflo(w.x); v[1] = bfhi(w.x); v[2] = bflo(w.y); v[3] = bfhi(w.y); xr[64 * j] = v * rs * gg; }
        }
    }
}

extern "C" void kernel_launch(void* const* d_in, const int* in_sizes, int n_in, void* d_out, int out_size, void* d_ws, size_t ws_size, hipStream_t stream) {
    static int grid = 0;
    if (grid == 0) {
        if (n_in != 23 || out_size != MTOK * DM || ws_size < WS_END) { fprintf(stderr, "kernel_launch: unexpected shapes (n_in %d out %d ws %zu need %zu)\n", n_in, out_size, ws_size, (size_t)WS_END); grid = -1; return; }
        int dev = 0, cus = 0, per_cu = 0;
        hipGetDevice(&dev); hipDeviceGetAttribute(&cus, hipDeviceAttributeMultiprocessorCount, dev);
        hipFuncSetAttribute((const void*)fwd_kernel, hipFuncAttributeMaxDynamicSharedMemorySize, LDS_BYTES);
        hipOccupancyMaxActiveBlocksPerMultiprocessor(&per_cu, (const void*)fwd_kernel, NTHR, LDS_BYTES);
        if (per_cu < 1) { fprintf(stderr, "kernel_launch: occupancy query returned %d\n", per_cu); per_cu = 1; }
        grid = cus;
    }
    if (grid < 0) return;
    if (hipMemsetAsync(d_ws, 0, 16384, stream) != hipSuccess) { fprintf(stderr, "kernel_launch: memset of the control words failed\n"); return; }
    Ptrs p{};
    for (int i = 0; i < 23; ++i) p.in[i] = (const float*)d_in[i];
    p.out = (float*)d_out; p.ws = (unsigned char*)d_ws;
    void* args[] = {&p};
    hipError_t e = hipLaunchCooperativeKernel((const void*)fwd_kernel, dim3(grid), dim3(NTHR), args, LDS_BYTES, stream);
    if (e != hipSuccess) fprintf(stderr, "cooperative launch failed: %s (grid %d)\n", hipGetErrorString(e), grid);
}
```

```cpp
#include <hip/hip_runtime.h>
#include <hip/hip_cooperative_groups.h>
#include <cstdio>
#include <cstdint>
namespace cg = cooperative_groups;

#define DI __device__ __forceinline__
#define LAS __attribute__((address_space(3)))
typedef unsigned short bf16_t;
typedef short bf16x8 __attribute__((ext_vector_type(8)));
typedef short s16x4 __attribute__((ext_vector_type(4)));
typedef float f32x4 __attribute__((ext_vector_type(4)));
typedef float f32x2 __attribute__((ext_vector_type(2)));
typedef float f32x16 __attribute__((ext_vector_type(16)));
typedef unsigned u32x4 __attribute__((ext_vector_type(4)));
typedef unsigned u32x2 __attribute__((ext_vector_type(2)));
typedef __bf16 bf16v2 __attribute__((ext_vector_type(2)));

DI unsigned pk2(float lo, float hi) { bf16v2 v = {(__bf16)lo, (__bf16)hi}; return __builtin_bit_cast(unsigned, v); }
DI int fresh_lane() { int l; asm volatile("v_mbcnt_lo_u32_b32 %0, -1, 0\n\tv_mbcnt_hi_u32_b32 %0, -1, %0" : "=v"(l)); return l; }
DI float shflx(float v, int lane, int k) { return __int_as_float(__builtin_amdgcn_ds_bpermute((lane ^ k) << 2, __float_as_int(v))); }
DI unsigned shflxu(unsigned v, int lane, int k) { return (unsigned)__builtin_amdgcn_ds_bpermute((lane ^ k) << 2, (int)v); }
DI float bflo(unsigned u) { return __uint_as_float(u << 16); }
DI float bfhi(unsigned u) { return __uint_as_float(u & 0xffff0000u); }
DI float bf2f(bf16_t v) { return __uint_as_float(((unsigned)v) << 16); }

constexpr int DM = 2048, SEQ = 2048, NBATCH = 8, MTOK = NBATCH * SEQ, FF = 8192;
constexpr int EIN = 3120, EINP = 3328, OIN = 1344, OINP = 1536, QUP = 3072, KVUP = 4096;
constexpr float EPS = 1e-6f, LOG2E = 1.4426950408889634f, NEGBIG = -1e30f;
constexpr int NTHR = 512;

constexpr size_t al256(size_t x) { return (x + 255) & ~(size_t)255; }
constexpr size_t WS_CTL = 0;
constexpr size_t WS_BAR = 1024;
constexpr size_t WS_PART = 16384;
constexpr size_t WS_PART2 = WS_PART + (size_t)MTOK * 32 * 4;
constexpr size_t WS_BIAS = WS_PART2 + (size_t)MTOK * 32 * 4;
constexpr size_t WS_COS = WS_BIAS + 32 * 128 * 4;
constexpr size_t WS_SIN = WS_COS + 2048 * 32 * 4;
constexpr size_t WS_KC = WS_SIN + 2048 * 32 * 4;
constexpr size_t WS_VC = WS_KC + 8 * 128 * 128 * 2;
constexpr size_t WS_KR = WS_VC + 8 * 128 * 128 * 2;
constexpr size_t WS_WINE = WS_KR + (size_t)MTOK * 64 * 2;
constexpr size_t WS_WOUTE = WS_WINE + (size_t)EINP * DM * 2;
constexpr size_t WS_WINO = WS_WOUTE + (size_t)DM * DM * 2;
constexpr size_t WS_WQUP = WS_WINO + (size_t)OINP * DM * 2;
constexpr size_t WS_WKVUP = WS_WQUP + (size_t)QUP * 768 * 2;
constexpr size_t WS_WOUTO = WS_WKVUP + (size_t)KVUP * 512 * 2;
constexpr size_t WS_WUP = WS_WOUTO + (size_t)DM * DM * 2;
constexpr size_t WS_WDN = WS_WUP + (size_t)FF * DM * 2;
constexpr size_t WS_CW1K = WS_WDN + (size_t)DM * FF * 2;
constexpr size_t WS_CW1V = WS_CW1K + 256 * 2048 * 2;
constexpr size_t WS_CW2K = WS_CW1V + 256 * 2048 * 2;
constexpr size_t WS_CW2V = WS_CW2K + 64 * 256 * 2;
constexpr size_t WS_XB = WS_CW2V + 64 * 256 * 2;
constexpr size_t WS_R = WS_XB + (size_t)MTOK * DM * 2;
constexpr size_t WS_P0 = WS_R, WS_OB0 = WS_R + (size_t)MTOK * EINP * 2;
constexpr size_t WS_P1 = WS_R, WS_OB1 = WS_R, WS_Q1 = WS_R + (size_t)MTOK * DM * 2, WS_KV1 = WS_Q1 + (size_t)MTOK * QUP * 2;
constexpr size_t WS_HB = WS_R;
constexpr size_t WS_END = WS_KV1 + (size_t)MTOK * KVUP * 2;
static_assert(WS_R + (size_t)MTOK * FF * 2 <= WS_END, "HB fits");

namespace pg8 {
#define PG8_LAS __attribute__((address_space(3)))
constexpr int BM = 256, BK = 64, HALF = 128, HTB = HALF * BK * 2  , STAGE_BYTES = 8 * HTB, NXCD = 8, WGM = 8;
__host__ __device__ __forceinline__ int lds_byte(int r, int c) { const int st = (r >> 4) * 2 + (c >> 5), rr = r & 15, cc = c & 31, ob = rr * 64 + cc * 2; return st * 1024 + (ob ^ (((ob >> 9) & 1) << 5)); }
__host__ __device__ __forceinline__ void stage_rc(int b, int& R, int& C) { const int st = b / 1024, sb = b % 1024, swz = sb ^ (((sb >> 9) & 1) << 5); R = (st >> 1) * 16 + swz / 64; C = (st & 1) * 32 + (swz % 64) / 2; }
__host__ __device__ __forceinline__ int perm32(int rho) { const int n = rho >> 4, i = rho & 15; return 8 * (i >> 2) + 4 * n + (i & 3); }
struct Unit { int pm, pn; };
struct Gemm { const bf16_t* A; const bf16_t* Bt; int M, N, K, lda; };
struct StaticOrder {
    int nM, nN, nwg, G, c;
    __host__ __device__ void init(int M, int N, int G_, int c_) { nM = M / BM; nN = N / BM; nwg = nM * nN; G = G_; c = c_; }
    __host__ __device__ bool next(int i, Unit& u) const {
        const long L = (long)i * G + c; if (L >= nwg) return false;
        int wgid = (int)L; { const int q = nwg / NXCD, r = nwg % NXCD, xcd = wgid % NXCD, off = wgid / NXCD; wgid = (xcd < r ? xcd * (q + 1) : r * (q + 1) + (xcd - r) * q) + off; }
        const int nig = WGM * nN, gid = wgid / nig, fm = gid * WGM, gsz = (nM - fm) < WGM ? (nM - fm) : WGM;
        u.pm = fm + ((wgid % nig) % gsz); u.pn = (wgid % nig) / gsz; return true;
    }
    __device__ __forceinline__ void a_ready(const Unit&) const {}
    __device__ __forceinline__ void done(const Unit&) const {}
};
struct TailOrder {
    int c, pn;
    __host__ __device__ bool next(int i, Unit& u) const { if (i > 0 || c >= 64) return false; u.pm = c; u.pn = pn; return true; }
    __device__ __forceinline__ void a_ready(const Unit&) const {}
    __device__ __forceinline__ void done(const Unit&) const {}
};
template <int FIRST4, int CNT4> __device__ __forceinline__ float row_rs(const float* part, int row, int fq, int lane, float inv_dim) {
    const f32x4* p = (const f32x4*)(part + (size_t)row * 32) + FIRST4; float s = 0.f;
#pragma unroll
    for (int i = 0; i < (CNT4 + 3) / 4; ++i) { const int k = fq + 4 * i; if (k < CNT4) { const f32x4 v = p[k]; s += (v[0] + v[1]) + (v[2] + v[3]); } }
    s += shflx(s, lane, 16); s += shflx(s, lane, 32);
    return __builtin_amdgcn_rsqf(s * inv_dim + EPS);
}
template <int MODE> struct EpiScale {
    static constexpr bool PERM = true, AFTER_DRAIN = false;
    bf16_t* O; int ldc; const float* part; float* part_out; bf16_t* kr; const float* cosT; const float* sinT;
    __device__ __forceinline__ void operator()(const f32x4 (&acc)[2][2][4][2], const Unit& u, int wr, int wc, int fr, int fq) const {
        const int row0 = u.pm * BM + wr * 64 + fr; const int col0 = u.pn * BM + wc * 32 + 8 * fq;
#pragma unroll
        for (int ai = 0; ai < 2; ++ai)
#pragma unroll
            for (int m = 0; m < 4; ++m) {
                const int row = row0 + ai * HALF + m * 16;
                float rs;
                if (MODE == 0 || MODE == 1 || MODE == 2) rs = row_rs<0, 8>(part, row, fq, fr + 16 * fq, 1.0f / 2048.0f);
                else if (MODE == 3) rs = row_rs<0, 3>(part, row, fq, fr + 16 * fq, 1.0f / 768.0f);
                else rs = row_rs<3, 2>(part, row, fq, fr + 16 * fq, 1.0f / 512.0f);
                bf16_t* rowp = O + (size_t)row * ldc + col0;
                float ss = 0.f;
#pragma unroll
                for (int bj = 0; bj < 2; ++bj) {
                    f32x4 v0 = acc[ai][bj][m][0] * rs, v1 = acc[ai][bj][m][1] * rs;
                    const int col = col0 + bj * HALF;
                    if (MODE == 1) {
#pragma unroll
                        for (int e = 0; e < 4; ++e) { float a = fmaxf(v0[e], 0.f), b = fmaxf(v1[e], 0.f); v0[e] = a * a; v1[e] = b * b; }
                    }
                    if (MODE == 2) {
#pragma unroll
                        for (int e = 0; e < 4; ++e) ss += v0[e] * v0[e] + v1[e] * v1[e];
                    }
                    bool rope = false; int ri = 0;
                    if (MODE == 2) { rope = (col >= 1280 && col < 1344); ri = (col - 1280) >> 1; }
                    if (MODE == 3) { const int j = col % 192; rope = j >= 128; ri = (j - 128) >> 1; }
                    if ((MODE == 2 || MODE == 3) && rope) {
                        const int s = row & (SEQ - 1);
                        const f32x4 cs = *(const f32x4*)(cosT + s * 32 + ri), sn = *(const f32x4*)(sinT + s * 32 + ri);
                        f32x4 w0, w1;
                        w0[0] = v0[0] * cs[0] - v0[1] * sn[0]; w0[1] = v0[1] * cs[0] + v0[0] * sn[0];
                        w0[2] = v0[2] * cs[1] - v0[3] * sn[1]; w0[3] = v0[3] * cs[1] + v0[2] * sn[1];
                        w1[0] = v1[0] * cs[2] - v1[1] * sn[2]; w1[1] = v1[1] * cs[2] + v1[0] * sn[2];
                        w1[2] = v1[2] * cs[3] - v1[3] * sn[3]; w1[3] = v1[3] * cs[3] + v1[2] * sn[3];
                        v0 = w0; v1 = w1;
                    }
                    u32x4 w; w.x = pk2(v0[0], v0[1]); w.y = pk2(v0[2], v0[3]); w.z = pk2(v1[0], v1[1]); w.w = pk2(v1[2], v1[3]);
                    if (MODE == 2 && rope) *(u32x4*)(kr + (size_t)row * 64 + (col - 1280)) = w;
                    *(u32x4*)(rowp + bj * HALF) = w;
                }
                if (MODE == 2) {
                    ss += shflx(ss, fr + 16 * fq, 16); ss += shflx(ss, fr + 16 * fq, 32);
                    if (fq == 0) part_out[(size_t)row * 32 + u.pn * 4 + wc] = ss;
                }
                asm volatile("" ::: "memory");
            }
    }
};
template <bool LAST> struct EpiResidual {
    static constexpr bool PERM = false, AFTER_DRAIN = false;
    const float* base; float* out; bf16_t* xb; float* part_out;
    __device__ __forceinline__ void operator()(const f32x4 (&acc)[2][2][4][2], const Unit& u, int wr, int wc, int fr, int fq) const {
        const int row0 = u.pm * BM + wr * 64 + fr; const int col0 = u.pn * BM + wc * 32 + 4 * fq;
#pragma unroll
        for (int ai = 0; ai < 2; ++ai)
#pragma unroll
            for (int m = 0; m < 4; ++m) {
                const int row = row0 + ai * HALF + m * 16; const size_t off = (size_t)row * DM + col0; float ss = 0.f;
#pragma unroll
                for (int bj = 0; bj < 2; ++bj)
#pragma unroll
                    for (int n = 0; n < 2; ++n) {
                        const size_t o = off + bj * HALF + n * 16;
                        const f32x4 v = *(const f32x4*)(base + o) + acc[ai][bj][m][n];
                        if (!LAST) *(f32x4*)(out + o) = v;
                        u32x2 w; w.x = pk2(v[0], v[1]); w.y = pk2(v[2], v[3]); *(u32x2*)(xb + o) = w;
                        ss += (v[0] * v[0] + v[1] * v[1]) + (v[2] * v[2] + v[3] * v[3]);
                    }
                ss += shflx(ss, fr + 16 * fq, 16); ss += shflx(ss, fr + 16 * fq, 32);
                if (fq == 0) part_out[(size_t)row * 32 + u.pn * 4 + wc] = ss;
                asm volatile("" ::: "memory");
            }
    }
};
template <class Epi, class Sched, bool ALIGN_EPI = false, bool SP2 = false>
__device__ __forceinline__ void gemm_phase(PG8_LAS unsigned char* lds, const Gemm g, const Sched& S, const Epi& E, const int wid_in) {
    const int lane_ = fresh_lane();
    const int wid = wid_in, lane = lane_, tid = wid * 64 + lane, wr = wid >> 2, wc = wid & 3, fr = lane & 15, fq = lane >> 4;
    const int K = g.K, nt = K / BK;
    unsigned voffA[2], voffB[2];
#pragma unroll
    for (int i = 0; i < 2; ++i) { int R, C; stage_rc(tid * 16 + i * 8192, R, C); const int Rb = Epi::PERM ? ((R & ~31) + perm32(R & 31)) : R;
        voffA[i] = (unsigned)(R * g.lda + C) * 2u; voffB[i] = (unsigned)(Rb * K + C) * 2u; }
    const size_t kstep = (size_t)(BK * 2);
    const size_t hstep = (size_t)HALF * K * 2;
    const size_t tstep = 2 * hstep; const size_t hstepA = (size_t)HALF * g.lda * 2, tstepA = 2 * hstepA;
    const unsigned ldsw = (unsigned)wid * 1024u;
    const int aoff = lds_byte(wr * 64 + fr, fq * 8), boff = lds_byte(wc * 32 + fr, fq * 8);
#define PG8_SA(b, h) (((b) * 2 + (h)) * HTB)
#define PG8_SB(b, h) ((4 + (b) * 2 + (h)) * HTB)
#define PG8_STAGE(bufoff, gbase, voff) do { _Pragma("unroll") for (int _i = 0; _i < 2; ++_i) \
        __builtin_amdgcn_global_load_lds((const unsigned*)((const char*)(gbase) + (voff)[_i]), (PG8_LAS unsigned*)(lds + (bufoff) + ldsw + _i * 8192), 16, 0, 0); } while (0)
#define PG8_LDA(dst, b, h) do { _Pragma("unroll") for (int m = 0; m < 4; ++m) _Pragma("unroll") for (int k = 0; k < 2; ++k) dst[m][k] = *(const PG8_LAS bf16x8*)(lds + PG8_SA(b, h) + aoff + m * 2048 + k * 1024); } while (0)
#define PG8_LDB(dst, b, h) do { _Pragma("unroll") for (int n = 0; n < 2; ++n) _Pragma("unroll") for (int k = 0; k < 2; ++k) dst[n][k] = *(const PG8_LAS bf16x8*)(lds + PG8_SB(b, h) + boff + n * 2048 + k * 1024); } while (0)
#define PG8_MMA(ai, bj, At, Bt) do { __builtin_amdgcn_s_setprio(1); _Pragma("unroll") for (int m = 0; m < 4; ++m) _Pragma("unroll") for (int n = 0; n < 2; ++n) _Pragma("unroll") for (int k = 0; k < 2; ++k) \
        acc[ai][bj][m][n] = __builtin_amdgcn_mfma_f32_16x16x32_bf16(Bt[n][k], At[m][k], acc[ai][bj][m][n], 0, 0, 0); __builtin_amdgcn_s_setprio(0); } while (0)
#define PG8_WAIT_V(n) asm volatile("s_waitcnt vmcnt(" #n ")" ::: "memory")
#define PG8_WAIT_L(n) asm volatile("s_waitcnt lgkmcnt(" #n ")" ::: "memory")
#define PG8_BAR __builtin_amdgcn_s_barrier()
#define PG8_SCHED __builtin_amdgcn_sched_barrier(0)
    Unit cur, nxt; int ui = 0;
    if (!S.next(0, cur)) return;
    f32x4 acc[2][2][4][2];
#pragma unroll
    for (int a = 0; a < 2; ++a)
#pragma unroll
        for (int b = 0; b < 2; ++b)
#pragma unroll
            for (int m = 0; m < 4; ++m)
#pragma unroll
                for (int n = 0; n < 2; ++n) acc[a][b][m][n] = (f32x4){0.f, 0.f, 0.f, 0.f};
    bf16x8 At[4][2], B0[2][2], B1[2][2];
    const char* cA = (const char*)g.A + (size_t)cur.pm * tstepA; const char* cB = (const char*)g.Bt + (size_t)cur.pn * tstep;
    S.a_ready(cur);
    if constexpr (SP2) {
        PG8_STAGE(PG8_SB(0, 0), cB, voffB); PG8_STAGE(PG8_SB(0, 1), cB + hstep, voffB); PG8_STAGE(PG8_SA(0, 0), cA, voffA); PG8_STAGE(PG8_SA(0, 1), cA + hstepA, voffA);
        if (wr == 1) PG8_BAR;
        PG8_WAIT_V(2); PG8_BAR;
        PG8_STAGE(PG8_SB(1, 0), cB + kstep, voffB); PG8_STAGE(PG8_SA(1, 0), cA + kstep, voffA); PG8_STAGE(PG8_SB(1, 1), cB + hstep + kstep, voffB);
        PG8_WAIT_V(6); PG8_BAR;
    } else {
        PG8_STAGE(PG8_SB(0, 0), cB, voffB); PG8_STAGE(PG8_SA(0, 0), cA, voffA); PG8_STAGE(PG8_SB(0, 1), cB + hstep, voffB); PG8_STAGE(PG8_SA(0, 1), cA + hstepA, voffA);
        if (wr == 1) PG8_BAR;
        PG8_WAIT_V(4); PG8_BAR;
        PG8_STAGE(PG8_SB(1, 0), cB + kstep, voffB); PG8_STAGE(PG8_SA(1, 0), cA + kstep, voffA); PG8_STAGE(PG8_SB(1, 1), cB + hstep + kstep, voffB);
        PG8_WAIT_V(6); PG8_BAR;
    }
    for (;;) {
        const bool has_next = S.next(ui + 1, nxt);
        const char* nA = has_next ? (const char*)g.A + (size_t)nxt.pm * tstepA : cA; const char* nB = has_next ? (const char*)g.Bt + (size_t)nxt.pn * tstep : cB;
        for (int t = 0; t < nt; t += 2) {
            const bool last = (t == nt - 2);
            const char* a1 = cA + (size_t)(t + 1) * kstep;
            const char* a2 = last ? nA : cA + (size_t)(t + 2) * kstep; const char* b2 = last ? nB : cB + (size_t)(t + 2) * kstep;
            const char* a3 = a2 + kstep; const char* b3 = b2 + kstep;
            if (last && has_next) S.a_ready(nxt);
            if constexpr (SP2) {
            PG8_LDB(B0, 0, 0); PG8_LDB(B1, 0, 1); PG8_SCHED; PG8_LDA(At, 0, 0); PG8_STAGE(PG8_SA(1, 1), a1 + hstepA, voffA);
            PG8_WAIT_V(8); PG8_WAIT_L(0); PG8_BAR; PG8_MMA(0, 0, At, B0); PG8_MMA(0, 1, At, B1); PG8_BAR; PG8_SCHED;
            PG8_LDA(At, 0, 1); PG8_STAGE(PG8_SB(0, 0), b2, voffB); PG8_STAGE(PG8_SB(0, 1), b2 + hstep, voffB); PG8_STAGE(PG8_SA(0, 0), a2, voffA);
            PG8_WAIT_V(8); PG8_WAIT_L(0); PG8_BAR; PG8_MMA(1, 0, At, B0); PG8_MMA(1, 1, At, B1); PG8_BAR; PG8_SCHED;
            PG8_LDB(B0, 1, 0); PG8_LDB(B1, 1, 1); PG8_SCHED; PG8_LDA(At, 1, 0); PG8_STAGE(PG8_SA(0, 1), a2 + hstepA, voffA);
            PG8_WAIT_V(8); PG8_WAIT_L(0); PG8_BAR; PG8_MMA(0, 0, At, B0); PG8_MMA(0, 1, At, B1); PG8_BAR; PG8_SCHED;
            PG8_LDA(At, 1, 1); PG8_STAGE(PG8_SB(1, 0), b3, voffB); PG8_STAGE(PG8_SB(1, 1), b3 + hstep, voffB); PG8_STAGE(PG8_SA(1, 0), a3, voffA);
            PG8_WAIT_V(8); PG8_WAIT_L(0); PG8_BAR; PG8_MMA(1, 0, At, B0); PG8_MMA(1, 1, At, B1); PG8_BAR; PG8_SCHED;
            } else {
            PG8_LDB(B0, 0, 0); PG8_SCHED; PG8_LDA(At, 0, 0); PG8_STAGE(PG8_SA(1, 1), a1 + hstepA, voffA);
            PG8_WAIT_L(8); PG8_BAR; PG8_WAIT_L(0); PG8_MMA(0, 0, At, B0); PG8_BAR; PG8_SCHED;
            PG8_LDB(B1, 0, 1); PG8_STAGE(PG8_SB(0, 0), b2, voffB);
            PG8_BAR; PG8_WAIT_L(0); PG8_MMA(0, 1, At, B1); PG8_BAR;
            PG8_LDA(At, 0, 1); PG8_STAGE(PG8_SA(0, 0), a2, voffA);
            PG8_BAR; PG8_WAIT_L(0); PG8_MMA(1, 0, At, B0); PG8_BAR; PG8_SCHED;
            PG8_STAGE(PG8_SB(0, 1), b2 + hstep, voffB);
            PG8_WAIT_V(6); PG8_BAR; PG8_MMA(1, 1, At, B1); PG8_BAR;
            PG8_LDB(B0, 1, 0); PG8_SCHED; PG8_LDA(At, 1, 0); PG8_STAGE(PG8_SA(0, 1), a2 + hstepA, voffA);
            PG8_WAIT_L(8); PG8_BAR; PG8_WAIT_L(0); PG8_MMA(0, 0, At, B0); PG8_BAR; PG8_SCHED;
            PG8_LDB(B1, 1, 1); PG8_STAGE(PG8_SB(1, 0), b3, voffB);
            PG8_BAR; PG8_WAIT_L(0); PG8_MMA(0, 1, At, B1); PG8_BAR;
            PG8_LDA(At, 1, 1); PG8_STAGE(PG8_SA(1, 0), a3, voffA);
            PG8_BAR; PG8_WAIT_L(0); PG8_MMA(1, 0, At, B0); PG8_BAR; PG8_SCHED;
            PG8_STAGE(PG8_SB(1, 1), b3 + hstep, voffB);
            PG8_WAIT_V(6); PG8_BAR; PG8_MMA(1, 1, At, B1); PG8_BAR;
            }
        }
        if constexpr (ALIGN_EPI) { if (wr == 0) PG8_BAR; }
        if constexpr (!Epi::AFTER_DRAIN) { E(acc, cur, wr, wc, fr, fq); S.done(cur); }
        if (!has_next) break;
#pragma unroll
        for (int a = 0; a < 2; ++a)
#pragma unroll
            for (int b = 0; b < 2; ++b)
#pragma unroll
                for (int m = 0; m < 4; ++m)
#pragma unroll
                    for (int n = 0; n < 2; ++n) acc[a][b][m][n] = (f32x4){0.f, 0.f, 0.f, 0.f};
        cur = nxt; cA = nA; cB = nB; ++ui;
        if constexpr (ALIGN_EPI) { if (wr == 1) PG8_BAR; }
    }
    PG8_WAIT_V(0);
    if constexpr (!ALIGN_EPI) { if (wr == 0) PG8_BAR; }
    PG8_BAR;
    if constexpr (Epi::AFTER_DRAIN) { E.fused(acc, cur, wr, wc, fr, fq, lds, wid, lane); S.done(cur); }
#undef PG8_SA
#undef PG8_SB
#undef PG8_STAGE
#undef PG8_LDA
#undef PG8_LDB
#undef PG8_MMA
#undef PG8_WAIT_V
#undef PG8_WAIT_L
#undef PG8_BAR
#undef PG8_SCHED
}
}

#define MFMA32(a, b, c) __builtin_amdgcn_mfma_f32_32x32x16_bf16((a), (b), (c), 0, 0, 0)
DI int crow(int reg, int h) { return (reg & 3) + 8 * (reg >> 2) + 4 * h; }
DI float fexp2(float x) { return __builtin_amdgcn_exp2f(x); }
DI bf16x8 pack8(const f32x16& x, int s) {
    u32x4 p; p.x = pk2(x[8 * s + 0], x[8 * s + 1]); p.y = pk2(x[8 * s + 2], x[8 * s + 3]); p.z = pk2(x[8 * s + 4], x[8 * s + 5]); p.w = pk2(x[8 * s + 6], x[8 * s + 7]);
    return __builtin_bit_cast(bf16x8, p);
}
DI bf16x8 tr_pair(LAS const unsigned char* p0, LAS const unsigned char* p1) {
    const s16x4 lo = __builtin_amdgcn_ds_read_tr16_b64_v4i16((LAS s16x4*)p0);
    const s16x4 hi = __builtin_amdgcn_ds_read_tr16_b64_v4i16((LAS s16x4*)p1);
    return __builtin_shufflevector(lo, hi, 0, 1, 2, 3, 4, 5, 6, 7);
}
template <int DQK, int KSTR> DI f32x16 st_block(const bf16x8 (&qf)[DQK / 16], LAS const unsigned char* Kt, int kb, int r, int h) {
    f32x16 s;
#pragma unroll
    for (int i = 0; i < 16; ++i) s[i] = 0.f;
    LAS const unsigned char* kp = Kt + (32 * kb + r) * KSTR + 16 * h;
#pragma unroll
    for (int kk = 0; kk < DQK / 16; ++kk) { const bf16x8 kf = *(LAS const bf16x8*)(kp + 32 * kk); s = MFMA32(kf, qf[kk], s); }
    return s;
}
template <int DV, int VSTR> DI void pv_block(f32x16 (&o)[DV / 32], const f32x16& p, LAS const unsigned char* Vt, int kb, int vlane) {
#pragma unroll
    for (int st = 0; st < 2; ++st) {
        const bf16x8 pf = pack8(p, st);
        LAS const unsigned char* vp = Vt + vlane + (32 * kb + 16 * st) * VSTR;
#pragma unroll
        for (int db = 0; db < DV / 32; ++db) { const bf16x8 vf = tr_pair(vp + 64 * db, vp + 8 * VSTR + 64 * db); o[db] = MFMA32(vf, pf, o[db]); }
    }
}
#define SCHED_FENCE() __builtin_amdgcn_sched_barrier(0)
#ifndef TC_CUT
#define TC_CUT 0
#endif
template <int DQK, int DV, int KSTR, int VSTR, int EARLYV, bool DBUF = true>
DI void tile_qk(const bf16x8 (&qf)[DQK / 16], LAS const unsigned char* Kt, LAS const unsigned char* Vt, int r, int h, int vlane, f32x16& s0, f32x16& s1, bf16x8 (&vf0)[DV / 32]) {
    constexpr int NKK = DQK / 16, KC = 2, NCH = NKK / KC, NDB = DV / 32;
    static_assert(NKK % KC == 0, "chunking");
#pragma unroll
    for (int i = 0; i < 16; ++i) { s0[i] = 0.f; s1[i] = 0.f; }
    LAS const unsigned char* kp = Kt + r * KSTR + 16 * h;
    bf16x8 ka[2][KC], kb[2][KC];
    if (DBUF) {
#pragma unroll
        for (int kk = 0; kk < KC; ++kk) { ka[0][kk] = *(LAS const bf16x8*)(kp + 32 * kk); kb[0][kk] = *(LAS const bf16x8*)(kp + 32 * KSTR + 32 * kk); }
    }
    LAS const unsigned char* vp = Vt + vlane;
    if (EARLYV >= 2) {
#pragma unroll
        for (int db = 0; db < NDB; ++db) vf0[db] = tr_pair(vp + 64 * db, vp + 8 * VSTR + 64 * db);
    }
#pragma unroll
    for (int c = 0; c < NCH; ++c) {
        if (DBUF) {
            if (c + 1 < NCH) {
#pragma unroll
                for (int kk = 0; kk < KC; ++kk) { ka[(c + 1) & 1][kk] = *(LAS const bf16x8*)(kp + 32 * ((c + 1) * KC + kk)); kb[(c + 1) & 1][kk] = *(LAS const bf16x8*)(kp + 32 * KSTR + 32 * ((c + 1) * KC + kk)); }
            }
        } else {
#pragma unroll
            for (int kk = 0; kk < KC; ++kk) { ka[0][kk] = *(LAS const bf16x8*)(kp + 32 * (c * KC + kk)); kb[0][kk] = *(LAS const bf16x8*)(kp + 32 * KSTR + 32 * (c * KC + kk)); }
        }
        SCHED_FENCE();
#pragma unroll
        for (int kk = 0; kk < KC; ++kk) { s0 = MFMA32(ka[DBUF ? (c & 1) : 0][kk], qf[c * KC + kk], s0); s1 = MFMA32(kb[DBUF ? (c & 1) : 0][kk], qf[c * KC + kk], s1); }
        SCHED_FENCE();
    }
}
template <int DV, int VSTR, bool PLAINB, int EARLYV, class Fix>
DI void tile_sv(LAS const unsigned char* Vt, f32x16& s0, f32x16& s1, bf16x8 (&vf0)[DV / 32], f32x16 (&o)[DV / 32], float& m, float& l, int r, int h, int vlane, const Fix& fix, const bool plain, const float pb) {
    constexpr int NDB = DV / 32;
    LAS const unsigned char* vp = Vt + vlane;
    bf16x8 vf1[NDB];
    if (EARLYV < 2) {
#pragma unroll
        for (int db = 0; db < NDB; ++db) vf0[db] = tr_pair(vp + 64 * db, vp + 8 * VSTR + 64 * db);
    }
    if (EARLYV >= 1) {
#pragma unroll
        for (int db = 0; db < NDB; ++db) vf1[db] = tr_pair(vp + 16 * VSTR + 64 * db, vp + 24 * VSTR + 64 * db);
    }
    bf16x8 vf2[NDB];
    if (EARLYV >= 3) {
#pragma unroll
        for (int db = 0; db < NDB; ++db) vf2[db] = tr_pair(vp + 32 * VSTR + 64 * db, vp + 40 * VSTR + 64 * db);
    }
    if (plain) {
        if (PLAINB) {
#pragma unroll
            for (int i = 0; i < 16; ++i) { s0[i] += pb; s1[i] += pb; }
        }
    } else {
#pragma unroll
        for (int i = 0; i < 16; ++i) s0[i] = fix(s0[i], crow(i, h));
        SCHED_FENCE();
#pragma unroll
        for (int i = 0; i < 16; ++i) s1[i] = fix(s1[i], 32 + crow(i, h));
        SCHED_FENCE();
    }
    float mx = NEGBIG;
#pragma unroll
    for (int i = 0; i < 16; ++i) mx = fmaxf(mx, fmaxf(s0[i], s1[i]));
    mx = fmaxf(mx, shflx(mx, r + 32 * h, 32));
    const float m_old = m, mn = fmaxf(m, mx), alpha = fexp2(m - mn);
    float rs = 0.f;
#pragma unroll
    for (int i = 0; i < 16; ++i) { s0[i] = fexp2(s0[i] - mn); s1[i] = fexp2(s1[i] - mn); rs += s0[i] + s1[i]; }
    rs += shflx(rs, r + 32 * h, 32);
    l = l * alpha + rs; m = mn;
    if (__any(mx > m_old)) {
#pragma unroll
        for (int db = 0; db < NDB; ++db) o[db] = o[db] * alpha;
    }
    SCHED_FENCE();
    if (EARLYV < 1) {
#pragma unroll
        for (int db = 0; db < NDB; ++db) vf1[db] = tr_pair(vp + 16 * VSTR + 64 * db, vp + 24 * VSTR + 64 * db);
    }
    {   const bf16x8 pf = pack8(s0, 0); SCHED_FENCE();
#pragma unroll
        for (int db = 0; db < NDB; ++db) o[db] = MFMA32(vf0[db], pf, o[db]);
#pragma unroll
        for (int db = 0; db < NDB; ++db) vf0[db] = EARLYV >= 3 ? tr_pair(vp + 48 * VSTR + 64 * db, vp + 56 * VSTR + 64 * db) : tr_pair(vp + 32 * VSTR + 64 * db, vp + 40 * VSTR + 64 * db);
        SCHED_FENCE(); }
    {   const bf16x8 pf = pack8(s0, 1); SCHED_FENCE();
#pragma unroll
        for (int db = 0; db < NDB; ++db) o[db] = MFMA32(vf1[db], pf, o[db]);
        if (EARLYV < 3) {
#pragma unroll
            for (int db = 0; db < NDB; ++db) vf1[db] = tr_pair(vp + 48 * VSTR + 64 * db, vp + 56 * VSTR + 64 * db);
        }
        SCHED_FENCE(); }
    {   const bf16x8 pf = pack8(s1, 0); SCHED_FENCE();
#pragma unroll
        for (int db = 0; db < NDB; ++db) o[db] = MFMA32(EARLYV >= 3 ? vf2[db] : vf0[db], pf, o[db]);
        SCHED_FENCE(); }
    {   const bf16x8 pf = pack8(s1, 1); SCHED_FENCE();
#pragma unroll
        for (int db = 0; db < NDB; ++db) o[db] = MFMA32(EARLYV >= 3 ? vf0[db] : vf1[db], pf, o[db]);
        SCHED_FENCE(); }
}
template <int DQK, int DV, int KSTR, int VSTR, bool PLAINB, int EARLYV, class Fix>
DI void tile_compute(const bf16x8 (&qf)[DQK / 16], LAS const unsigned char* Kt, LAS const unsigned char* Vt, f32x16 (&o)[DV / 32], float& m, float& l, int r, int h, int vlane, const Fix& fix, const bool plain, const float pb) {
    f32x16 s0, s1; bf16x8 vf0[DV / 32];
    tile_qk<DQK, DV, KSTR, VSTR, EARLYV>(qf, Kt, Vt, r, h, vlane, s0, s1, vf0);
    tile_sv<DV, VSTR, PLAINB, EARLYV>(Vt, s0, s1, vf0, o, m, l, r, h, vlane, fix, plain, pb);
}

template <bool PLAINB, int NDB, class Fix>
DI void tile_softmax(f32x16& s0, f32x16& s1, bf16x8 (&pf)[4], f32x16 (&o)[NDB], float& m, float& l, int r, int h, const Fix& fix, const bool plain, const float pb) {
    if (plain) {
        if (PLAINB) {
#pragma unroll
            for (int i = 0; i < 16; ++i) { s0[i] += pb; s1[i] += pb; }
        }
    } else {
#pragma unroll
        for (int i = 0; i < 16; ++i) { s0[i] = fix(s0[i], crow(i, h)); s1[i] = fix(s1[i], 32 + crow(i, h)); }
    }
    float mx = NEGBIG;
#pragma unroll
    for (int i = 0; i < 16; ++i) mx = fmaxf(mx, fmaxf(s0[i], s1[i]));
    mx = fmaxf(mx, shflx(mx, r + 32 * h, 32));
    const float m_old = m, mn = fmaxf(m, mx), alpha = fexp2(m - mn);
    float rs = 0.f;
#pragma unroll
    for (int i = 0; i < 16; ++i) { s0[i] = fexp2(s0[i] - mn); s1[i] = fexp2(s1[i] - mn); rs += s0[i] + s1[i]; }
    rs += shflx(rs, r + 32 * h, 32);
    l = l * alpha + rs; m = mn;
    pf[0] = pack8(s0, 0); pf[1] = pack8(s0, 1); pf[2] = pack8(s1, 0); pf[3] = pack8(s1, 1);
    if (__any(mx > m_old)) {
#pragma unroll
        for (int db = 0; db < NDB; ++db) o[db] = o[db] * alpha;
    }
}
template <int DV, int VSTR>
DI void tile_pv(LAS const unsigned char* Vt, const bf16x8 (&pfr)[4], f32x16 (&o)[DV / 32], int vlane) {
    constexpr int NDB = DV / 32;
    LAS const unsigned char* vp = Vt + vlane;
#pragma unroll
    for (int step = 0; step < 4; ++step) {
        bf16x8 va[NDB];
#pragma unroll
        for (int db = 0; db < NDB; ++db) va[db] = tr_pair(vp + (16 * step) * VSTR + 64 * db, vp + (16 * step + 8) * VSTR + 64 * db);
        SCHED_FENCE();
#pragma unroll
        for (int db = 0; db < NDB; ++db) o[db] = MFMA32(va[db], pfr[step], o[db]);
        SCHED_FENCE();
    }
}

constexpr int L0_KSTR = 144, L0_VSTR = 192, L0_KSZ = 64 * L0_KSTR, L0_BUF = L0_KSZ + 64 * L0_VSTR;
constexpr int OFIN_OFF = 2 * L0_BUF, MISC_OFF = 110592, BT_OFF = MISC_OFF, PSUM_OFF = MISC_OFF + 4096, PSLC_OFF = PSUM_OFF + 16384, SEL_OFF = PSLC_OFF + 32 * 33 * 4, SLOT_OFF = SEL_OFF + 128;
constexpr int LDS_BYTES = 139264;
static_assert(OFIN_OFF + 65536 <= MISC_OFF && SLOT_OFF + 4 <= LDS_BYTES - 16 && 8 * 16640 - 768 <= LDS_BYTES - 16, "LDS map");
struct KVSrc { const bf16_t* k; const bf16_t* v; int stride; };

template <int MODE> struct Fix0 {
    int tq, kpos0, W; LAS const float* bt; bool far, selbit; float bfar;
    DI float operator()(float s, int kl) const {
        if (MODE == 2) { const int c = kpos0 + kl, cd = tq - (16 * c + 31); const bool ok = cd >= 0 && c < 127; const int dd = cd < 0 ? 0 : (cd > 127 ? 127 : cd); return ok ? s + bt[dd] : NEGBIG; }
        const int dist = tq - (kpos0 + kl);
        const bool ok = MODE == 0 ? ((unsigned)dist < (unsigned)W) : (selbit && dist >= 0);
        float b = bfar; if (!far) { const int dd = dist < 0 ? 0 : (dist > 127 ? 127 : dist); b = bt[dd]; }
        return ok ? s + b : NEGBIG;
    }
};
struct FixPlain { float b; DI float operator()(float s, int) const { return s + b; } };
struct FixNone { DI float operator()(float s, int) const { return s; } };
DI u32x4 ldg16(const bf16_t* p) { return *(const u32x4*)p; }
template <int MODE, int EARLYV> DI void l0_run(unsigned tiles, const KVSrc src, LAS unsigned char* lds, const bf16x8 (&qf)[4], f32x16 (&o)[2], float& m, float& l,
                                   int tq, int t0, int W, unsigned selmask, LAS const float* bt, int tid, int r, int h, int vlane) {
    if (tiles == 0u) return;
    const int lrow = tid >> 3, lch = tid & 7; const unsigned goff = (unsigned)(lrow * src.stride + lch * 8) * 2u;
#define L0_LD(base, j) (*(const u32x4*)((const char*)((base) + (size_t)(64 * (j)) * src.stride) + goff))
#define L0_ST(bufi, kr, vr) do { LAS unsigned char* Bn_ = lds + (bufi) * L0_BUF; *(LAS u32x4*)(Bn_ + lrow * L0_KSTR + lch * 16) = (kr); *(LAS u32x4*)(Bn_ + L0_KSZ + lrow * L0_VSTR + lch * 16) = (vr); } while (0)
    int j0 = __builtin_ctz(tiles); tiles &= tiles - 1;
    u32x4 k1 = {0u, 0u, 0u, 0u}, v1 = k1, k2 = k1, v2 = k1;
    int j1 = -1;
    {   const u32x4 k0 = L0_LD(src.k, j0), v0 = L0_LD(src.v, j0);
        if (tiles != 0u) { j1 = __builtin_ctz(tiles); tiles &= tiles - 1; k1 = L0_LD(src.k, j1); v1 = L0_LD(src.v, j1); }
        L0_ST(0, k0, v0);
    }
    __syncthreads();
    int buf = 0, jc = j0;
    for (;;) {
        const bool has1 = j1 >= 0, has2 = tiles != 0u;
        int j2 = -1;
        if (has2) { j2 = __builtin_ctz(tiles); tiles &= tiles - 1; k2 = L0_LD(src.k, j2); v2 = L0_LD(src.v, j2); }
        const int j = jc;
        Fix0<MODE> fx; fx.tq = tq; fx.kpos0 = 64 * j; fx.W = W; fx.bt = bt; fx.bfar = bt[127];
        fx.far = (MODE != 2) && (t0 - (64 * j + 63) >= 113); fx.selbit = (selmask >> j) & 1u;
        LAS unsigned char* B = lds + buf * L0_BUF;
        bool plain = false;
        if (MODE == 0) plain = fx.far && (t0 + 31 - 64 * j < W);
        if (MODE == 1) plain = fx.far && __all(fx.selbit);
        tile_compute<64, 64, L0_KSTR, L0_VSTR, true, EARLYV>(qf, B, B + L0_KSZ, o, m, l, r, h, vlane, fx, plain, fx.bfar);
        const int nbuf = buf ^ 1;
        if (has1) L0_ST(nbuf, k1, v1);
        asm volatile("s_waitcnt lgkmcnt(0)\n\ts_barrier" ::: "memory");
        if (!has1) break;
        buf = nbuf; jc = j1; j1 = j2; k1 = k2; v1 = v2;
    }
#undef L0_LD
#undef L0_ST
}
DI int next_item(unsigned* ctr, LAS int* slot_in, int wave) {
    unsigned so_ = (unsigned)(size_t)slot_in; asm volatile("" : "+s"(so_)); LAS int* slot = (LAS int*)(size_t)so_;
    __syncthreads();
    if (wave == 0 && fresh_lane() == 0) *slot = (int)atomicAdd(ctr, 1u);
    __syncthreads();
    return *slot;
}
DI unsigned band_mask(int t0, int W) { const int lo = (t0 - W + 1 < 0 ? 0 : t0 - W + 1) >> 6, hi = (t0 + 31) >> 6; return (hi == 31 ? 0xffffffffu : ((1u << (hi + 1)) - 1u)) & ~((1u << lo) - 1u); }
template <int NDB> DI void store_o(const f32x16 (&o)[NDB], bf16_t* orow, int h) {
#pragma unroll
    for (int db = 0; db < NDB; ++db)
#pragma unroll
        for (int g = 0; g < 4; ++g) { u32x2 w; w.x = pk2(o[db][4 * g], o[db][4 * g + 1]); w.y = pk2(o[db][4 * g + 2], o[db][4 * g + 3]); *(u32x2*)(orow + 32 * db + 8 * g + 4 * h) = w; }
}

struct Ptrs {
    const float* in[23]; float* out; unsigned char* ws;
};
DI float sigmoidf_(float x) { return 1.0f / (1.0f + __expf(-x)); }

DI void mixerA_item(int item, unsigned char* ws, const float* sinks, LAS unsigned char* lds, int tid, int wave, int lane) {
    lane = fresh_lane(); tid = wave * 64 + lane;
    const int tt = item & 63, bg = item >> 6, b = bg >> 1, g = bg & 1, t0 = 32 * tt, hq = g * 8 + wave, r = lane & 31, h = lane >> 5, tq = t0 + r;
    const bf16_t* P0 = (const bf16_t*)(ws + WS_P0); const float* biasT = (const float*)(ws + WS_BIAS);
    LAS float* bt = (LAS float*)(lds + BT_OFF) + wave * 128; bt[lane] = biasT[hq * 128 + lane]; bt[lane + 64] = biasT[hq * 128 + lane + 64];
    const int i16 = lane & 15, vlane = ((i16 >> 2) + 4 * h) * L0_VSTR + 32 * ((lane >> 4) & 1) + 8 * (i16 & 3);
    const size_t rowb = (size_t)(b * SEQ + tq);
    bf16x8 qf[4];
#pragma unroll
    for (int kk = 0; kk < 4; ++kk) qf[kk] = __builtin_bit_cast(bf16x8, ldg16(P0 + rowb * EINP + hq * 64 + 16 * kk + 8 * h));
    f32x16 o[2];
#pragma unroll
    for (int i = 0; i < 16; ++i) { o[0][i] = 0.f; o[1][i] = 0.f; }
    float m = sinks[hq] * LOG2E, l = 1.0f;
    KVSrc src; src.k = P0 + (size_t)b * SEQ * EINP + 1024 + g * 64; src.v = P0 + (size_t)b * SEQ * EINP + 1152 + g * 64; src.stride = EINP;
    l0_run<0, 2>(band_mask(t0, 128), src, lds, qf, o, m, l, tq, t0, 128, 0u, bt, tid, r, h, vlane);
    const float inv = 1.0f / l; o[0] = o[0] * inv; o[1] = o[1] * inv;
    { int tq_ = tq; asm volatile("" : "+v"(tq_)); store_o<2>(o, (bf16_t*)(ws + WS_OB0) + (size_t)(b * SEQ + tq_) * DM + hq * 64, h); }
}

DI void mixerB_item(int item, unsigned char* ws, LAS unsigned char* lds, int tid, int wave, int lane) {
    lane = fresh_lane(); tid = wave * 64 + lane;
    const int tt = 63 - (item >> 4), bg = item & 15, b = bg >> 1, g = bg & 1, t0 = 32 * tt, hq = g * 8 + wave, r = lane & 31, h = lane >> 5, tq = t0 + r;
    const bf16_t* P0 = (const bf16_t*)(ws + WS_P0); const float* biasT = (const float*)(ws + WS_BIAS);
    LAS float* bt = (LAS float*)(lds + BT_OFF) + wave * 128; bt[lane] = biasT[(16 + hq) * 128 + lane]; bt[lane + 64] = biasT[(16 + hq) * 128 + lane + 64];
    LAS unsigned* psum = (LAS unsigned*)(lds + PSUM_OFF); LAS unsigned* pslc = (LAS unsigned*)(lds + PSLC_OFF); LAS unsigned* sel = (LAS unsigned*)(lds + SEL_OFF);
    for (int i = tid; i < 4096; i += NTHR) psum[i] = 0u;
    const int i16 = lane & 15, vlane = ((i16 >> 2) + 4 * h) * L0_VSTR + 32 * ((lane >> 4) & 1) + 8 * (i16 & 3);
    const size_t rowb = (size_t)(b * SEQ + tq);
    bf16x8 qf[4];
#pragma unroll
    for (int kk = 0; kk < 4; ++kk) qf[kk] = __builtin_bit_cast(bf16x8, ldg16(P0 + rowb * EINP + 1280 + hq * 64 + 16 * kk + 8 * h));
#define B_ROWB() ({ int tq_ = tq; asm volatile("" : "+v"(tq_)); (size_t)(b * SEQ + tq_); })
    f32x16 o[2];
    LAS float* OF = (LAS float*)(lds + OFIN_OFF) + tid;
    {
        const bf16_t* KC = (const bf16_t*)(ws + WS_KC); const bf16_t* VC = (const bf16_t*)(ws + WS_VC);
        const int lrow = tid >> 3, lch = tid & 7;
#pragma unroll
        for (int jt = 0; jt < 2; ++jt) {
            const size_t off = ((size_t)(b * 128 + 64 * jt + lrow) * 2 + g) * 64 + lch * 8;
            LAS unsigned char* B = lds + jt * L0_BUF;
            *(LAS u32x4*)(B + lrow * L0_KSTR + lch * 16) = ldg16(KC + off); *(LAS u32x4*)(B + L0_KSZ + lrow * L0_VSTR + lch * 16) = ldg16(VC + off);
        }
        __syncthreads();
#pragma unroll
        for (int i = 0; i < 16; ++i) { o[0][i] = 0.f; o[1][i] = 0.f; }
        float m = NEGBIG, l = 0.f;
        Fix0<2> fx; fx.tq = tq; fx.W = 0; fx.bt = bt; fx.far = false; fx.selbit = false; fx.bfar = 0.f;
        fx.kpos0 = 0;  tile_compute<64, 64, L0_KSTR, L0_VSTR, false, 0>(qf, lds, lds + L0_KSZ, o, m, l, r, h, vlane, fx, false, 0.f);
        fx.kpos0 = 64; tile_compute<64, 64, L0_KSTR, L0_VSTR, false, 0>(qf, lds + L0_BUF, lds + L0_BUF + L0_KSZ, o, m, l, r, h, vlane, fx, false, 0.f);
        const float inv = (tq >= 31 ? 1.0f : 0.0f) / l;
#pragma unroll 1
        for (int q = 0; q < 4; ++q) {
            f32x16 s = st_block<64, L0_KSTR>(qf, lds + (q >> 1) * L0_BUF, q & 1, r, h);
            fx.kpos0 = 64 * (q >> 1);
            LAS unsigned* pr = psum + r * 128 + 32 * q + 4 * h;
#pragma unroll
            for (int i = 0; i < 16; ++i) { const float p = fexp2(fx(s[i], 32 * (q & 1) + crow(i, h)) - m) * inv;
                __hip_atomic_fetch_add(pr + (i & 3) + 8 * (i >> 2), (unsigned)(p * 268435456.0f + 0.5f), __ATOMIC_RELAXED, __HIP_MEMORY_SCOPE_WORKGROUP); }
        }
        o[0] = o[0] * inv; o[1] = o[1] * inv;
        const float g0 = sigmoidf_(bf2f(P0[B_ROWB() * EINP + 3072 + hq * 3 + 0]));
#pragma unroll
        for (int i = 0; i < 16; ++i) { OF[i * NTHR] = o[0][i] * g0; OF[(16 + i) * NTHR] = o[1][i] * g0; }
        asm volatile("" ::: "memory");
    }
    __syncthreads();
    {
        const int tok = tid >> 4, nn = tid & 15;
#pragma unroll
        for (int e = 0; e < 2; ++e) { const int n = nn + 16 * e; const int c0 = (4 * n - 1 < 0) ? 0 : 4 * n - 1, c1 = (4 * n + 3 > 126) ? 126 : 4 * n + 3; unsigned v = 0u;
            for (int c = c0; c <= c1; ++c) v += psum[tok * 128 + c];
            pslc[tok * 33 + n] = v; }
        __syncthreads();
        const int t = t0 + tok, cur = t >> 6, quota = 8 - (cur == 0 ? 1 : (cur == 1 ? 2 : 3));
        bool sb[2];
#pragma unroll
        for (int e = 0; e < 2; ++e) { const int n = nn + 16 * e;
            const bool forced = (n == 0) || (n == cur) || (n == cur - 1), cand = (n >= 1) && (n <= cur - 2);
            const unsigned v = pslc[tok * 33 + n]; int rank = 0;
            _Pragma("unroll 1") for (int n2 = 1; n2 <= cur - 2; ++n2) { const unsigned v2 = pslc[tok * 33 + n2]; rank += (v2 > v || (v2 == v && n2 < n)) ? 1 : 0; }
            sb[e] = forced || (cand && rank < quota); }
        const unsigned long long b0 = __ballot(sb[0]), b1 = __ballot(sb[1]);
        const int k = (lane >> 4);
        if (nn == 0) sel[tok] = (unsigned)((b0 >> (16 * k)) & 0xffffull) | ((unsigned)((b1 >> (16 * k)) & 0xffffull) << 16);
        __syncthreads();
    }
    const unsigned selm = sel[r];
    unsigned U = selm;
#pragma unroll
    for (int d = 1; d < 32; d <<= 1) U |= shflxu(U, lane, d);
    U = (unsigned)__builtin_amdgcn_readfirstlane((int)U);
    const size_t bbase = (size_t)b * SEQ * EINP;
    {
#pragma unroll
        for (int i = 0; i < 16; ++i) { o[0][i] = 0.f; o[1][i] = 0.f; }
        float m = NEGBIG, l = 0.f;
        KVSrc src; src.k = P0 + bbase + 2560 + g * 64; src.v = P0 + bbase + 2688 + g * 64; src.stride = EINP;
        l0_run<1, 0>(U, src, lds, qf, o, m, l, tq, t0, 0, selm, bt, tid, r, h, vlane);
        const float sc = sigmoidf_(bf2f(P0[B_ROWB() * EINP + 3072 + hq * 3 + 1])) / l;
#pragma unroll
        for (int i = 0; i < 16; ++i) { OF[i * NTHR] += o[0][i] * sc; OF[(16 + i) * NTHR] += o[1][i] * sc; }
        asm volatile("" ::: "memory");
    }
    {
#pragma unroll
        for (int i = 0; i < 16; ++i) { o[0][i] = 0.f; o[1][i] = 0.f; }
        float m = NEGBIG, l = 0.f;
        KVSrc src; src.k = P0 + bbase + 2816 + g * 64; src.v = P0 + bbase + 2944 + g * 64; src.stride = EINP;
        l0_run<0, 0>(band_mask(t0, 512), src, lds, qf, o, m, l, tq, t0, 512, 0u, bt, tid, r, h, vlane);
        const float sc = sigmoidf_(bf2f(P0[B_ROWB() * EINP + 3072 + hq * 3 + 2])) / l;
#pragma unroll
        for (int i = 0; i < 16; ++i) { o[0][i] = OF[i * NTHR] + o[0][i] * sc; o[1][i] = OF[(16 + i) * NTHR] + o[1][i] * sc; }
    }
    store_o<2>(o, (bf16_t*)(ws + WS_OB0) + B_ROWB() * DM + 1024 + hq * 64, h);
#undef B_ROWB
}

DI float gelu_tanh(float x) { const float u = 0.7978845608028654f * (x + 0.044715f * x * x * x); return 0.5f * x * (1.0f + tanhf(u)); }
DI void compress_item(int item, unsigned char* ws, const float* pos_k, const float* pos_v, LAS unsigned char* lds, int tid, int wave, int lane) {
    lane = fresh_lane(); tid = wave * 64 + lane;
    const int kv = item >> 6, rb = item & 63, r = lane & 31, h = lane >> 5;
    const bf16_t* P0 = (const bf16_t*)(ws + WS_P0);
    const float* pos = kv ? pos_v : pos_k;
    const bf16_t* w1t = (const bf16_t*)(ws + (kv ? WS_CW1V : WS_CW1K)); const bf16_t* w2t = (const bf16_t*)(ws + (kv ? WS_CW2V : WS_CW2K));
    bf16_t* dst = (bf16_t*)(ws + (kv ? WS_VC : WS_KC));
    int rho = 32 * rb + r; if (rho > 2031) rho = 2031;
    const int b = rho / 254, rem = rho % 254, c = rem >> 1, g = rem & 1;
    const bf16_t* src = P0 + (size_t)(b * SEQ + 16 * c) * EINP + (kv ? 2432 : 2304) + g * 64 + 8 * h;
    const bf16_t* wrow = w1t + (size_t)(32 * wave + r) * 2048 + 8 * h;
    const float* prow = pos + 8 * h;
    f32x16 acc;
#pragma unroll
    for (int i = 0; i < 16; ++i) acc[i] = 0.f;
#pragma unroll 4
    for (int kk = 0; kk < 128; ++kk) {
        const int l = kk >> 2, d = 16 * (kk & 3);
        const u32x4 a = ldg16(src + (size_t)l * EINP + d); const f32x4 p0 = *(const f32x4*)(prow + l * 64 + d), p1 = *(const f32x4*)(prow + l * 64 + d + 4);
        u32x4 aa; aa.x = pk2(bflo(a.x) + p0[0], bfhi(a.x) + p0[1]); aa.y = pk2(bflo(a.y) + p0[2], bfhi(a.y) + p0[3]);
        aa.z = pk2(bflo(a.z) + p1[0], bfhi(a.z) + p1[1]); aa.w = pk2(bflo(a.w) + p1[2], bfhi(a.w) + p1[3]);
        const bf16x8 bf = __builtin_bit_cast(bf16x8, ldg16(wrow + 16 * kk));
        acc = MFMA32(__builtin_bit_cast(bf16x8, aa), bf, acc);
    }
    LAS bf16_t* Hs = (LAS bf16_t*)lds;
#pragma unroll
    for (int i = 0; i < 16; ++i) { const float v = gelu_tanh(acc[i]); Hs[crow(i, h) * 264 + 32 * wave + r] = (bf16_t)(pk2(v, 0.f) & 0xffffu); }
    __syncthreads();
    if (wave < 2) {
        f32x16 a2;
#pragma unroll
        for (int i = 0; i < 16; ++i) a2[i] = 0.f;
#pragma unroll
        for (int kk = 0; kk < 16; ++kk) {
            const bf16x8 af = *(LAS const bf16x8*)(Hs + r * 264 + 16 * kk + 8 * h);
            const bf16x8 bf = __builtin_bit_cast(bf16x8, ldg16(w2t + (size_t)(32 * wave + r) * 256 + 16 * kk + 8 * h));
            a2 = MFMA32(af, bf, a2);
        }
#pragma unroll
        for (int i = 0; i < 16; ++i) { const int rr = 32 * rb + crow(i, h);
            if (rr < 2032) { const int b2 = rr / 254, rem2 = rr % 254; dst[((size_t)(b2 * 128 + (rem2 >> 1)) * 2 + (rem2 & 1)) * 64 + 32 * wave + r] = (bf16_t)(pk2(a2[i], 0.f) & 0xffffu); } }
    }
    __syncthreads();
}

constexpr int C_KSTR = 400, C_VSTR = 320, C_KSZ = 64 * C_KSTR, C_BUF = C_KSZ + 64 * C_VSTR;
struct FixC { int tq, kpos0; DI float operator()(float s, int kl) const { return (kpos0 + kl) <= tq ? s : NEGBIG; } };
template <int VAR> DI void mla_item(int item, unsigned char* ws, LAS unsigned char* lds, int tid, int wave, int lane) {
    lane = fresh_lane(); tid = wave * 64 + lane;
    const int qb = 7 - (item >> 7), bh = item & 127, b = bh >> 4, hh = bh & 15, r = lane & 31, h = lane >> 5, tq = qb * 256 + 32 * wave + r;
    const bf16_t* Q1 = (const bf16_t*)(ws + WS_Q1); const bf16_t* KV1 = (const bf16_t*)(ws + WS_KV1); const bf16_t* KR = (const bf16_t*)(ws + WS_KR);
    const int i16 = lane & 15, vlane = ((i16 >> 2) + 4 * h) * C_VSTR + 32 * ((lane >> 4) & 1) + 8 * (i16 & 3);
    const size_t rowb = (size_t)(b * SEQ + tq);
    bf16x8 qf[12];
#pragma unroll
    for (int kk = 0; kk < 12; ++kk) qf[kk] = __builtin_bit_cast(bf16x8, ldg16(Q1 + rowb * QUP + hh * 192 + 16 * kk + 8 * h));
    f32x16 o[4];
#pragma unroll
    for (int d = 0; d < 4; ++d)
#pragma unroll
        for (int i = 0; i < 16; ++i) o[d][i] = 0.f;
    float m, l = 0.f; { unsigned nb_ = 0xf149f2cau; asm volatile("" : "+s"(nb_)); m = __uint_as_float(nb_); }
    const int ntile = 4 * qb + 4;
    const bf16_t* kvb = KV1 + (size_t)b * SEQ * KVUP + hh * 256; const bf16_t* krb = KR + (size_t)b * SEQ * 64;
    const int vrow0 = tid >> 4, vch = tid & 15, rrow = tid >> 3, rch = tid & 7;
    const unsigned kvoff = (unsigned)(vrow0 * KVUP + vch * 8) * 2u, kroff = (unsigned)(rrow * 64 + rch * 8) * 2u;
    u32x4 kreg[3], vreg[2];
#define MLA_LOAD(j) do { const char* tb_ = (const char*)(kvb + (size_t)(64 * (j)) * KVUP); const char* rb_ = (const char*)(krb + (size_t)(64 * (j)) * 64); \
        kreg[0] = *(const u32x4*)(tb_ + kvoff); kreg[1] = *(const u32x4*)(tb_ + kvoff + 32u * KVUP * 2u); kreg[2] = *(const u32x4*)(rb_ + kroff); \
        vreg[0] = *(const u32x4*)(tb_ + kvoff + 256u); vreg[1] = *(const u32x4*)(tb_ + kvoff + 32u * KVUP * 2u + 256u); } while (0)
#define MLA_STORE(B) do { *(LAS u32x4*)((B) + vrow0 * C_KSTR + vch * 16) = kreg[0]; *(LAS u32x4*)((B) + (vrow0 + 32) * C_KSTR + vch * 16) = kreg[1]; *(LAS u32x4*)((B) + rrow * C_KSTR + 256 + rch * 16) = kreg[2]; \
        *(LAS u32x4*)((B) + C_KSZ + vrow0 * C_VSTR + vch * 16) = vreg[0]; *(LAS u32x4*)((B) + C_KSZ + (vrow0 + 32) * C_VSTR + vch * 16) = vreg[1]; } while (0)
    MLA_LOAD(0); MLA_STORE(lds);
    __syncthreads();
    const int tqmax = qb * 256 + 32 * wave + 31;
    for (int j = 0; j < ntile; ++j) {
        const bool more = (j + 1 < ntile);
        if (more) MLA_LOAD(j + 1);
        LAS unsigned char* B = lds + (j & 1) * C_BUF;
        if (64 * j <= tqmax) {
            FixC fx; fx.tq = tq; fx.kpos0 = 64 * j;
            tile_compute<192, 128, C_KSTR, C_VSTR, false, 1>(qf, B, B + C_KSZ, o, m, l, r, h, vlane, fx, 64 * j + 63 <= tqmax - 31  , 0.f);
        }
        if (more) { LAS unsigned char* Bn = lds + ((j + 1) & 1) * C_BUF; MLA_STORE(Bn); }
        __syncthreads();
    }
#undef MLA_LOAD
#undef MLA_STORE
    const float inv = __builtin_amdgcn_rcpf(l);
#pragma unroll
    for (int d = 0; d < 4; ++d) o[d] = o[d] * inv;
    {
        int it_ = item; asm volatile("" : "+s"(it_)); const int bh_ = it_ & 127, qb_ = 7 - (it_ >> 7);
        int ln_ = lane; asm volatile("" : "+v"(ln_));
        const size_t row_ = (size_t)((bh_ >> 4) * SEQ + qb_ * 256 + 32 * wave + (ln_ & 31));
        store_o<4>(o, (bf16_t*)(ws + WS_OB1) + row_ * DM + (bh_ & 15) * 128, ln_ >> 5); }
}

DI float wave_sum(float v, int lane) {
#pragma unroll
    for (int o = 1; o < 64; o <<= 1) v += shflx(v, lane, o);
    return v;
}
DI void wt_item(const float* W, int K, int N, int nblk, bf16_t* WT, const float* gk, int mode, LAS float* scr, int item, int lane) {
    const int kb = item / nblk, nb = item % nblk, k0 = 64 * kb, n0 = 64 * nb;
    const int lr = lane >> 4, lc = 4 * (lane & 15);
    const bool cvalid = (n0 + lc) < N;
    const float* wp = W + (size_t)(k0 + lr) * N + n0 + lc;
    f32x4 v[16];
#pragma unroll
    for (int r = 0; r < 16; ++r) v[r] = cvalid ? *(const f32x4*)(wp + (size_t)(4 * r) * N) : (f32x4){0.f, 0.f, 0.f, 0.f};
    if (gk) {
#pragma unroll
        for (int r = 0; r < 16; ++r) v[r] = v[r] * gk[k0 + 4 * r + lr];
    }
#pragma unroll
    for (int r = 0; r < 16; ++r) { LAS float* q = scr + (4 * r + lr) * 65 + lc; q[0] = v[r][0]; q[1] = v[r][1]; q[2] = v[r][2]; q[3] = v[r][3]; }
    const int nl = lane >> 3, c = lane & 7;
#pragma unroll
    for (int i = 0; i < 8; ++i) {
        const int ln = 8 * i + nl, n = n0 + ln; int srcl = ln; float scale = 1.0f;
        if (mode == 1) { if (n < 1024 || (n >= 1280 && n < 2304)) scale = 0.125f * LOG2E; }
        else if (mode == 2) { if (n >= 1280 && n < 1344) srcl = (ln >> 1) + 32 * (ln & 1); }
        else if (mode == 3) { if ((n % 192) >= 128) srcl = (ln >> 1) + 32 * (ln & 1); scale = 0.07216878364870322f * LOG2E; }
        const LAS float* sp = scr + (8 * c) * 65 + srcl;
        u32x4 o; o.x = pk2(sp[0 * 65] * scale, sp[1 * 65] * scale); o.y = pk2(sp[2 * 65] * scale, sp[3 * 65] * scale);
        o.z = pk2(sp[4 * 65] * scale, sp[5 * 65] * scale); o.w = pk2(sp[6 * 65] * scale, sp[7 * 65] * scale);
        *(u32x4*)(WT + (size_t)n * K + k0 + 8 * c) = o;
    }
}
#define WT_JOB(W_, K_, N_, NPAD_, DST_, GK_, MODE_) do { const int nblk_ = (NPAD_) / 64, cnt_ = ((K_) / 64) * nblk_; int first_ = (gw - wt_base) % ngw; if (first_ < 0) first_ += ngw; \
    for (int it_ = first_; it_ < cnt_; it_ += ngw) wt_item((W_), (K_), (N_), nblk_, (bf16_t*)(ws + (DST_)), (GK_), (MODE_), scr, it_, lane); wt_base = (wt_base + cnt_) % ngw; } while (0)
DI int t5_bucket(int d) {
    if (d < 16) return d;
    const int v = 16 + (int)(logf((float)d / 16.0f) / 2.0794415416798357f * 16.0f);
    return v > 31 ? 31 : v;
}

#define CAS __attribute__((address_space(4)))
DI const float* inp(int i) { const CAS char* ka = (const CAS char*)__builtin_amdgcn_kernarg_segment_ptr(); asm volatile("" : "+s"(ka)); return ((const float* const CAS*)ka)[i]; }
DI unsigned xcc_id() { return (unsigned)__builtin_amdgcn_s_getreg((3 << 11) | 20) & 7u; }
#ifndef REP_P0
#define REP_P0 0
#endif
#ifndef REP_A
#define REP_A 0
#endif
#ifndef REP_B
#define REP_B 0
#endif
#ifndef REP_C
#define REP_C 0
#endif
#ifndef REP_UP
#define REP_UP 0
#endif
#ifndef EN_PRO
#define EN_PRO 1
#endif
#ifndef EN_GEMM
#define EN_GEMM 1
#endif
#ifndef EN_A
#define EN_A 1
#endif
#ifndef EN_B
#define EN_B 1
#endif
#ifndef EN_C
#define EN_C 1
#endif
#define XB_TMO      128
#define XB_XCNT(j)  (256  + 64 * (j))
#define XB_XSUB(j)  (1280 + 64 * (j))
#define XB_XGEN(j)  (2304 + 64 * (j))
#define XB_TOP      3328
#define XB_TOPGEN   3392
#define XCD_BAR_WORDS 3456
#define XB_SPIN_CAP (1u << 18)

__device__ __forceinline__ unsigned xb_ld(unsigned* p)              { return __hip_atomic_load(p, __ATOMIC_RELAXED, __HIP_MEMORY_SCOPE_AGENT); }
__device__ __forceinline__ unsigned xb_add(unsigned* p, unsigned v) { return __hip_atomic_fetch_add(p, v, __ATOMIC_RELAXED, __HIP_MEMORY_SCOPE_AGENT); }
__device__ __forceinline__ unsigned xb_xcc_id() { return (unsigned)__builtin_amdgcn_s_getreg((3 << 11) | 20) & 0xFu; }
#define XB_SPIN(cond, bar) do { unsigned _sp = 0; while (cond) { __builtin_amdgcn_s_sleep(1); \
    if ((++_sp & 255u) == 0u) { if (xb_ld(&(bar)[XB_TMO])) break; if (_sp > XB_SPIN_CAP) { atomicAdd(&(bar)[XB_TMO], 1u); break; } } } } while (0)

struct XcdBarrier {
    unsigned* bar; unsigned x;
    volatile LAS unsigned* st;
};

__device__ __forceinline__ XcdBarrier xcd_barrier_post(unsigned* bar, volatile LAS unsigned* st, int wave) {
    XcdBarrier b; b.bar = bar; b.x = xb_xcc_id(); b.st = st;
    if (wave == 0 && fresh_lane() == 0) (void)xb_add(&bar[XB_XCNT(b.x)], 1u);
    return b;
}
__device__ __forceinline__ void xcd_barrier_complete(unsigned* bar, unsigned x, unsigned& nloc, unsigned& nx) {
    const unsigned G = gridDim.x * gridDim.y * gridDim.z;
    unsigned sum, cnt, mine, sp = 0u;
    for (;;) {
        sum = 0u; cnt = 0u; mine = 0u;
#pragma unroll
        for (unsigned j = 0; j < 16; ++j) { const unsigned c = xb_ld(&bar[XB_XCNT(j)]); sum += c; cnt += (c > 0u) ? 1u : 0u; mine = (j == x) ? c : mine; }
        if (sum == G) break;
        __builtin_amdgcn_s_sleep(1);
        if ((++sp & 255u) == 0u) { if (xb_ld(&bar[XB_TMO])) break; if (sp > XB_SPIN_CAP) { atomicAdd(&bar[XB_TMO], 1u); break; } }
    }
    nloc = mine > 0u ? mine : 1u; nx = cnt > 0u ? cnt : 1u;
}

__device__ __forceinline__ void xcd_barrier(const XcdBarrier& b, int wave) {
    asm volatile("s_waitcnt vmcnt(0)" ::: "memory");
    __syncthreads();
    if (wave == 0 && fresh_lane() == 0) {
        unsigned* bar = b.bar;
        __builtin_amdgcn_s_waitcnt(0);
        unsigned nloc = b.st[0], nx = b.st[1];
        if (nloc == 0u) { xcd_barrier_complete(bar, b.x, nloc, nx); b.st[0] = nloc; b.st[1] = nx; }
        const unsigned old = xb_add(&bar[XB_XSUB(b.x)], 1u);
        const unsigned gen = old / nloc;
        if (old + 1u == (gen + 1u) * nloc) {
            __builtin_amdgcn_fence(__ATOMIC_RELEASE, "agent");
            asm volatile("s_waitcnt vmcnt(0)" ::: "memory");
            const unsigned og = xb_add(&bar[XB_TOP], 1u);
            const unsigned tg = og / nx;
            if (og + 1u == (tg + 1u) * nx) xb_add(&bar[XB_TOPGEN], 1u);
            else XB_SPIN(xb_ld(&bar[XB_TOPGEN]) == tg, bar);
            __builtin_amdgcn_fence(__ATOMIC_ACQUIRE, "agent");
            xb_add(&bar[XB_XGEN(b.x)], 1u);
            asm volatile("s_waitcnt vmcnt(0)" ::: "memory");
        } else {
            XB_SPIN(xb_ld(&bar[XB_XGEN(b.x)]) == gen, bar);
            __builtin_amdgcn_fence(__ATOMIC_ACQUIRE, "agent");
            asm volatile("s_waitcnt vmcnt(0)" ::: "memory");
        }
    }
    __syncthreads();
}

__global__ void __launch_bounds__(NTHR, 2) fwd_kernel(Ptrs P) {
    extern __shared__ __attribute__((aligned(16))) unsigned char lds_raw[];
    LAS unsigned char* lds = (LAS unsigned char*)lds_raw;
    const int wave = __builtin_amdgcn_readfirstlane((int)threadIdx.x >> 6);
    int lane, tid;
#define FRESH_TID() do { lane = fresh_lane(); tid = wave * 64 + lane; } while (0)
    FRESH_TID();
    if (tid < 4) ((volatile LAS unsigned*)(lds + LDS_BYTES - 16))[tid] = 0u;
    __syncthreads();
    const int G = gridDim.x, bx = blockIdx.x, gw = bx * 8 + wave, ngw = G * 8;
    unsigned char* ws = (unsigned char*)inp(24);
    unsigned* ctl = (unsigned*)(ws + WS_CTL);
    const XcdBarrier xbar = xcd_barrier_post((unsigned*)(ws + WS_BAR), (volatile LAS unsigned*)(lds + LDS_BYTES - 16), wave);
    float* part = (float*)(ws + WS_PART); float* part2 = (float*)(ws + WS_PART2);
    bf16_t* XB = (bf16_t*)(ws + WS_XB);
    LAS float* scr = (LAS float*)(lds + wave * 17408);
    LAS int* slot = (LAS int*)(lds + SLOT_OFF);

    for (int rep_ = 0; rep_ <= REP_P0; ++rep_) {
    if (rep_) xcd_barrier(xbar, wave);
        if (bx == 0 && tid < 64) ctl[tid] = 0u;
        int wt_base = 0;
        WT_JOB(inp(3), DM, EIN, EINP, WS_WINE, inp(2), 1); WT_JOB(inp(11), DM, DM, DM, WS_WOUTE, (const float*)nullptr, 0); WT_JOB(inp(13), DM, OIN, OINP, WS_WINO, inp(12), 2);
        WT_JOB(inp(15), 768, QUP, QUP, WS_WQUP, inp(14), 3); WT_JOB(inp(17), 512, KVUP, KVUP, WS_WKVUP, inp(16), 0); WT_JOB(inp(18), DM, DM, DM, WS_WOUTO, (const float*)nullptr, 0);
        WT_JOB(inp(20), DM, FF, FF, WS_WUP, inp(19), 0); WT_JOB(inp(21), FF, DM, DM, WS_WDN, (const float*)nullptr, 0);
        WT_JOB(inp(7), 2048, 256, 256, WS_CW1K, (const float*)nullptr, 0); WT_JOB(inp(9), 2048, 256, 256, WS_CW1V, (const float*)nullptr, 0);
        WT_JOB(inp(8), 256, 64, 64, WS_CW2K, (const float*)nullptr, 0); WT_JOB(inp(10), 256, 64, 64, WS_CW2V, (const float*)nullptr, 0);
        const float* x = inp(0);
        for (int row = gw; row < MTOK; row += ngw) {
            const f32x4* xr = (const f32x4*)(x + (size_t)row * DM) + lane; u32x2* xo = (u32x2*)(XB + (size_t)row * DM) + lane; float s = 0.f;
#pragma unroll
            for (int j = 0; j < 8; ++j) { const f32x4 v = xr[64 * j]; s += (v[0] * v[0] + v[1] * v[1]) + (v[2] * v[2] + v[3] * v[3]); u32x2 w; w.x = pk2(v[0], v[1]); w.y = pk2(v[2], v[3]); xo[64 * j] = w; }
            s = wave_sum(s, lane);
            if (lane < 32) part[(size_t)row * 32 + lane] = lane == 0 ? s : 0.f;
        }
        const int gt = bx * NTHR + tid, ngt = G * NTHR;
        float* biasT = (float*)(ws + WS_BIAS); float* cosT = (float*)(ws + WS_COS); float* sinT = (float*)(ws + WS_SIN);
        { const float* rb = inp(1); for (int i = gt; i < 32 * 128; i += ngt) { const int hd = i >> 7, d = i & 127; biasT[i] = rb[t5_bucket(d) * 32 + hd] * LOG2E; } }
        for (int i = gt; i < 2048 * 32; i += ngt) { const int s = i >> 5, ii = i & 31; const float inv = 1.0f / powf(10000.0f, (float)(2 * ii) / 64.0f); const float ang = (float)s * inv; cosT[i] = cosf(ang); sinT[i] = sinf(ang); }
        bf16_t* KC = (bf16_t*)(ws + WS_KC); bf16_t* VC = (bf16_t*)(ws + WS_VC);
        for (int i = gt; i < 8 * 128; i += ngt) { const int b = i >> 7, e = i & 127; KC[(size_t)(b * 128 + 127) * 128 + e] = 0; VC[(size_t)(b * 128 + 127) * 128 + e] = 0; }
    }
    if (gridDim.y == 0x7fffu) cg::this_grid().sync();
    xcd_barrier(xbar, wave);
    {
        pg8::Gemm g{XB, (const bf16_t*)(ws + WS_WINE), MTOK, EINP, DM, DM}; pg8::StaticOrder S; S.init(MTOK, 3072, G, bx);
        pg8::EpiScale<0> E{(bf16_t*)(ws + WS_P0), EINP, part, nullptr, nullptr, nullptr, nullptr};
        if (EN_GEMM) pg8::gemm_phase<pg8::EpiScale<0>, pg8::StaticOrder, true, true>(lds, g, S, E, wave);
    }
    xcd_barrier(xbar, wave);
    FRESH_TID();
    {
        pg8::Gemm g{XB, (const bf16_t*)(ws + WS_WINE), MTOK, EINP, DM, DM}; pg8::TailOrder T{bx, 12};
        pg8::EpiScale<0> E{(bf16_t*)(ws + WS_P0), EINP, part, nullptr, nullptr, nullptr, nullptr};
        pg8::gemm_phase<pg8::EpiScale<0>, pg8::TailOrder, true, true>(lds, g, T, E, wave);
        __syncthreads();
        FRESH_TID();
    }
    {
        const float* pk_ = inp(5); const float* pv_ = inp(6); const float* sk_ = inp(4);
        for (;;) { const int it = next_item(ctl + 0, slot, wave); if (it >= 128) break; compress_item(it, ws, pk_, pv_, lds, tid, wave, lane); }
        const unsigned x0 = xcc_id();
        for (int s = 0; s < 8; ++s) { const int xq = (int)((x0 + s) & 7u);
            for (;;) { const int k = next_item(ctl + 16 + xq, slot, wave); if (k >= 128) break; mixerA_item((xq + 8 * (k & 1)) * 64 + (k >> 1), ws, sk_, lds, tid, wave, lane); } }
    }
    xcd_barrier(xbar, wave);
    FRESH_TID();
    {
        const unsigned x0 = xcc_id();
        for (int s = 0; s < 8; ++s) { const int xq = (int)((x0 + s) & 7u);
            for (;;) { const int k = next_item(ctl + 32 + xq, slot, wave); if (k >= 128) break; mixerB_item(((k >> 1) << 4) | (xq + 8 * (k & 1)), ws, lds, tid, wave, lane); } }
    }
    xcd_barrier(xbar, wave);
    {
        pg8::Gemm g{(const bf16_t*)(ws + WS_OB0), (const bf16_t*)(ws + WS_WOUTE), MTOK, DM, DM, DM}; pg8::StaticOrder S; S.init(MTOK, DM, G, bx);
        pg8::EpiResidual<false> E{inp(0), (float*)inp(23), XB, part};
        if (EN_GEMM) pg8::gemm_phase<pg8::EpiResidual<false>, pg8::StaticOrder, true, true>(lds, g, S, E, wave);
    }
    xcd_barrier(xbar, wave);
    {
        for (int rep_ = 0; rep_ <= REP_UP; ++rep_) {
            if (rep_) xcd_barrier(xbar, wave);
            pg8::Gemm g{XB, (const bf16_t*)(ws + WS_WUP), MTOK, FF, DM, DM}; pg8::StaticOrder S; S.init(MTOK, FF, G, bx);
            pg8::EpiScale<1> E{(bf16_t*)(ws + WS_HB), FF, part, nullptr, nullptr, nullptr, nullptr};
            if (EN_GEMM) pg8::gemm_phase<pg8::EpiScale<1>, pg8::StaticOrder, true, true>(lds, g, S, E, wave);
        }
        xcd_barrier(xbar, wave);
        {
            pg8::Gemm g{(const bf16_t*)(ws + WS_HB), (const bf16_t*)(ws + WS_WDN), MTOK, DM, FF, FF}; pg8::StaticOrder S; S.init(MTOK, DM, G, bx);
            float* outp = (float*)inp(23); pg8::EpiResidual<false> E{outp, outp, XB, part};
            if (EN_GEMM) pg8::gemm_phase<pg8::EpiResidual<false>, pg8::StaticOrder, true, true>(lds, g, S, E, wave);
        }
        xcd_barrier(xbar, wave);
    }
    {
            FRESH_TID();
            int wt_base = 0;
            WT_JOB(inp(20) + (size_t)DM * FF, DM, FF, FF, WS_WUP, inp(19) + DM, 0); WT_JOB(inp(21) + (size_t)FF * DM, FF, DM, DM, WS_WDN, (const float*)nullptr, 0);
            __syncthreads();
            {
                pg8::Gemm g{XB, (const bf16_t*)(ws + WS_WINO), MTOK, OINP, DM, DM}; pg8::StaticOrder S; S.init(MTOK, OINP, G, bx);
                pg8::EpiScale<2> E{(bf16_t*)(ws + WS_P1), OINP, part, part2, (bf16_t*)(ws + WS_KR), (const float*)(ws + WS_COS), (const float*)(ws + WS_SIN)};
                if (EN_GEMM) pg8::gemm_phase<pg8::EpiScale<2>, pg8::StaticOrder, true, true>(lds, g, S, E, wave);
            }
            xcd_barrier(xbar, wave);
            {
                pg8::Gemm g{(const bf16_t*)(ws + WS_P1), (const bf16_t*)(ws + WS_WQUP), MTOK, QUP, 768, OINP}; pg8::StaticOrder S; S.init(MTOK, QUP, G, bx);
                pg8::EpiScale<3> E{(bf16_t*)(ws + WS_Q1), QUP, part2, nullptr, nullptr, (const float*)(ws + WS_COS), (const float*)(ws + WS_SIN)};
                if (EN_GEMM) pg8::gemm_phase<pg8::EpiScale<3>, pg8::StaticOrder, true, true>(lds, g, S, E, wave);
            }
            {
                pg8::Gemm g{(const bf16_t*)(ws + WS_P1) + 768, (const bf16_t*)(ws + WS_WKVUP), MTOK, KVUP, 512, OINP}; pg8::StaticOrder S; S.init(MTOK, KVUP, G, bx);
                pg8::EpiScale<4> E{(bf16_t*)(ws + WS_KV1), KVUP, part2, nullptr, nullptr, nullptr, nullptr};
                if (EN_GEMM) pg8::gemm_phase<pg8::EpiScale<4>, pg8::StaticOrder, true, true>(lds, g, S, E, wave);
            }
            xcd_barrier(xbar, wave);
            FRESH_TID();
#ifndef MLA_PROBE
#define MLA_PROBE 0
#endif
            if (MLA_PROBE) {
                const unsigned x0 = xcc_id();
                for (int s = 0; s < 8; ++s) { const int xq = (int)((x0 + s) & 7u);
                    for (;;) { const int k = next_item(ctl + 56 + xq, slot, wave); if (k >= 128) break;
                        const int bh = ((k >> 5) * 4 + (k & 3)) * 8 + xq, q7 = (k & 31) >> 2;
                        mla_item<MLA_PROBE>((q7 << 7) | bh, ws, lds, tid, wave, lane); } }
                xcd_barrier(xbar, wave);
            }
            {
                const unsigned x0 = xcc_id();
                for (int s = 0; s < 8; ++s) { const int xq = (int)((x0 + s) & 7u);
                    for (;;) { const int k = next_item(ctl + 48 + xq, slot, wave); if (k >= 128) break;
                        const int bh = ((k >> 5) * 4 + (k & 3)) * 8 + xq, q7 = (k & 31) >> 2;
                        mla_item<0>((q7 << 7) | bh, ws, lds, tid, wave, lane); } }
            }
            xcd_barrier(xbar, wave);
            {
                pg8::Gemm g{(const bf16_t*)(ws + WS_OB1), (const bf16_t*)(ws + WS_WOUTO), MTOK, DM, DM, DM}; pg8::StaticOrder S; S.init(MTOK, DM, G, bx);
                float* outp = (float*)inp(23); pg8::EpiResidual<false> E{outp, outp, XB, part};
                if (EN_GEMM) pg8::gemm_phase<pg8::EpiResidual<false>, pg8::StaticOrder, true, true>(lds, g, S, E, wave);
            }
            xcd_barrier(xbar, wave);
    }
    {
        for (int rep_ = 0; rep_ <= REP_UP; ++rep_) {
            if (rep_) xcd_barrier(xbar, wave);
            pg8::Gemm g{XB, (const bf16_t*)(ws + WS_WUP), MTOK, FF, DM, DM}; pg8::StaticOrder S; S.init(MTOK, FF, G, bx);
            pg8::EpiScale<1> E{(bf16_t*)(ws + WS_HB), FF, part, nullptr, nullptr, nullptr, nullptr};
            if (EN_GEMM) pg8::gemm_phase<pg8::EpiScale<1>, pg8::StaticOrder, true, true>(lds, g, S, E, wave);
        }
        xcd_barrier(xbar, wave);
        {
            pg8::Gemm g{(const bf16_t*)(ws + WS_HB), (const bf16_t*)(ws + WS_WDN), MTOK, DM, FF, FF}; pg8::StaticOrder S; S.init(MTOK, DM, G, bx);
            float* outp = (float*)inp(23); pg8::EpiResidual<true> E{outp, outp, XB, part};
            if (EN_GEMM) pg8::gemm_phase<pg8::EpiResidual<true>, pg8::StaticOrder, true, true>(lds, g, S, E, wave);
        }
        xcd_barrier(xbar, wave);
    }
    FRESH_TID();
    {
        const float* gf = inp(22); float* outp = (float*)inp(23);
        for (int row = gw; row < MTOK; row += ngw) {
            const f32x4* pr = (const f32x4*)(part + (size_t)row * 32); float s = 0.f;
#pragma unroll
            for (int i = 0; i < 8; ++i) { const f32x4 v = pr[i]; s += (v[0] + v[1]) + (v[2] + v[3]); }
            const float rs = __builtin_amdgcn_rsqf(s * (1.0f / 2048.0f) + EPS);
            f32x4* xr = (f32x4*)(outp + (size_t)row * DM) + lane; const f32x4* gr = (const f32x4*)gf + lane; const u32x2* xb = (const u32x2*)(XB + (size_t)row * DM) + lane;
#pragma unroll
            for (int j = 0; j < 8; ++j) { const u32x2 w = xb[64 * j]; const f32x4 gg = gr[64 * j]; f32x4 v; v[0] = bflo(w.x); v[1] = bfhi(w.x); v[2] = bflo(w.y); v[3] = bfhi(w.y); xr[64 * j] = v * rs * gg; }
        }
    }
}

extern "C" void kernel_launch(void* const* d_in, const int* in_sizes, int n_in, void* d_out, int out_size, void* d_ws, size_t ws_size, hipStream_t stream) {
    static int grid = 0;
    if (grid == 0) {
        if (n_in != 23 || out_size != MTOK * DM || ws_size < WS_END) { fprintf(stderr, "kernel_launch: unexpected shapes (n_in %d out %d ws %zu need %zu)\n", n_in, out_size, ws_size, (size_t)WS_END); grid = -1; return; }
        int dev = 0, cus = 0, per_cu = 0;
        hipGetDevice(&dev); hipDeviceGetAttribute(&cus, hipDeviceAttributeMultiprocessorCount, dev);
        hipFuncSetAttribute((const void*)fwd_kernel, hipFuncAttributeMaxDynamicSharedMemorySize, LDS_BYTES);
        hipOccupancyMaxActiveBlocksPerMultiprocessor(&per_cu, (const void*)fwd_kernel, NTHR, LDS_BYTES);
        if (per_cu < 1) { fprintf(stderr, "kernel_launch: occupancy query returned %d\n", per_cu); per_cu = 1; }
        grid = cus;
    }
    if (grid < 0) return;
    if (hipMemsetAsync(d_ws, 0, 16384, stream) != hipSuccess) { fprintf(stderr, "kernel_launch: memset of the control words failed\n"); return; }
    Ptrs p{};
    for (int i = 0; i < 23; ++i) p.in[i] = (const float*)d_in[i];
    p.out = (float*)d_out; p.ws = (unsigned char*)d_ws;
    void* args[] = {&p};
    hipError_t e = hipLaunchCooperativeKernel((const void*)fwd_kernel, dim3(grid), dim3(NTHR), args, LDS_BYTES, stream);
    if (e != hipSuccess) fprintf(stderr, "cooperative launch failed: %s (grid %d)\n", hipGetErrorString(e), grid);
}
```

```cpp
#include <hip/hip_runtime.h>
#include <hip/hip_cooperative_groups.h>
#include <cstdio>
#include <cstdint>
namespace cg = cooperative_groups;

#define DI __device__ __forceinline__
#define LAS __attribute__((address_space(3)))
typedef unsigned short bf16_t;
typedef short bf16x8 __attribute__((ext_vector_type(8)));
typedef short s16x4 __attribute__((ext_vector_type(4)));
typedef float f32x4 __attribute__((ext_vector_type(4)));
typedef float f32x2 __attribute__((ext_vector_type(2)));
typedef float f32x16 __attribute__((ext_vector_type(16)));
typedef unsigned u32x4 __attribute__((ext_vector_type(4)));
typedef unsigned u32x2 __attribute__((ext_vector_type(2)));
typedef __bf16 bf16v2 __attribute__((ext_vector_type(2)));

DI unsigned pk2(float lo, float hi) { bf16v2 v = {(__bf16)lo, (__bf16)hi}; return __builtin_bit_cast(unsigned, v); }
DI int fresh_lane() { int l; asm volatile("v_mbcnt_lo_u32_b32 %0, -1, 0\n\tv_mbcnt_hi_u32_b32 %0, -1, %0" : "=v"(l)); return l; }
DI float shflx(float v, int lane, int k) { return __int_as_float(__builtin_amdgcn_ds_bpermute((lane ^ k) << 2, __float_as_int(v))); }
DI unsigned shflxu(unsigned v, int lane, int k) { return (unsigned)__builtin_amdgcn_ds_bpermute((lane ^ k) << 2, (int)v); }
DI float bflo(unsigned u) { return __uint_as_float(u << 16); }
DI float bfhi(unsigned u) { return __uint_as_float(u & 0xffff0000u); }
DI float bf2f(bf16_t v) { return __uint_as_float(((unsigned)v) << 16); }

constexpr int DM = 2048, SEQ = 2048, NBATCH = 8, MTOK = NBATCH * SEQ, FF = 8192;
constexpr int EIN = 3120, EINP = 3328, OIN = 1344, OINP = 1536, QUP = 3072, KVUP = 4096;
constexpr float EPS = 1e-6f, LOG2E = 1.4426950408889634f, NEGBIG = -1e30f;
constexpr int NTHR = 512;

constexpr size_t al256(size_t x) { return (x + 255) & ~(size_t)255; }
constexpr size_t WS_CTL = 0;
constexpr size_t WS_BAR = 1024;
constexpr size_t WS_PART = 16384;
constexpr size_t WS_PART2 = WS_PART + (size_t)MTOK * 32 * 4;
constexpr size_t WS_BIAS = WS_PART2 + (size_t)MTOK * 32 * 4;
constexpr size_t WS_COS = WS_BIAS + 32 * 128 * 4;
constexpr size_t WS_SIN = WS_COS + 2048 * 32 * 4;
constexpr size_t WS_KC = WS_SIN + 2048 * 32 * 4;
constexpr size_t WS_VC = WS_KC + 8 * 128 * 128 * 2;
constexpr size_t WS_KR = WS_VC + 8 * 128 * 128 * 2;
constexpr size_t WS_WINE = WS_KR + (size_t)MTOK * 64 * 2;
constexpr size_t WS_WOUTE = WS_WINE + (size_t)EINP * DM * 2;
constexpr size_t WS_WINO = WS_WOUTE + (size_t)DM * DM * 2;
constexpr size_t WS_WQUP = WS_WINO + (size_t)OINP * DM * 2;
constexpr size_t WS_WKVUP = WS_WQUP + (size_t)QUP * 768 * 2;
constexpr size_t WS_WOUTO = WS_WKVUP + (size_t)KVUP * 512 * 2;
constexpr size_t WS_WUP = WS_WOUTO + (size_t)DM * DM * 2;
constexpr size_t WS_WDN = WS_WUP + (size_t)FF * DM * 2;
constexpr size_t WS_CW1K = WS_WDN + (size_t)DM * FF * 2;
constexpr size_t WS_CW1V = WS_CW1K + 256 * 2048 * 2;
constexpr size_t WS_CW2K = WS_CW1V + 256 * 2048 * 2;
constexpr size_t WS_CW2V = WS_CW2K + 64 * 256 * 2;
constexpr size_t WS_XB = WS_CW2V + 64 * 256 * 2;
constexpr size_t WS_R = WS_XB + (size_t)MTOK * DM * 2;
constexpr size_t WS_P0 = WS_R, WS_OB0 = WS_R + (size_t)MTOK * EINP * 2;
constexpr size_t WS_P1 = WS_R, WS_OB1 = WS_R, WS_Q1 = WS_R + (size_t)MTOK * DM * 2, WS_KV1 = WS_Q1 + (size_t)MTOK * QUP * 2;
constexpr size_t WS_HB = WS_R;
constexpr size_t WS_END = WS_KV1 + (size_t)MTOK * KVUP * 2;
static_assert(WS_R + (size_t)MTOK * FF * 2 <= WS_END, "HB fits");

namespace pg8 {
#define PG8_LAS __attribute__((address_space(3)))
constexpr int BM = 256, BK = 64, HALF = 128, HTB = HALF * BK * 2  , STAGE_BYTES = 8 * HTB, NXCD = 8, WGM = 8;
__host__ __device__ __forceinline__ int lds_byte(int r, int c) { const int st = (r >> 4) * 2 + (c >> 5), rr = r & 15, cc = c & 31, ob = rr * 64 + cc * 2; return st * 1024 + (ob ^ (((ob >> 9) & 1) << 5)); }
__host__ __device__ __forceinline__ void stage_rc(int b, int& R, int& C) { const int st = b / 1024, sb = b % 1024, swz = sb ^ (((sb >> 9) & 1) << 5); R = (st >> 1) * 16 + swz / 64; C = (st & 1) * 32 + (swz % 64) / 2; }
__host__ __device__ __forceinline__ int perm32(int rho) { const int n = rho >> 4, i = rho & 15; return 8 * (i >> 2) + 4 * n + (i & 3); }
struct Unit { int pm, pn; };
struct Gemm { const bf16_t* A; const bf16_t* Bt; int M, N, K, lda; };
struct StaticOrder {
    int nM, nN, nwg, G, c;
    __host__ __device__ void init(int M, int N, int G_, int c_) { nM = M / BM; nN = N / BM; nwg = nM * nN; G = G_; c = c_; }
    __host__ __device__ bool next(int i, Unit& u) const {
        const long L = (long)i * G + c; if (L >= nwg) return false;
        int wgid = (int)L; { const int q = nwg / NXCD, r = nwg % NXCD, xcd = wgid % NXCD, off = wgid / NXCD; wgid = (xcd < r ? xcd * (q + 1) : r * (q + 1) + (xcd - r) * q) + off; }
        const int nig = WGM * nN, gid = wgid / nig, fm = gid * WGM, gsz = (nM - fm) < WGM ? (nM - fm) : WGM;
        u.pm = fm + ((wgid % nig) % gsz); u.pn = (wgid % nig) / gsz; return true;
    }
    __device__ __forceinline__ void a_ready(const Unit&) const {}
    __device__ __forceinline__ void done(const Unit&) const {}
};
struct TailOrder {
    int c, pn;
    __host__ __device__ bool next(int i, Unit& u) const { if (i > 0 || c >= 64) return false; u.pm = c; u.pn = pn; return true; }
    __device__ __forceinline__ void a_ready(const Unit&) const {}
    __device__ __forceinline__ void done(const Unit&) const {}
};
template <int FIRST4, int CNT4> __device__ __forceinline__ float row_rs(const float* part, int row, int fq, int lane, float inv_dim) {
    const f32x4* p = (const f32x4*)(part + (size_t)row * 32) + FIRST4; float s = 0.f;
#pragma unroll
    for (int i = 0; i < (CNT4 + 3) / 4; ++i) { const int k = fq + 4 * i; if (k < CNT4) { const f32x4 v = p[k]; s += (v[0] + v[1]) + (v[2] + v[3]); } }
    s += shflx(s, lane, 16); s += shflx(s, lane, 32);
    return __builtin_amdgcn_rsqf(s * inv_dim + EPS);
}
template <int MODE> struct EpiScale {
    static constexpr bool PERM = true, AFTER_DRAIN = false;
    bf16_t* O; int ldc; const float* part; float* part_out; bf16_t* kr; const float* cosT; const float* sinT;
    __device__ __forceinline__ void operator()(const f32x4 (&acc)[2][2][4][2], const Unit& u, int wr, int wc, int fr, int fq) const {
        const int row0 = u.pm * BM + wr * 64 + fr; const int col0 = u.pn * BM + wc * 32 + 8 * fq;
#pragma unroll
        for (int ai = 0; ai < 2; ++ai)
#pragma unroll
            for (int m = 0; m < 4; ++m) {
                const int row = row0 + ai * HALF + m * 16;
                float rs;
                if (MODE == 0 || MODE == 1 || MODE == 2) rs = row_rs<0, 8>(part, row, fq, fr + 16 * fq, 1.0f / 2048.0f);
                else if (MODE == 3) rs = row_rs<0, 3>(part, row, fq, fr + 16 * fq, 1.0f / 768.0f);
                else rs = row_rs<3, 2>(part, row, fq, fr + 16 * fq, 1.0f / 512.0f);
                bf16_t* rowp = O + (size_t)row * ldc + col0;
                float ss = 0.f;
#pragma unroll
                for (int bj = 0; bj < 2; ++bj) {
                    f32x4 v0 = acc[ai][bj][m][0] * rs, v1 = acc[ai][bj][m][1] * rs;
                    const int col = col0 + bj * HALF;
                    if (MODE == 1) {
#pragma unroll
                        for (int e = 0; e < 4; ++e) { float a = fmaxf(v0[e], 0.f), b = fmaxf(v1[e], 0.f); v0[e] = a * a; v1[e] = b * b; }
                    }
                    if (MODE == 2) {
#pragma unroll
                        for (int e = 0; e < 4; ++e) ss += v0[e] * v0[e] + v1[e] * v1[e];
                    }
                    bool rope = false; int ri = 0;
                    if (MODE == 2) { rope = (col >= 1280 && col < 1344); ri = (col - 1280) >> 1; }
                    if (MODE == 3) { const int j = col % 192; rope = j >= 128; ri = (j - 128) >> 1; }
                    if ((MODE == 2 || MODE == 3) && rope) {
                        const int s = row & (SEQ - 1);
                        const f32x4 cs = *(const f32x4*)(cosT + s * 32 + ri), sn = *(const f32x4*)(sinT + s * 32 + ri);
                        f32x4 w0, w1;
                        w0[0] = v0[0] * cs[0] - v0[1] * sn[0]; w0[1] = v0[1] * cs[0] + v0[0] * sn[0];
                        w0[2] = v0[2] * cs[1] - v0[3] * sn[1]; w0[3] = v0[3] * cs[1] + v0[2] * sn[1];
                        w1[0] = v1[0] * cs[2] - v1[1] * sn[2]; w1[1] = v1[1] * cs[2] + v1[0] * sn[2];
                        w1[2] = v1[2] * cs[3] - v1[3] * sn[3]; w1[3] = v1[3] * cs[3] + v1[2] * sn[3];
                        v0 = w0; v1 = w1;
                    }
                    u32x4 w; w.x = pk2(v0[0], v0[1]); w.y = pk2(v0[2], v0[3]); w.z = pk2(v1[0], v1[1]); w.w = pk2(v1[2], v1[3]);
                    if (MODE == 2 && rope) *(u32x4*)(kr + (size_t)row * 64 + (col - 1280)) = w;
                    *(u32x4*)(rowp + bj * HALF) = w;
                }
                if (MODE == 2) {
                    ss += shflx(ss, fr + 16 * fq, 16); ss += shflx(ss, fr + 16 * fq, 32);
                    if (fq == 0) part_out[(size_t)row * 32 + u.pn * 4 + wc] = ss;
                }
                asm volatile("" ::: "memory");
            }
    }
};
template <bool LAST> struct EpiResidual {
    static constexpr bool PERM = false, AFTER_DRAIN = false;
    const float* base; float* out; bf16_t* xb; float* part_out;
    __device__ __forceinline__ void operator()(const f32x4 (&acc)[2][2][4][2], const Unit& u, int wr, int wc, int fr, int fq) const {
        const int row0 = u.pm * BM + wr * 64 + fr; const int col0 = u.pn * BM + wc * 32 + 4 * fq;
#pragma unroll
        for (int ai = 0; ai < 2; ++ai)
#pragma unroll
            for (int m = 0; m < 4; ++m) {
                const int row = row0 + ai * HALF + m * 16; const size_t off = (size_t)row * DM + col0; float ss = 0.f;
#pragma unroll
                for (int bj = 0; bj < 2; ++bj)
#pragma unroll
                    for (int n = 0; n < 2; ++n) {
                        const size_t o = off + bj * HALF + n * 16;
                        const f32x4 v = *(const f32x4*)(base + o) + acc[ai][bj][m][n];
                        if (!LAST) *(f32x4*)(out + o) = v;
                        u32x2 w; w.x = pk2(v[0], v[1]); w.y = pk2(v[2], v[3]); *(u32x2*)(xb + o) = w;
                        ss += (v[0] * v[0] + v[1] * v[1]) + (v[2] * v[2] + v[3] * v[3]);
                    }
                ss += shflx(ss, fr + 16 * fq, 16); ss += shflx(ss, fr + 16 * fq, 32);
                if (fq == 0) part_out[(size_t)row * 32 + u.pn * 4 + wc] = ss;
                asm volatile("" ::: "memory");
            }
    }
};
template <class Epi, class Sched, bool ALIGN_EPI = false, bool SP2 = false>
__device__ __forceinline__ void gemm_phase(PG8_LAS unsigned char* lds, const Gemm g, const Sched& S, const Epi& E, const int wid_in) {
    const int lane_ = fresh_lane();
    const int wid = wid_in, lane = lane_, tid = wid * 64 + lane, wr = wid >> 2, wc = wid & 3, fr = lane & 15, fq = lane >> 4;
    const int K = g.K, nt = K / BK;
    unsigned voffA[2], voffB[2];
#pragma unroll
    for (int i = 0; i < 2; ++i) { int R, C; stage_rc(tid * 16 + i * 8192, R, C); const int Rb = Epi::PERM ? ((R & ~31) + perm32(R & 31)) : R;
        voffA[i] = (unsigned)(R * g.lda + C) * 2u; voffB[i] = (unsigned)(Rb * K + C) * 2u; }
    const size_t kstep = (size_t)(BK * 2);
    const size_t hstep = (size_t)HALF * K * 2;
    const size_t tstep = 2 * hstep; const size_t hstepA = (size_t)HALF * g.lda * 2, tstepA = 2 * hstepA;
    const unsigned ldsw = (unsigned)wid * 1024u;
    const int aoff = lds_byte(wr * 64 + fr, fq * 8), boff = lds_byte(wc * 32 + fr, fq * 8);
#define PG8_SA(b, h) (((b) * 2 + (h)) * HTB)
#define PG8_SB(b, h) ((4 + (b) * 2 + (h)) * HTB)
#define PG8_STAGE(bufoff, gbase, voff) do { _Pragma("unroll") for (int _i = 0; _i < 2; ++_i) \
        __builtin_amdgcn_global_load_lds((const unsigned*)((const char*)(gbase) + (voff)[_i]), (PG8_LAS unsigned*)(lds + (bufoff) + ldsw + _i * 8192), 16, 0, 0); } while (0)
#define PG8_LDA(dst, b, h) do { _Pragma("unroll") for (int m = 0; m < 4; ++m) _Pragma("unroll") for (int k = 0; k < 2; ++k) dst[m][k] = *(const PG8_LAS bf16x8*)(lds + PG8_SA(b, h) + aoff + m * 2048 + k * 1024); } while (0)
#define PG8_LDB(dst, b, h) do { _Pragma("unroll") for (int n = 0; n < 2; ++n) _Pragma("unroll") for (int k = 0; k < 2; ++k) dst[n][k] = *(const PG8_LAS bf16x8*)(lds + PG8_SB(b, h) + boff + n * 2048 + k * 1024); } while (0)
#define PG8_MMA(ai, bj, At, Bt) do { __builtin_amdgcn_s_setprio(1); _Pragma("unroll") for (int m = 0; m < 4; ++m) _Pragma("unroll") for (int n = 0; n < 2; ++n) _Pragma("unroll") for (int k = 0; k < 2; ++k) \
        acc[ai][bj][m][n] = __builtin_amdgcn_mfma_f32_16x16x32_bf16(Bt[n][k], At[m][k], acc[ai][bj][m][n], 0, 0, 0); __builtin_amdgcn_s_setprio(0); } while (0)
#define PG8_WAIT_V(n) asm volatile("s_waitcnt vmcnt(" #n ")" ::: "memory")
#define PG8_WAIT_L(n) asm volatile("s_waitcnt lgkmcnt(" #n ")" ::: "memory")
#define PG8_BAR __builtin_amdgcn_s_barrier()
#define PG8_SCHED __builtin_amdgcn_sched_barrier(0)
    Unit cur, nxt; int ui = 0;
    if (!S.next(0, cur)) return;
    f32x4 acc[2][2][4][2];
#pragma unroll
    for (int a = 0; a < 2; ++a)
#pragma unroll
        for (int b = 0; b < 2; ++b)
#pragma unroll
            for (int m = 0; m < 4; ++m)
#pragma unroll
                for (int n = 0; n < 2; ++n) acc[a][b][m][n] = (f32x4){0.f, 0.f, 0.f, 0.f};
    bf16x8 At[4][2], B0[2][2], B1[2][2];
    const char* cA = (const char*)g.A + (size_t)cur.pm * tstepA; const char* cB = (const char*)g.Bt + (size_t)cur.pn * tstep;
    S.a_ready(cur);
    if constexpr (SP2) {
        PG8_STAGE(PG8_SB(0, 0), cB, voffB); PG8_STAGE(PG8_SB(0, 1), cB + hstep, voffB); PG8_STAGE(PG8_SA(0, 0), cA, voffA); PG8_STAGE(PG8_SA(0, 1), cA + hstepA, voffA);
        if (wr == 1) PG8_BAR;
        PG8_WAIT_V(2); PG8_BAR;
        PG8_STAGE(PG8_SB(1, 0), cB + kstep, voffB); PG8_STAGE(PG8_SA(1, 0), cA + kstep, voffA); PG8_STAGE(PG8_SB(1, 1), cB + hstep + kstep, voffB);
        PG8_WAIT_V(6); PG8_BAR;
    } else {
        PG8_STAGE(PG8_SB(0, 0), cB, voffB); PG8_STAGE(PG8_SA(0, 0), cA, voffA); PG8_STAGE(PG8_SB(0, 1), cB + hstep, voffB); PG8_STAGE(PG8_SA(0, 1), cA + hstepA, voffA);
        if (wr == 1) PG8_BAR;
        PG8_WAIT_V(4); PG8_BAR;
        PG8_STAGE(PG8_SB(1, 0), cB + kstep, voffB); PG8_STAGE(PG8_SA(1, 0), cA + kstep, voffA); PG8_STAGE(PG8_SB(1, 1), cB + hstep + kstep, voffB);
        PG8_WAIT_V(6); PG8_BAR;
    }
    for (;;) {
        const bool has_next = S.next(ui + 1, nxt);
        const char* nA = has_next ? (const char*)g.A + (size_t)nxt.pm * tstepA : cA; const char* nB = has_next ? (const char*)g.Bt + (size_t)nxt.pn * tstep : cB;
        for (int t = 0; t < nt; t += 2) {
            const bool last = (t == nt - 2);
            const char* a1 = cA + (size_t)(t + 1) * kstep;
            const char* a2 = last ? nA : cA + (size_t)(t + 2) * kstep; const char* b2 = last ? nB : cB + (size_t)(t + 2) * kstep;
            const char* a3 = a2 + kstep; const char* b3 = b2 + kstep;
            if (last && has_next) S.a_ready(nxt);
            if constexpr (SP2) {
            PG8_LDB(B0, 0, 0); PG8_LDB(B1, 0, 1); PG8_SCHED; PG8_LDA(At, 0, 0); PG8_STAGE(PG8_SA(1, 1), a1 + hstepA, voffA);
            PG8_WAIT_V(8); PG8_WAIT_L(0); PG8_BAR; PG8_MMA(0, 0, At, B0); PG8_MMA(0, 1, At, B1); PG8_BAR; PG8_SCHED;
            PG8_LDA(At, 0, 1); PG8_STAGE(PG8_SB(0, 0), b2, voffB); PG8_STAGE(PG8_SB(0, 1), b2 + hstep, voffB); PG8_STAGE(PG8_SA(0, 0), a2, voffA);
            PG8_WAIT_V(8); PG8_WAIT_L(0); PG8_BAR; PG8_MMA(1, 0, At, B0); PG8_MMA(1, 1, At, B1); PG8_BAR; PG8_SCHED;
            PG8_LDB(B0, 1, 0); PG8_LDB(B1, 1, 1); PG8_SCHED; PG8_LDA(At, 1, 0); PG8_STAGE(PG8_SA(0, 1), a2 + hstepA, voffA);
            PG8_WAIT_V(8); PG8_WAIT_L(0); PG8_BAR; PG8_MMA(0, 0, At, B0); PG8_MMA(0, 1, At, B1); PG8_BAR; PG8_SCHED;
            PG8_LDA(At, 1, 1); PG8_STAGE(PG8_SB(1, 0), b3, voffB); PG8_STAGE(PG8_SB(1, 1), b3 + hstep, voffB); PG8_STAGE(PG8_SA(1, 0), a3, voffA);
            PG8_WAIT_V(8); PG8_WAIT_L(0); PG8_BAR; PG8_MMA(1, 0, At, B0); PG8_MMA(1, 1, At, B1); PG8_BAR; PG8_SCHED;
            } else {
            PG8_LDB(B0, 0, 0); PG8_SCHED; PG8_LDA(At, 0, 0); PG8_STAGE(PG8_SA(1, 1), a1 + hstepA, voffA);
            PG8_WAIT_L(8); PG8_BAR; PG8_WAIT_L(0); PG8_MMA(0, 0, At, B0); PG8_BAR; PG8_SCHED;
            PG8_LDB(B1, 0, 1); PG8_STAGE(PG8_SB(0, 0), b2, voffB);
            PG8_BAR; PG8_WAIT_L(0); PG8_MMA(0, 1, At, B1); PG8_BAR;
            PG8_LDA(At, 0, 1); PG8_STAGE(PG8_SA(0, 0), a2, voffA);
            PG8_BAR; PG8_WAIT_L(0); PG8_MMA(1, 0, At, B0); PG8_BAR; PG8_SCHED;
            PG8_STAGE(PG8_SB(0, 1), b2 + hstep, voffB);
            PG8_WAIT_V(6); PG8_BAR; PG8_MMA(1, 1, At, B1); PG8_BAR;
            PG8_LDB(B0, 1, 0); PG8_SCHED; PG8_LDA(At, 1, 0); PG8_STAGE(PG8_SA(0, 1), a2 + hstepA, voffA);
            PG8_WAIT_L(8); PG8_BAR; PG8_WAIT_L(0); PG8_MMA(0, 0, At, B0); PG8_BAR; PG8_SCHED;
            PG8_LDB(B1, 1, 1); PG8_STAGE(PG8_SB(1, 0), b3, voffB);
            PG8_BAR; PG8_WAIT_L(0); PG8_MMA(0, 1, At, B1); PG8_BAR;
            PG8_LDA(At, 1, 1); PG8_STAGE(PG8_SA(1, 0), a3, voffA);
            PG8_BAR; PG8_WAIT_L(0); PG8_MMA(1, 0, At, B0); PG8_BAR; PG8_SCHED;
            PG8_STAGE(PG8_SB(1, 1), b3 + hstep, voffB);
            PG8_WAIT_V(6); PG8_BAR; PG8_MMA(1, 1, At, B1); PG8_BAR;
            }
        }
        if constexpr (ALIGN_EPI) { if (wr == 0) PG8_BAR; }
        if constexpr (!Epi::AFTER_DRAIN) { E(acc, cur, wr, wc, fr, fq); S.done(cur); }
        if (!has_next) break;
#pragma unroll
        for (int a = 0; a < 2; ++a)
#pragma unroll
            for (int b = 0; b < 2; ++b)
#pragma unroll
                for (int m = 0; m < 4; ++m)
#pragma unroll
                    for (int n = 0; n < 2; ++n) acc[a][b][m][n] = (f32x4){0.f, 0.f, 0.f, 0.f};
        cur = nxt; cA = nA; cB = nB; ++ui;
        if constexpr (ALIGN_EPI) { if (wr == 1) PG8_BAR; }
    }
    PG8_WAIT_V(0);
    if constexpr (!ALIGN_EPI) { if (wr == 0) PG8_BAR; }
    PG8_BAR;
    if constexpr (Epi::AFTER_DRAIN) { E.fused(acc, cur, wr, wc, fr, fq, lds, wid, lane); S.done(cur); }
#undef PG8_SA
#undef PG8_SB
#undef PG8_STAGE
#undef PG8_LDA
#undef PG8_LDB
#undef PG8_MMA
#undef PG8_WAIT_V
#undef PG8_WAIT_L
#undef PG8_BAR
#undef PG8_SCHED
}
}

#define MFMA32(a, b, c) __builtin_amdgcn_mfma_f32_32x32x16_bf16((a), (b), (c), 0, 0, 0)
DI int crow(int reg, int h) { return (reg & 3) + 8 * (reg >> 2) + 4 * h; }
DI float fexp2(float x) { return __builtin_amdgcn_exp2f(x); }
DI bf16x8 pack8(const f32x16& x, int s) {
    u32x4 p; p.x = pk2(x[8 * s + 0], x[8 * s + 1]); p.y = pk2(x[8 * s + 2], x[8 * s + 3]); p.z = pk2(x[8 * s + 4], x[8 * s + 5]); p.w = pk2(x[8 * s + 6], x[8 * s + 7]);
    return __builtin_bit_cast(bf16x8, p);
}
DI bf16x8 tr_pair(LAS const unsigned char* p0, LAS const unsigned char* p1) {
    const s16x4 lo = __builtin_amdgcn_ds_read_tr16_b64_v4i16((LAS s16x4*)p0);
    const s16x4 hi = __builtin_amdgcn_ds_read_tr16_b64_v4i16((LAS s16x4*)p1);
    return __builtin_shufflevector(lo, hi, 0, 1, 2, 3, 4, 5, 6, 7);
}
template <int DQK, int KSTR> DI f32x16 st_block(const bf16x8 (&qf)[DQK / 16], LAS const unsigned char* Kt, int kb, int r, int h) {
    f32x16 s;
#pragma unroll
    for (int i = 0; i < 16; ++i) s[i] = 0.f;
    LAS const unsigned char* kp = Kt + (32 * kb + r) * KSTR + 16 * h;
#pragma unroll
    for (int kk = 0; kk < DQK / 16; ++kk) { const bf16x8 kf = *(LAS const bf16x8*)(kp + 32 * kk); s = MFMA32(kf, qf[kk], s); }
    return s;
}
template <int DV, int VSTR> DI void pv_block(f32x16 (&o)[DV / 32], const f32x16& p, LAS const unsigned char* Vt, int kb, int vlane) {
#pragma unroll
    for (int st = 0; st < 2; ++st) {
        const bf16x8 pf = pack8(p, st);
        LAS const unsigned char* vp = Vt + vlane + (32 * kb + 16 * st) * VSTR;
#pragma unroll
        for (int db = 0; db < DV / 32; ++db) { const bf16x8 vf = tr_pair(vp + 64 * db, vp + 8 * VSTR + 64 * db); o[db] = MFMA32(vf, pf, o[db]); }
    }
}
#define SCHED_FENCE() __builtin_amdgcn_sched_barrier(0)
#ifndef TC_CUT
#define TC_CUT 0
#endif
template <int DQK, int DV, int KSTR, int VSTR, bool PLAINB, class Fix, bool CUTOK = false>
DI void tile_compute(const bf16x8 (&qf)[DQK / 16], LAS const unsigned char* Kt, LAS const unsigned char* Vt, f32x16 (&o)[DV / 32], float& m, float& l, int r, int h, int vlane, const Fix& fix, const bool plain, const float pb) {
    constexpr int NKK = DQK / 16, KC = 2, NCH = NKK / KC, NDB = DV / 32;
    static_assert(NKK % KC == 0, "chunking");
    f32x16 s0, s1;
#pragma unroll
    for (int i = 0; i < 16; ++i) { s0[i] = 0.f; s1[i] = 0.f; }
    LAS const unsigned char* kp = Kt + r * KSTR + 16 * h;
    bf16x8 ka[2][KC], kb[2][KC];
#pragma unroll
    for (int kk = 0; kk < KC; ++kk) { ka[0][kk] = *(LAS const bf16x8*)(kp + 32 * kk); kb[0][kk] = *(LAS const bf16x8*)(kp + 32 * KSTR + 32 * kk); }
#pragma unroll
    for (int c = 0; c < NCH; ++c) {
        if (c + 1 < NCH) {
#pragma unroll
            for (int kk = 0; kk < KC; ++kk) { ka[(c + 1) & 1][kk] = *(LAS const bf16x8*)(kp + 32 * ((c + 1) * KC + kk)); kb[(c + 1) & 1][kk] = *(LAS const bf16x8*)(kp + 32 * KSTR + 32 * ((c + 1) * KC + kk)); }
        }
        SCHED_FENCE();
#pragma unroll
        for (int kk = 0; kk < KC; ++kk) { s0 = MFMA32(ka[c & 1][kk], qf[c * KC + kk], s0); s1 = MFMA32(kb[c & 1][kk], qf[c * KC + kk], s1); }
        SCHED_FENCE();
    }
    if (TC_CUT == 1 && CUTOK) { o[0] = o[0] + s0 + s1; return; }
    bf16x8 vf[2][NDB];
    LAS const unsigned char* vp = Vt + vlane;
#pragma unroll
    for (int db = 0; db < NDB; ++db) vf[0][db] = tr_pair(vp + 64 * db, vp + 8 * VSTR + 64 * db);
    if (plain) {
        if (PLAINB) {
#pragma unroll
            for (int i = 0; i < 16; ++i) { s0[i] += pb; s1[i] += pb; }
        }
    } else {
#pragma unroll
        for (int i = 0; i < 16; ++i) { s0[i] = fix(s0[i], crow(i, h)); s1[i] = fix(s1[i], 32 + crow(i, h)); }
    }
    float mx = NEGBIG;
#pragma unroll
    for (int i = 0; i < 16; ++i) mx = fmaxf(mx, fmaxf(s0[i], s1[i]));
    mx = fmaxf(mx, shflx(mx, r + 32 * h, 32));
    const float m_old = m, mn = fmaxf(m, mx), alpha = fexp2(m - mn);
    float rs = 0.f;
#pragma unroll
    for (int i = 0; i < 16; ++i) { s0[i] = fexp2(s0[i] - mn); s1[i] = fexp2(s1[i] - mn); rs += s0[i] + s1[i]; }
    rs += shflx(rs, r + 32 * h, 32);
    l = l * alpha + rs; m = mn;
    if (TC_CUT == 2 && CUTOK) { o[0] = o[0] + s0 + s1; return; }
    if (__any(mx > m_old)) {
#pragma unroll
        for (int db = 0; db < NDB; ++db) o[db] = o[db] * alpha;
    }
    SCHED_FENCE();
#pragma unroll
    for (int step = 0; step < 4; ++step) {
        if (step < 3) {
            LAS const unsigned char* vq = vp + (16 * (step + 1)) * VSTR;
#pragma unroll
            for (int db = 0; db < NDB; ++db) vf[(step + 1) & 1][db] = tr_pair(vq + 64 * db, vq + 8 * VSTR + 64 * db);
        }
        const bf16x8 pf = pack8((step >> 1) ? s1 : s0, step & 1);
        SCHED_FENCE();
#pragma unroll
        for (int db = 0; db < NDB; ++db) o[db] = MFMA32(vf[step & 1][db], pf, o[db]);
        SCHED_FENCE();
    }
}

constexpr int L0_KSTR = 144, L0_VSTR = 192, L0_KSZ = 64 * L0_KSTR, L0_BUF = L0_KSZ + 64 * L0_VSTR;
constexpr int OFIN_OFF = 2 * L0_BUF, MISC_OFF = 110592, BT_OFF = MISC_OFF, PSUM_OFF = MISC_OFF + 4096, PSLC_OFF = PSUM_OFF + 16384, SEL_OFF = PSLC_OFF + 32 * 33 * 4, SLOT_OFF = SEL_OFF + 128;
constexpr int LDS_BYTES = 139264;
static_assert(OFIN_OFF + 65536 <= MISC_OFF && SLOT_OFF + 4 <= LDS_BYTES - 16 && 8 * 16640 - 768 <= LDS_BYTES - 16, "LDS map");
struct KVSrc { const bf16_t* k; const bf16_t* v; int stride; };

template <int MODE> struct Fix0 {
    int tq, kpos0, W; LAS const float* bt; bool far, selbit; float bfar;
    DI float operator()(float s, int kl) const {
        if (MODE == 2) { const int c = kpos0 + kl, cd = tq - (16 * c + 31); const bool ok = cd >= 0 && c < 127; const int dd = cd < 0 ? 0 : (cd > 127 ? 127 : cd); return ok ? s + bt[dd] : NEGBIG; }
        const int dist = tq - (kpos0 + kl);
        const bool ok = MODE == 0 ? ((unsigned)dist < (unsigned)W) : (selbit && dist >= 0);
        float b = bfar; if (!far) { const int dd = dist < 0 ? 0 : (dist > 127 ? 127 : dist); b = bt[dd]; }
        return ok ? s + b : NEGBIG;
    }
};
struct FixPlain { float b; DI float operator()(float s, int) const { return s + b; } };
struct FixNone { DI float operator()(float s, int) const { return s; } };
DI u32x4 ldg16(const bf16_t* p) { return *(const u32x4*)p; }
template <int MODE> DI void l0_run(unsigned tiles, const KVSrc src, LAS unsigned char* lds, const bf16x8 (&qf)[4], f32x16 (&o)[2], float& m, float& l,
                                   int tq, int t0, int W, unsigned selmask, LAS const float* bt, int tid, int r, int h, int vlane) {
    if (tiles == 0u) return;
    const int lrow = tid >> 3, lch = tid & 7; const unsigned goff = (unsigned)(lrow * src.stride + lch * 8) * 2u;
#define L0_LD(base, j) (*(const u32x4*)((const char*)((base) + (size_t)(64 * (j)) * src.stride) + goff))
    int jn = __builtin_ctz(tiles); tiles &= tiles - 1;
    {
        const u32x4 kreg = L0_LD(src.k, jn), vreg = L0_LD(src.v, jn);
        *(LAS u32x4*)(lds + lrow * L0_KSTR + lch * 16) = kreg; *(LAS u32x4*)(lds + L0_KSZ + lrow * L0_VSTR + lch * 16) = vreg;
    }
    __syncthreads();
    int buf = 0;
    for (;;) {
        const int j = jn; const bool more = tiles != 0u;
        u32x4 kreg, vreg;
        if (more) { jn = __builtin_ctz(tiles); tiles &= tiles - 1;
            kreg = L0_LD(src.k, jn); vreg = L0_LD(src.v, jn); }
        Fix0<MODE> fx; fx.tq = tq; fx.kpos0 = 64 * j; fx.W = W; fx.bt = bt; fx.bfar = bt[127];
        fx.far = (MODE != 2) && (t0 - (64 * j + 63) >= 113); fx.selbit = (selmask >> j) & 1u;
        LAS unsigned char* B = lds + buf * L0_BUF;
        bool plain = false;
        if (MODE == 0) plain = fx.far && (t0 + 31 - 64 * j < W);
        if (MODE == 1) plain = fx.far && __all(fx.selbit);
        tile_compute<64, 64, L0_KSTR, L0_VSTR, true>(qf, B, B + L0_KSZ, o, m, l, r, h, vlane, fx, plain, fx.bfar);
        if (more) { LAS unsigned char* Bn = lds + (buf ^ 1) * L0_BUF; *(LAS u32x4*)(Bn + lrow * L0_KSTR + lch * 16) = kreg; *(LAS u32x4*)(Bn + L0_KSZ + lrow * L0_VSTR + lch * 16) = vreg; }
        __syncthreads();
        if (!more) break;
        buf ^= 1;
    }
#undef L0_LD
}
DI int next_item(unsigned* ctr, LAS int* slot, int wave) {
    __syncthreads();
    if (wave == 0 && fresh_lane() == 0) *slot = (int)atomicAdd(ctr, 1u);
    __syncthreads();
    return *slot;
}
DI unsigned band_mask(int t0, int W) { const int lo = (t0 - W + 1 < 0 ? 0 : t0 - W + 1) >> 6, hi = (t0 + 31) >> 6; return (hi == 31 ? 0xffffffffu : ((1u << (hi + 1)) - 1u)) & ~((1u << lo) - 1u); }
template <int NDB> DI void store_o(const f32x16 (&o)[NDB], bf16_t* orow, int h) {
#pragma unroll
    for (int db = 0; db < NDB; ++db)
#pragma unroll
        for (int g = 0; g < 4; ++g) { u32x2 w; w.x = pk2(o[db][4 * g], o[db][4 * g + 1]); w.y = pk2(o[db][4 * g + 2], o[db][4 * g + 3]); *(u32x2*)(orow + 32 * db + 8 * g + 4 * h) = w; }
}

struct Ptrs {
    const float* in[23]; float* out; unsigned char* ws;
};
DI float sigmoidf_(float x) { return 1.0f / (1.0f + __expf(-x)); }

DI void mixerA_item(int item, unsigned char* ws, const float* sinks, LAS unsigned char* lds, int tid, int wave, int lane) {
    lane = fresh_lane(); tid = wave * 64 + lane;
    const int tt = item & 63, bg = item >> 6, b = bg >> 1, g = bg & 1, t0 = 32 * tt, hq = g * 8 + wave, r = lane & 31, h = lane >> 5, tq = t0 + r;
    const bf16_t* P0 = (const bf16_t*)(ws + WS_P0); const float* biasT = (const float*)(ws + WS_BIAS);
    LAS float* bt = (LAS float*)(lds + BT_OFF) + wave * 128; bt[lane] = biasT[hq * 128 + lane]; bt[lane + 64] = biasT[hq * 128 + lane + 64];
    const int i16 = lane & 15, vlane = ((i16 >> 2) + 4 * h) * L0_VSTR + 32 * ((lane >> 4) & 1) + 8 * (i16 & 3);
    const size_t rowb = (size_t)(b * SEQ + tq);
    bf16x8 qf[4];
#pragma unroll
    for (int kk = 0; kk < 4; ++kk) qf[kk] = __builtin_bit_cast(bf16x8, ldg16(P0 + rowb * EINP + hq * 64 + 16 * kk + 8 * h));
    f32x16 o[2];
#pragma unroll
    for (int i = 0; i < 16; ++i) { o[0][i] = 0.f; o[1][i] = 0.f; }
    float m = sinks[hq] * LOG2E, l = 1.0f;
    KVSrc src; src.k = P0 + (size_t)b * SEQ * EINP + 1024 + g * 64; src.v = P0 + (size_t)b * SEQ * EINP + 1152 + g * 64; src.stride = EINP;
    l0_run<0>(band_mask(t0, 128), src, lds, qf, o, m, l, tq, t0, 128, 0u, bt, tid, r, h, vlane);
    const float inv = 1.0f / l; o[0] = o[0] * inv; o[1] = o[1] * inv;
    store_o<2>(o, (bf16_t*)(ws + WS_OB0) + rowb * DM + hq * 64, h);
}

DI void mixerB_item(int item, unsigned char* ws, LAS unsigned char* lds, int tid, int wave, int lane) {
    lane = fresh_lane(); tid = wave * 64 + lane;
    const int tt = 63 - (item >> 4), bg = item & 15, b = bg >> 1, g = bg & 1, t0 = 32 * tt, hq = g * 8 + wave, r = lane & 31, h = lane >> 5, tq = t0 + r;
    const bf16_t* P0 = (const bf16_t*)(ws + WS_P0); const float* biasT = (const float*)(ws + WS_BIAS);
    LAS float* bt = (LAS float*)(lds + BT_OFF) + wave * 128; bt[lane] = biasT[(16 + hq) * 128 + lane]; bt[lane + 64] = biasT[(16 + hq) * 128 + lane + 64];
    LAS unsigned* psum = (LAS unsigned*)(lds + PSUM_OFF); LAS unsigned* pslc = (LAS unsigned*)(lds + PSLC_OFF); LAS unsigned* sel = (LAS unsigned*)(lds + SEL_OFF);
    for (int i = tid; i < 4096; i += NTHR) psum[i] = 0u;
    const int i16 = lane & 15, vlane = ((i16 >> 2) + 4 * h) * L0_VSTR + 32 * ((lane >> 4) & 1) + 8 * (i16 & 3);
    const size_t rowb = (size_t)(b * SEQ + tq);
    bf16x8 qf[4];
#pragma unroll
    for (int kk = 0; kk < 4; ++kk) qf[kk] = __builtin_bit_cast(bf16x8, ldg16(P0 + rowb * EINP + 1280 + hq * 64 + 16 * kk + 8 * h));
    const bf16_t* gp = P0 + rowb * EINP + 3072 + hq * 3;
    f32x16 o[2];
    LAS float* OF = (LAS float*)(lds + OFIN_OFF) + tid;
    {
        const bf16_t* KC = (const bf16_t*)(ws + WS_KC); const bf16_t* VC = (const bf16_t*)(ws + WS_VC);
        const int lrow = tid >> 3, lch = tid & 7;
#pragma unroll
        for (int jt = 0; jt < 2; ++jt) {
            const size_t off = ((size_t)(b * 128 + 64 * jt + lrow) * 2 + g) * 64 + lch * 8;
            LAS unsigned char* B = lds + jt * L0_BUF;
            *(LAS u32x4*)(B + lrow * L0_KSTR + lch * 16) = ldg16(KC + off); *(LAS u32x4*)(B + L0_KSZ + lrow * L0_VSTR + lch * 16) = ldg16(VC + off);
        }
        __syncthreads();
#pragma unroll
        for (int i = 0; i < 16; ++i) { o[0][i] = 0.f; o[1][i] = 0.f; }
        float m = NEGBIG, l = 0.f;
        Fix0<2> fx; fx.tq = tq; fx.W = 0; fx.bt = bt; fx.far = false; fx.selbit = false; fx.bfar = 0.f;
        fx.kpos0 = 0;  tile_compute<64, 64, L0_KSTR, L0_VSTR, false>(qf, lds, lds + L0_KSZ, o, m, l, r, h, vlane, fx, false, 0.f);
        fx.kpos0 = 64; tile_compute<64, 64, L0_KSTR, L0_VSTR, false>(qf, lds + L0_BUF, lds + L0_BUF + L0_KSZ, o, m, l, r, h, vlane, fx, false, 0.f);
        const float inv = (tq >= 31 ? 1.0f : 0.0f) / l;
#pragma unroll 1
        for (int q = 0; q < 4; ++q) {
            f32x16 s = st_block<64, L0_KSTR>(qf, lds + (q >> 1) * L0_BUF, q & 1, r, h);
            fx.kpos0 = 64 * (q >> 1);
            LAS unsigned* pr = psum + r * 128 + 32 * q + 4 * h;
#pragma unroll
            for (int i = 0; i < 16; ++i) { const float p = fexp2(fx(s[i], 32 * (q & 1) + crow(i, h)) - m) * inv;
                __hip_atomic_fetch_add(pr + (i & 3) + 8 * (i >> 2), (unsigned)(p * 268435456.0f + 0.5f), __ATOMIC_RELAXED, __HIP_MEMORY_SCOPE_WORKGROUP); }
        }
        o[0] = o[0] * inv; o[1] = o[1] * inv;
        const float g0 = sigmoidf_(bf2f(gp[0]));
#pragma unroll
        for (int i = 0; i < 16; ++i) { OF[i * NTHR] = o[0][i] * g0; OF[(16 + i) * NTHR] = o[1][i] * g0; }
    }
    __syncthreads();
    {
        const int tok = tid >> 4, nn = tid & 15;
#pragma unroll
        for (int e = 0; e < 2; ++e) { const int n = nn + 16 * e; const int c0 = (4 * n - 1 < 0) ? 0 : 4 * n - 1, c1 = (4 * n + 3 > 126) ? 126 : 4 * n + 3; unsigned v = 0u;
            for (int c = c0; c <= c1; ++c) v += psum[tok * 128 + c];
            pslc[tok * 33 + n] = v; }
        __syncthreads();
        const int t = t0 + tok, cur = t >> 6, quota = 8 - (cur == 0 ? 1 : (cur == 1 ? 2 : 3));
        bool sb[2];
#pragma unroll
        for (int e = 0; e < 2; ++e) { const int n = nn + 16 * e;
            const bool forced = (n == 0) || (n == cur) || (n == cur - 1), cand = (n >= 1) && (n <= cur - 2);
            const unsigned v = pslc[tok * 33 + n]; int rank = 0;
            _Pragma("unroll 1") for (int n2 = 1; n2 <= cur - 2; ++n2) { const unsigned v2 = pslc[tok * 33 + n2]; rank += (v2 > v || (v2 == v && n2 < n)) ? 1 : 0; }
            sb[e] = forced || (cand && rank < quota); }
        const unsigned long long b0 = __ballot(sb[0]), b1 = __ballot(sb[1]);
        const int k = (lane >> 4);
        if (nn == 0) sel[tok] = (unsigned)((b0 >> (16 * k)) & 0xffffull) | ((unsigned)((b1 >> (16 * k)) & 0xffffull) << 16);
        __syncthreads();
    }
    const unsigned selm = sel[r];
    unsigned U = selm;
#pragma unroll
    for (int d = 1; d < 32; d <<= 1) U |= shflxu(U, lane, d);
    U = (unsigned)__builtin_amdgcn_readfirstlane((int)U);
    const size_t bbase = (size_t)b * SEQ * EINP;
    {
#pragma unroll
        for (int i = 0; i < 16; ++i) { o[0][i] = 0.f; o[1][i] = 0.f; }
        float m = NEGBIG, l = 0.f;
        KVSrc src; src.k = P0 + bbase + 2560 + g * 64; src.v = P0 + bbase + 2688 + g * 64; src.stride = EINP;
        l0_run<1>(U, src, lds, qf, o, m, l, tq, t0, 0, selm, bt, tid, r, h, vlane);
        const float sc = sigmoidf_(bf2f(gp[1])) / l;
#pragma unroll
        for (int i = 0; i < 16; ++i) { OF[i * NTHR] += o[0][i] * sc; OF[(16 + i) * NTHR] += o[1][i] * sc; }
    }
    {
#pragma unroll
        for (int i = 0; i < 16; ++i) { o[0][i] = 0.f; o[1][i] = 0.f; }
        float m = NEGBIG, l = 0.f;
        KVSrc src; src.k = P0 + bbase + 2816 + g * 64; src.v = P0 + bbase + 2944 + g * 64; src.stride = EINP;
        l0_run<0>(band_mask(t0, 512), src, lds, qf, o, m, l, tq, t0, 512, 0u, bt, tid, r, h, vlane);
        const float sc = sigmoidf_(bf2f(gp[2])) / l;
#pragma unroll
        for (int i = 0; i < 16; ++i) { o[0][i] = OF[i * NTHR] + o[0][i] * sc; o[1][i] = OF[(16 + i) * NTHR] + o[1][i] * sc; }
    }
    store_o<2>(o, (bf16_t*)(ws + WS_OB0) + rowb * DM + 1024 + hq * 64, h);
}

DI float gelu_tanh(float x) { const float u = 0.7978845608028654f * (x + 0.044715f * x * x * x); return 0.5f * x * (1.0f + tanhf(u)); }
DI void compress_item(int item, unsigned char* ws, const float* pos_k, const float* pos_v, LAS unsigned char* lds, int tid, int wave, int lane) {
    lane = fresh_lane(); tid = wave * 64 + lane;
    const int kv = item >> 6, rb = item & 63, r = lane & 31, h = lane >> 5;
    const bf16_t* P0 = (const bf16_t*)(ws + WS_P0);
    const float* pos = kv ? pos_v : pos_k;
    const bf16_t* w1t = (const bf16_t*)(ws + (kv ? WS_CW1V : WS_CW1K)); const bf16_t* w2t = (const bf16_t*)(ws + (kv ? WS_CW2V : WS_CW2K));
    bf16_t* dst = (bf16_t*)(ws + (kv ? WS_VC : WS_KC));
    int rho = 32 * rb + r; if (rho > 2031) rho = 2031;
    const int b = rho / 254, rem = rho % 254, c = rem >> 1, g = rem & 1;
    const bf16_t* src = P0 + (size_t)(b * SEQ + 16 * c) * EINP + (kv ? 2432 : 2304) + g * 64 + 8 * h;
    const bf16_t* wrow = w1t + (size_t)(32 * wave + r) * 2048 + 8 * h;
    const float* prow = pos + 8 * h;
    f32x16 acc;
#pragma unroll
    for (int i = 0; i < 16; ++i) acc[i] = 0.f;
#pragma unroll 4
    for (int kk = 0; kk < 128; ++kk) {
        const int l = kk >> 2, d = 16 * (kk & 3);
        const u32x4 a = ldg16(src + (size_t)l * EINP + d); const f32x4 p0 = *(const f32x4*)(prow + l * 64 + d), p1 = *(const f32x4*)(prow + l * 64 + d + 4);
        u32x4 aa; aa.x = pk2(bflo(a.x) + p0[0], bfhi(a.x) + p0[1]); aa.y = pk2(bflo(a.y) + p0[2], bfhi(a.y) + p0[3]);
        aa.z = pk2(bflo(a.z) + p1[0], bfhi(a.z) + p1[1]); aa.w = pk2(bflo(a.w) + p1[2], bfhi(a.w) + p1[3]);
        const bf16x8 bf = __builtin_bit_cast(bf16x8, ldg16(wrow + 16 * kk));
        acc = MFMA32(__builtin_bit_cast(bf16x8, aa), bf, acc);
    }
    LAS bf16_t* Hs = (LAS bf16_t*)lds;
#pragma unroll
    for (int i = 0; i < 16; ++i) { const float v = gelu_tanh(acc[i]); Hs[crow(i, h) * 264 + 32 * wave + r] = (bf16_t)(pk2(v, 0.f) & 0xffffu); }
    __syncthreads();
    if (wave < 2) {
        f32x16 a2;
#pragma unroll
        for (int i = 0; i < 16; ++i) a2[i] = 0.f;
#pragma unroll
        for (int kk = 0; kk < 16; ++kk) {
            const bf16x8 af = *(LAS const bf16x8*)(Hs + r * 264 + 16 * kk + 8 * h);
            const bf16x8 bf = __builtin_bit_cast(bf16x8, ldg16(w2t + (size_t)(32 * wave + r) * 256 + 16 * kk + 8 * h));
            a2 = MFMA32(af, bf, a2);
        }
#pragma unroll
        for (int i = 0; i < 16; ++i) { const int rr = 32 * rb + crow(i, h);
            if (rr < 2032) { const int b2 = rr / 254, rem2 = rr % 254; dst[((size_t)(b2 * 128 + (rem2 >> 1)) * 2 + (rem2 & 1)) * 64 + 32 * wave + r] = (bf16_t)(pk2(a2[i], 0.f) & 0xffffu); } }
    }
    __syncthreads();
}

constexpr int C_KSTR = 400, C_VSTR = 320, C_KSZ = 64 * C_KSTR, C_BUF = C_KSZ + 64 * C_VSTR;
struct FixC { int tq, kpos0; DI float operator()(float s, int kl) const { return (kpos0 + kl) <= tq ? s : NEGBIG; } };
template <int VAR> DI void mla_item(int item, unsigned char* ws, LAS unsigned char* lds, int tid, int wave, int lane) {
    lane = fresh_lane(); tid = wave * 64 + lane;
    const int qb = 7 - (item >> 7), bh = item & 127, b = bh >> 4, hh = bh & 15, r = lane & 31, h = lane >> 5, tq = qb * 256 + 32 * wave + r;
    const bf16_t* Q1 = (const bf16_t*)(ws + WS_Q1); const bf16_t* KV1 = (const bf16_t*)(ws + WS_KV1); const bf16_t* KR = (const bf16_t*)(ws + WS_KR);
    const int i16 = lane & 15, vlane = ((i16 >> 2) + 4 * h) * C_VSTR + 32 * ((lane >> 4) & 1) + 8 * (i16 & 3);
    const size_t rowb = (size_t)(b * SEQ + tq);
    bf16x8 qf[12];
#pragma unroll
    for (int kk = 0; kk < 12; ++kk) qf[kk] = __builtin_bit_cast(bf16x8, ldg16(Q1 + rowb * QUP + hh * 192 + 16 * kk + 8 * h));
    f32x16 o[4];
#pragma unroll
    for (int d = 0; d < 4; ++d)
#pragma unroll
        for (int i = 0; i < 16; ++i) o[d][i] = 0.f;
    float m = NEGBIG, l = 0.f;
    const int ntile = 4 * qb + 4;
    const bf16_t* kvb = KV1 + (size_t)b * SEQ * KVUP + hh * 256; const bf16_t* krb = KR + (size_t)b * SEQ * 64;
    const int vrow0 = tid >> 4, vch = tid & 15, rrow = tid >> 3, rch = tid & 7;
    const unsigned kvoff = (unsigned)(vrow0 * KVUP + vch * 8) * 2u, kroff = (unsigned)(rrow * 64 + rch * 8) * 2u;
    u32x4 kreg[3], vreg[2];
#define MLA_LOAD(j) do { const char* tb_ = (const char*)(kvb + (size_t)(64 * (j)) * KVUP); const char* rb_ = (const char*)(krb + (size_t)(64 * (j)) * 64); \
        kreg[0] = *(const u32x4*)(tb_ + kvoff); kreg[1] = *(const u32x4*)(tb_ + kvoff + 32u * KVUP * 2u); kreg[2] = *(const u32x4*)(rb_ + kroff); \
        vreg[0] = *(const u32x4*)(tb_ + kvoff + 256u); vreg[1] = *(const u32x4*)(tb_ + kvoff + 32u * KVUP * 2u + 256u); } while (0)
#define MLA_STORE(B) do { *(LAS u32x4*)((B) + vrow0 * C_KSTR + vch * 16) = kreg[0]; *(LAS u32x4*)((B) + (vrow0 + 32) * C_KSTR + vch * 16) = kreg[1]; *(LAS u32x4*)((B) + rrow * C_KSTR + 256 + rch * 16) = kreg[2]; \
        *(LAS u32x4*)((B) + C_KSZ + vrow0 * C_VSTR + vch * 16) = vreg[0]; *(LAS u32x4*)((B) + C_KSZ + (vrow0 + 32) * C_VSTR + vch * 16) = vreg[1]; } while (0)
    MLA_LOAD(0); MLA_STORE(lds);
    __syncthreads();
    const int tqmax = qb * 256 + 32 * wave + 31;
    for (int j = 0; j < ntile; ++j) {
        const bool more = (j + 1 < ntile);
        if (more && VAR != 2) MLA_LOAD(j + 1);
        LAS unsigned char* B = lds + (j & 1) * C_BUF;
        if (VAR != 1 && 64 * j <= tqmax) {
            FixC fx; fx.tq = tq; fx.kpos0 = 64 * j;
            tile_compute<192, 128, C_KSTR, C_VSTR, false, FixC, (VAR == 2)>(qf, B, B + C_KSZ, o, m, l, r, h, vlane, fx, 64 * j + 63 <= tqmax - 31  , 0.f);
        }
        if (more && VAR != 2) { LAS unsigned char* Bn = lds + ((j + 1) & 1) * C_BUF; MLA_STORE(Bn); }
        __syncthreads();
    }
#undef MLA_LOAD
#undef MLA_STORE
    const float inv = 1.0f / l;
#pragma unroll
    for (int d = 0; d < 4; ++d) o[d] = o[d] * inv;
    store_o<4>(o, (bf16_t*)(ws + WS_OB1) + rowb * DM + hh * 128, h);
}

DI float wave_sum(float v, int lane) {
#pragma unroll
    for (int o = 1; o < 64; o <<= 1) v += shflx(v, lane, o);
    return v;
}
DI void wt_load(const float* W, int K, int N, int nblk, const float* gk, int item, int lane, f32x4 (&v)[16]) {
    const int kb = item / nblk, nb = item % nblk, k0 = 64 * kb, n0 = 64 * nb;
    const int lr = lane >> 4, lc = 4 * (lane & 15);
    const bool cvalid = (n0 + lc) < N;
    const float* wp = W + (size_t)(k0 + lr) * N + n0 + lc;
#pragma unroll
    for (int r = 0; r < 16; ++r) v[r] = cvalid ? *(const f32x4*)(wp + (size_t)(4 * r) * N) : (f32x4){0.f, 0.f, 0.f, 0.f};
    if (gk) {
#pragma unroll
        for (int r = 0; r < 16; ++r) v[r] = v[r] * gk[k0 + 4 * r + lr];
    }
}
DI void wt_finish(int K, int nblk, bf16_t* WT, int mode, LAS float* scr, int item, int lane, const f32x4 (&v)[16]) {
    const int kb = item / nblk, nb = item % nblk, k0 = 64 * kb, n0 = 64 * nb;
    const int lr = lane >> 4, lc = 4 * (lane & 15);
#pragma unroll
    for (int r = 0; r < 16; ++r) { LAS float* q = scr + (4 * r + lr) * 65 + lc; q[0] = v[r][0]; q[1] = v[r][1]; q[2] = v[r][2]; q[3] = v[r][3]; }
    const int nl = lane >> 3, c = lane & 7;
#pragma unroll
    for (int i = 0; i < 8; ++i) {
        const int ln = 8 * i + nl, n = n0 + ln; int srcl = ln; float scale = 1.0f;
        if (mode == 1) { if (n < 1024 || (n >= 1280 && n < 2304)) scale = 0.125f * LOG2E; }
        else if (mode == 2) { if (n >= 1280 && n < 1344) srcl = (ln >> 1) + 32 * (ln & 1); }
        else if (mode == 3) { if ((n % 192) >= 128) srcl = (ln >> 1) + 32 * (ln & 1); scale = 0.07216878364870322f * LOG2E; }
        const LAS float* sp = scr + (8 * c) * 65 + srcl;
        u32x4 o; o.x = pk2(sp[0 * 65] * scale, sp[1 * 65] * scale); o.y = pk2(sp[2 * 65] * scale, sp[3 * 65] * scale);
        o.z = pk2(sp[4 * 65] * scale, sp[5 * 65] * scale); o.w = pk2(sp[6 * 65] * scale, sp[7 * 65] * scale);
        *(u32x4*)(WT + (size_t)n * K + k0 + 8 * c) = o;
    }
}
#define WT_JOB(W_, K_, N_, NPAD_, DST_, GK_, MODE_) do { const int nblk_ = (NPAD_) / 64, cnt_ = ((K_) / 64) * nblk_; int first_ = (gw - wt_base) % ngw; if (first_ < 0) first_ += ngw; \
    for (int it_ = first_; it_ < cnt_; it_ += 2 * ngw) { f32x4 va_[16], vb_[16]; const bool two_ = it_ + ngw < cnt_;   \
        wt_load((W_), (K_), (N_), nblk_, (GK_), it_, lane, va_); if (two_) wt_load((W_), (K_), (N_), nblk_, (GK_), it_ + ngw, lane, vb_); \
        wt_finish((K_), nblk_, (bf16_t*)(ws + (DST_)), (MODE_), scr, it_, lane, va_); if (two_) wt_finish((K_), nblk_, (bf16_t*)(ws + (DST_)), (MODE_), scr, it_ + ngw, lane, vb_); } \
    wt_base = (wt_base + cnt_) % ngw; } while (0)
DI int t5_bucket(int d) {
    if (d < 16) return d;
    const int v = 16 + (int)(logf((float)d / 16.0f) / 2.0794415416798357f * 16.0f);
    return v > 31 ? 31 : v;
}

#define CAS __attribute__((address_space(4)))
DI const float* inp(int i) { const CAS char* ka = (const CAS char*)__builtin_amdgcn_kernarg_segment_ptr(); asm volatile("" : "+s"(ka)); return ((const float* const CAS*)ka)[i]; }
DI unsigned xcc_id() { return (unsigned)__builtin_amdgcn_s_getreg((3 << 11) | 20) & 7u; }
#ifndef REP_P0
#define REP_P0 0
#endif
#ifndef REP_A
#define REP_A 0
#endif
#ifndef REP_B
#define REP_B 0
#endif
#ifndef REP_C
#define REP_C 0
#endif
#ifndef REP_UP
#define REP_UP 0
#endif
#ifndef EN_PRO
#define EN_PRO 1
#endif
#ifndef EN_GEMM
#define EN_GEMM 1
#endif
#ifndef EN_A
#define EN_A 1
#endif
#ifndef EN_B
#define EN_B 1
#endif
#ifndef EN_C
#define EN_C 1
#endif
#define XB_TMO      128
#define XB_XCNT(j)  (256  + 64 * (j))
#define XB_XSUB(j)  (1280 + 64 * (j))
#define XB_XGEN(j)  (2304 + 64 * (j))
#define XB_TOP      3328
#define XB_TOPGEN   3392
#define XCD_BAR_WORDS 3456
#define XB_SPIN_CAP (1u << 18)

__device__ __forceinline__ unsigned xb_ld(unsigned* p)              { return __hip_atomic_load(p, __ATOMIC_RELAXED, __HIP_MEMORY_SCOPE_AGENT); }
__device__ __forceinline__ unsigned xb_add(unsigned* p, unsigned v) { return __hip_atomic_fetch_add(p, v, __ATOMIC_RELAXED, __HIP_MEMORY_SCOPE_AGENT); }
__device__ __forceinline__ unsigned xb_xcc_id() { return (unsigned)__builtin_amdgcn_s_getreg((3 << 11) | 20) & 0xFu; }
#define XB_SPIN(cond, bar) do { unsigned _sp = 0; while (cond) { __builtin_amdgcn_s_sleep(1); \
    if ((++_sp & 255u) == 0u) { if (xb_ld(&(bar)[XB_TMO])) break; if (_sp > XB_SPIN_CAP) { atomicAdd(&(bar)[XB_TMO], 1u); break; } } } } while (0)

struct XcdBarrier {
    unsigned* bar; unsigned x;
    volatile LAS unsigned* st;
};

__device__ __forceinline__ XcdBarrier xcd_barrier_post(unsigned* bar, volatile LAS unsigned* st, int wave) {
    XcdBarrier b; b.bar = bar; b.x = xb_xcc_id(); b.st = st;
    if (wave == 0 && fresh_lane() == 0) (void)xb_add(&bar[XB_XCNT(b.x)], 1u);
    return b;
}
__device__ __forceinline__ void xcd_barrier_complete(unsigned* bar, unsigned x, unsigned& nloc, unsigned& nx) {
    const unsigned G = gridDim.x * gridDim.y * gridDim.z;
    unsigned sum, cnt, mine, sp = 0u;
    for (;;) {
        sum = 0u; cnt = 0u; mine = 0u;
#pragma unroll
        for (unsigned j = 0; j < 16; ++j) { const unsigned c = xb_ld(&bar[XB_XCNT(j)]); sum += c; cnt += (c > 0u) ? 1u : 0u; mine = (j == x) ? c : mine; }
        if (sum == G) break;
        __builtin_amdgcn_s_sleep(1);
        if ((++sp & 255u) == 0u) { if (xb_ld(&bar[XB_TMO])) break; if (sp > XB_SPIN_CAP) { atomicAdd(&bar[XB_TMO], 1u); break; } }
    }
    nloc = mine > 0u ? mine : 1u; nx = cnt > 0u ? cnt : 1u;
}

__device__ __forceinline__ void xcd_barrier(const XcdBarrier& b, int wave) {
    asm volatile("s_waitcnt vmcnt(0)" ::: "memory");
    __syncthreads();
    if (wave == 0 && fresh_lane() == 0) {
        unsigned* bar = b.bar;
        __builtin_amdgcn_s_waitcnt(0);
        unsigned nloc = b.st[0], nx = b.st[1];
        if (nloc == 0u) { xcd_barrier_complete(bar, b.x, nloc, nx); b.st[0] = nloc; b.st[1] = nx; }
        const unsigned old = xb_add(&bar[XB_XSUB(b.x)], 1u);
        const unsigned gen = old / nloc;
        if (old + 1u == (gen + 1u) * nloc) {
            __builtin_amdgcn_fence(__ATOMIC_RELEASE, "agent");
            asm volatile("s_waitcnt vmcnt(0)" ::: "memory");
            const unsigned og = xb_add(&bar[XB_TOP], 1u);
            const unsigned tg = og / nx;
            if (og + 1u == (tg + 1u) * nx) xb_add(&bar[XB_TOPGEN], 1u);
            else XB_SPIN(xb_ld(&bar[XB_TOPGEN]) == tg, bar);
            __builtin_amdgcn_fence(__ATOMIC_ACQUIRE, "agent");
            xb_add(&bar[XB_XGEN(b.x)], 1u);
            asm volatile("s_waitcnt vmcnt(0)" ::: "memory");
        } else {
            XB_SPIN(xb_ld(&bar[XB_XGEN(b.x)]) == gen, bar);
            __builtin_amdgcn_fence(__ATOMIC_ACQUIRE, "agent");
            asm volatile("s_waitcnt vmcnt(0)" ::: "memory");
        }
    }
    __syncthreads();
}

__global__ void __launch_bounds__(NTHR, 2) fwd_kernel(Ptrs P) {
    extern __shared__ __attribute__((aligned(16))) unsigned char lds_raw[];
    LAS unsigned char* lds = (LAS unsigned char*)lds_raw;
    const int wave = __builtin_amdgcn_readfirstlane((int)threadIdx.x >> 6);
    int lane, tid;
#define FRESH_TID() do { lane = fresh_lane(); tid = wave * 64 + lane; } while (0)
    FRESH_TID();
    if (tid < 4) ((volatile LAS unsigned*)(lds + LDS_BYTES - 16))[tid] = 0u;
    __syncthreads();
    const int G = gridDim.x, bx = blockIdx.x, gw = bx * 8 + wave, ngw = G * 8;
    unsigned char* ws = (unsigned char*)inp(24);
    unsigned* ctl = (unsigned*)(ws + WS_CTL);
    const XcdBarrier xbar = xcd_barrier_post((unsigned*)(ws + WS_BAR), (volatile LAS unsigned*)(lds + LDS_BYTES - 16), wave);
    float* part = (float*)(ws + WS_PART); float* part2 = (float*)(ws + WS_PART2);
    bf16_t* XB = (bf16_t*)(ws + WS_XB);
    LAS float* scr = (LAS float*)(lds + wave * 17408);
    LAS int* slot = (LAS int*)(lds + SLOT_OFF);

    for (int rep_ = 0; rep_ <= REP_P0; ++rep_) {
    if (rep_) xcd_barrier(xbar, wave);
        if (bx == 0 && tid < 64) ctl[tid] = 0u;
        int wt_base = 0;
        WT_JOB(inp(3), DM, EIN, EINP, WS_WINE, inp(2), 1); WT_JOB(inp(11), DM, DM, DM, WS_WOUTE, (const float*)nullptr, 0); WT_JOB(inp(13), DM, OIN, OINP, WS_WINO, inp(12), 2);
        WT_JOB(inp(15), 768, QUP, QUP, WS_WQUP, inp(14), 3); WT_JOB(inp(17), 512, KVUP, KVUP, WS_WKVUP, inp(16), 0); WT_JOB(inp(18), DM, DM, DM, WS_WOUTO, (const float*)nullptr, 0);
        WT_JOB(inp(20), DM, FF, FF, WS_WUP, inp(19), 0); WT_JOB(inp(21), FF, DM, DM, WS_WDN, (const float*)nullptr, 0);
        WT_JOB(inp(7), 2048, 256, 256, WS_CW1K, (const float*)nullptr, 0); WT_JOB(inp(9), 2048, 256, 256, WS_CW1V, (const float*)nullptr, 0);
        WT_JOB(inp(8), 256, 64, 64, WS_CW2K, (const float*)nullptr, 0); WT_JOB(inp(10), 256, 64, 64, WS_CW2V, (const float*)nullptr, 0);
        const float* x = inp(0);
        for (int row = gw; row < MTOK; row += ngw) {
            const f32x4* xr = (const f32x4*)(x + (size_t)row * DM) + lane; u32x2* xo = (u32x2*)(XB + (size_t)row * DM) + lane; float s = 0.f;
#pragma unroll
            for (int j = 0; j < 8; ++j) { const f32x4 v = xr[64 * j]; s += (v[0] * v[0] + v[1] * v[1]) + (v[2] * v[2] + v[3] * v[3]); u32x2 w; w.x = pk2(v[0], v[1]); w.y = pk2(v[2], v[3]); xo[64 * j] = w; }
            s = wave_sum(s, lane);
            if (lane < 32) part[(size_t)row * 32 + lane] = lane == 0 ? s : 0.f;
        }
        const int gt = bx * NTHR + tid, ngt = G * NTHR;
        float* biasT = (float*)(ws + WS_BIAS); float* cosT = (float*)(ws + WS_COS); float* sinT = (float*)(ws + WS_SIN);
        { const float* rb = inp(1); for (int i = gt; i < 32 * 128; i += ngt) { const int hd = i >> 7, d = i & 127; biasT[i] = rb[t5_bucket(d) * 32 + hd] * LOG2E; } }
        for (int i = gt; i < 2048 * 32; i += ngt) { const int s = i >> 5, ii = i & 31; const float inv = 1.0f / powf(10000.0f, (float)(2 * ii) / 64.0f); const float ang = (float)s * inv; cosT[i] = cosf(ang); sinT[i] = sinf(ang); }
        bf16_t* KC = (bf16_t*)(ws + WS_KC); bf16_t* VC = (bf16_t*)(ws + WS_VC);
        for (int i = gt; i < 8 * 128; i += ngt) { const int b = i >> 7, e = i & 127; KC[(size_t)(b * 128 + 127) * 128 + e] = 0; VC[(size_t)(b * 128 + 127) * 128 + e] = 0; }
    }
    if (gridDim.y == 0x7fffu) cg::this_grid().sync();
    xcd_barrier(xbar, wave);
    {
        pg8::Gemm g{XB, (const bf16_t*)(ws + WS_WINE), MTOK, EINP, DM, DM}; pg8::StaticOrder S; S.init(MTOK, 3072, G, bx);
        pg8::EpiScale<0> E{(bf16_t*)(ws + WS_P0), EINP, part, nullptr, nullptr, nullptr, nullptr};
        if (EN_GEMM) pg8::gemm_phase<pg8::EpiScale<0>, pg8::StaticOrder, true, true>(lds, g, S, E, wave);
    }
    xcd_barrier(xbar, wave);
    FRESH_TID();
    {
        pg8::Gemm g{XB, (const bf16_t*)(ws + WS_WINE), MTOK, EINP, DM, DM}; pg8::TailOrder T{bx, 12};
        pg8::EpiScale<0> E{(bf16_t*)(ws + WS_P0), EINP, part, nullptr, nullptr, nullptr, nullptr};
        pg8::gemm_phase<pg8::EpiScale<0>, pg8::TailOrder, true, true>(lds, g, T, E, wave);
        __syncthreads();
        FRESH_TID();
    }
    {
        const float* pk_ = inp(5); const float* pv_ = inp(6); const float* sk_ = inp(4);
        for (;;) { const int it = next_item(ctl + 0, slot, wave); if (it >= 128) break; compress_item(it, ws, pk_, pv_, lds, tid, wave, lane); }
        const unsigned x0 = xcc_id();
        for (int s = 0; s < 8; ++s) { const int xq = (int)((x0 + s) & 7u);
            for (;;) { const int k = next_item(ctl + 16 + xq, slot, wave); if (k >= 128) break; mixerA_item((xq + 8 * (k & 1)) * 64 + (k >> 1), ws, sk_, lds, tid, wave, lane); } }
    }
    xcd_barrier(xbar, wave);
    FRESH_TID();
    {
        const unsigned x0 = xcc_id();
        for (int s = 0; s < 8; ++s) { const int xq = (int)((x0 + s) & 7u);
            for (;;) { const int k = next_item(ctl + 32 + xq, slot, wave); if (k >= 128) break; mixerB_item(((k >> 1) << 4) | (xq + 8 * (k & 1)), ws, lds, tid, wave, lane); } }
    }
    xcd_barrier(xbar, wave);
    {
        pg8::Gemm g{(const bf16_t*)(ws + WS_OB0), (const bf16_t*)(ws + WS_WOUTE), MTOK, DM, DM, DM}; pg8::StaticOrder S; S.init(MTOK, DM, G, bx);
        pg8::EpiResidual<false> E{inp(0), (float*)inp(23), XB, part};
        if (EN_GEMM) pg8::gemm_phase<pg8::EpiResidual<false>, pg8::StaticOrder, true, true>(lds, g, S, E, wave);
    }
    xcd_barrier(xbar, wave);
    {
        for (int rep_ = 0; rep_ <= REP_UP; ++rep_) {
            if (rep_) xcd_barrier(xbar, wave);
            pg8::Gemm g{XB, (const bf16_t*)(ws + WS_WUP), MTOK, FF, DM, DM}; pg8::StaticOrder S; S.init(MTOK, FF, G, bx);
            pg8::EpiScale<1> E{(bf16_t*)(ws + WS_HB), FF, part, nullptr, nullptr, nullptr, nullptr};
            if (EN_GEMM) pg8::gemm_phase<pg8::EpiScale<1>, pg8::StaticOrder, true, true>(lds, g, S, E, wave);
        }
        xcd_barrier(xbar, wave);
        {
            pg8::Gemm g{(const bf16_t*)(ws + WS_HB), (const bf16_t*)(ws + WS_WDN), MTOK, DM, FF, FF}; pg8::StaticOrder S; S.init(MTOK, DM, G, bx);
            float* outp = (float*)inp(23); pg8::EpiResidual<false> E{outp, outp, XB, part};
            if (EN_GEMM) pg8::gemm_phase<pg8::EpiResidual<false>, pg8::StaticOrder, true, true>(lds, g, S, E, wave);
        }
        xcd_barrier(xbar, wave);
    }
    {
            FRESH_TID();
            int wt_base = 0;
            WT_JOB(inp(20) + (size_t)DM * FF, DM, FF, FF, WS_WUP, inp(19) + DM, 0); WT_JOB(inp(21) + (size_t)FF * DM, FF, DM, DM, WS_WDN, (const float*)nullptr, 0);
            __syncthreads();
            {
                pg8::Gemm g{XB, (const bf16_t*)(ws + WS_WINO), MTOK, OINP, DM, DM}; pg8::StaticOrder S; S.init(MTOK, OINP, G, bx);
                pg8::EpiScale<2> E{(bf16_t*)(ws + WS_P1), OINP, part, part2, (bf16_t*)(ws + WS_KR), (const float*)(ws + WS_COS), (const float*)(ws + WS_SIN)};
                if (EN_GEMM) pg8::gemm_phase<pg8::EpiScale<2>, pg8::StaticOrder, true, true>(lds, g, S, E, wave);
            }
            xcd_barrier(xbar, wave);
            {
                pg8::Gemm g{(const bf16_t*)(ws + WS_P1), (const bf16_t*)(ws + WS_WQUP), MTOK, QUP, 768, OINP}; pg8::StaticOrder S; S.init(MTOK, QUP, G, bx);
                pg8::EpiScale<3> E{(bf16_t*)(ws + WS_Q1), QUP, part2, nullptr, nullptr, (const float*)(ws + WS_COS), (const float*)(ws + WS_SIN)};
                if (EN_GEMM) pg8::gemm_phase<pg8::EpiScale<3>, pg8::StaticOrder, true, true>(lds, g, S, E, wave);
            }
            {
                pg8::Gemm g{(const bf16_t*)(ws + WS_P1) + 768, (const bf16_t*)(ws + WS_WKVUP), MTOK, KVUP, 512, OINP}; pg8::StaticOrder S; S.init(MTOK, KVUP, G, bx);
                pg8::EpiScale<4> E{(bf16_t*)(ws + WS_KV1), KVUP, part2, nullptr, nullptr, nullptr, nullptr};
                if (EN_GEMM) pg8::gemm_phase<pg8::EpiScale<4>, pg8::StaticOrder, true, true>(lds, g, S, E, wave);
            }
            xcd_barrier(xbar, wave);
            FRESH_TID();
#ifndef MLA_PROBE
#define MLA_PROBE 0
#endif
            if (MLA_PROBE) {
                const unsigned x0 = xcc_id();
                for (int s = 0; s < 8; ++s) { const int xq = (int)((x0 + s) & 7u);
                    for (;;) { const int k = next_item(ctl + 56 + xq, slot, wave); if (k >= 128) break;
                        const int bh = ((k >> 5) * 4 + (k & 3)) * 8 + xq, q7 = (k & 31) >> 2;
                        mla_item<MLA_PROBE>((q7 << 7) | bh, ws, lds, tid, wave, lane); } }
                xcd_barrier(xbar, wave);
            }
            {
                const unsigned x0 = xcc_id();
                for (int s = 0; s < 8; ++s) { const int xq = (int)((x0 + s) & 7u);
                    for (;;) { const int k = next_item(ctl + 48 + xq, slot, wave); if (k >= 128) break;
                        const int bh = ((k >> 5) * 4 + (k & 3)) * 8 + xq, q7 = (k & 31) >> 2;
                        mla_item<0>((q7 << 7) | bh, ws, lds, tid, wave, lane); } }
            }
            xcd_barrier(xbar, wave);
            {
                pg8::Gemm g{(const bf16_t*)(ws + WS_OB1), (const bf16_t*)(ws + WS_WOUTO), MTOK, DM, DM, DM}; pg8::StaticOrder S; S.init(MTOK, DM, G, bx);
                float* outp = (float*)inp(23); pg8::EpiResidual<false> E{outp, outp, XB, part};
                if (EN_GEMM) pg8::gemm_phase<pg8::EpiResidual<false>, pg8::StaticOrder, true, true>(lds, g, S, E, wave);
            }
            xcd_barrier(xbar, wave);
    }
    {
        for (int rep_ = 0; rep_ <= REP_UP; ++rep_) {
            if (rep_) xcd_barrier(xbar, wave);
            pg8::Gemm g{XB, (const bf16_t*)(ws + WS_WUP), MTOK, FF, DM, DM}; pg8::StaticOrder S; S.init(MTOK, FF, G, bx);
            pg8::EpiScale<1> E{(bf16_t*)(ws + WS_HB), FF, part, nullptr, nullptr, nullptr, nullptr};
            if (EN_GEMM) pg8::gemm_phase<pg8::EpiScale<1>, pg8::StaticOrder, true, true>(lds, g, S, E, wave);
        }
        xcd_barrier(xbar, wave);
        {
            pg8::Gemm g{(const bf16_t*)(ws + WS_HB), (const bf16_t*)(ws + WS_WDN), MTOK, DM, FF, FF}; pg8::StaticOrder S; S.init(MTOK, DM, G, bx);
            float* outp = (float*)inp(23); pg8::EpiResidual<true> E{outp, outp, XB, part};
            if (EN_GEMM) pg8::gemm_phase<pg8::EpiResidual<true>, pg8::StaticOrder, true, true>(lds, g, S, E, wave);
        }
        xcd_barrier(xbar, wave);
    }
    FRESH_TID();
    {
        const float* gf = inp(22); float* outp = (float*)inp(23);
        for (int row = gw; row < MTOK; row += ngw) {
            const f32x4* pr = (const f32x4*)(part + (size_t)row * 32); float s = 0.f;
#pragma unroll
            for (int i = 0; i < 8; ++i) { const f32x4 v = pr[i]; s += (v[0] + v[1]) + (v[2] + v[3]); }
            const float rs = __builtin_amdgcn_rsqf(s * (1.0f / 2048.0f) + EPS);
            f32x4* xr = (f32x4*)(outp + (size_t)row * DM) + lane; const f32x4* gr = (const f32x4*)gf + lane; const u32x2* xb = (const u32x2*)(XB + (size_t)row * DM) + lane;
#pragma unroll
            for (int j = 0; j < 8; ++j) { const u32x2 w = xb[64 * j]; const f32x4 gg = gr[64 * j]; f32x4 v; v[0] = bflo(w.x); v[1] = bfhi(w.x); v[2] = bflo(w.y); v[3] = bfhi(w.y); xr[64 * j] = v * rs * gg; }
        }
    }
}

extern "C" void kernel_launch(void* const* d_in, const int* in_sizes, int n_in, void* d_out, int out_size, void* d_ws, size_t ws_size, hipStream_t stream) {
    static int grid = 0;
    if (grid == 0) {
        if (n_in != 23 || out_size != MTOK * DM || ws_size < WS_END) { fprintf(stderr, "kernel_launch: unexpected shapes (n_in %d out %d ws %zu need %zu)\n", n_in, out_size, ws_size, (size_t)WS_END); grid = -1; return; }
        int dev = 0, cus = 0, per_cu = 0;
        hipGetDevice(&dev); hipDeviceGetAttribute(&cus, hipDeviceAttributeMultiprocessorCount, dev);
        hipFuncSetAttribute((const void*)fwd_kernel, hipFuncAttributeMaxDynamicSharedMemorySize, LDS_BYTES);
        hipOccupancyMaxActiveBlocksPerMultiprocessor(&per_cu, (const void*)fwd_kernel, NTHR, LDS_BYTES);
        if (per_cu < 1) { fprintf(stderr, "kernel_launch: occupancy query returned %d\n", per_cu); per_cu = 1; }
        grid = cus;
    }
    if (grid < 0) return;
    if (hipMemsetAsync(d_ws, 0, 16384, stream) != hipSuccess) { fprintf(stderr, "kernel_launch: memset of the control words failed\n"); return; }
    Ptrs p{};
    for (int i = 0; i < 23; ++i) p.in[i] = (const float*)d_in[i];
    p.out = (float*)d_out; p.ws = (unsigned char*)d_ws;
    void* args[] = {&p};
    hipError_t e = hipLaunchCooperativeKernel((const void*)fwd_kernel, dim3(grid), dim3(NTHR), args, LDS_BYTES, stream);
    if (e != hipSuccess) fprintf(stderr, "cooperative launch failed: %s (grid %d)\n", hipGetErrorString(e), grid);
}
```

```cpp
#include <hip/hip_runtime.h>
#include <hip/hip_cooperative_groups.h>
#include <cstdio>
#include <cstdint>
namespace cg = cooperative_groups;

#define DI __device__ __forceinline__
#define LAS __attribute__((address_space(3)))
typedef unsigned short bf16_t;
typedef short bf16x8 __attribute__((ext_vector_type(8)));
typedef short s16x4 __attribute__((ext_vector_type(4)));
typedef float f32x4 __attribute__((ext_vector_type(4)));
typedef float f32x2 __attribute__((ext_vector_type(2)));
typedef float f32x16 __attribute__((ext_vector_type(16)));
typedef unsigned u32x4 __attribute__((ext_vector_type(4)));
typedef unsigned u32x2 __attribute__((ext_vector_type(2)));
typedef __bf16 bf16v2 __attribute__((ext_vector_type(2)));

DI unsigned pk2(float lo, float hi) { bf16v2 v = {(__bf16)lo, (__bf16)hi}; return __builtin_bit_cast(unsigned, v); }
DI int fresh_lane() { int l; asm volatile("v_mbcnt_lo_u32_b32 %0, -1, 0\n\tv_mbcnt_hi_u32_b32 %0, -1, %0" : "=v"(l)); return l; }
DI float shflx(float v, int lane, int k) { return __int_as_float(__builtin_amdgcn_ds_bpermute((lane ^ k) << 2, __float_as_int(v))); }
DI unsigned shflxu(unsigned v, int lane, int k) { return (unsigned)__builtin_amdgcn_ds_bpermute((lane ^ k) << 2, (int)v); }
DI float bflo(unsigned u) { return __uint_as_float(u << 16); }
DI float bfhi(unsigned u) { return __uint_as_float(u & 0xffff0000u); }
DI float bf2f(bf16_t v) { return __uint_as_float(((unsigned)v) << 16); }

constexpr int DM = 2048, SEQ = 2048, NBATCH = 8, MTOK = NBATCH * SEQ, FF = 8192;
constexpr int EIN = 3120, EINP = 3328, OIN = 1344, OINP = 1536, QUP = 3072, KVUP = 4096;
constexpr float EPS = 1e-6f, LOG2E = 1.4426950408889634f, NEGBIG = -1e30f;
constexpr int NTHR = 512;

constexpr size_t al256(size_t x) { return (x + 255) & ~(size_t)255; }
constexpr size_t WS_CTL = 0;
constexpr size_t WS_BAR = 1024;
constexpr size_t WS_PART = 16384;
constexpr size_t WS_PART2 = WS_PART + (size_t)MTOK * 32 * 4;
constexpr size_t WS_BIAS = WS_PART2 + (size_t)MTOK * 32 * 4;
constexpr size_t WS_COS = WS_BIAS + 32 * 128 * 4;
constexpr size_t WS_SIN = WS_COS + 2048 * 32 * 4;
constexpr size_t WS_KC = WS_SIN + 2048 * 32 * 4;
constexpr size_t WS_VC = WS_KC + 8 * 128 * 128 * 2;
constexpr size_t WS_KR = WS_VC + 8 * 128 * 128 * 2;
constexpr size_t WS_WINE = WS_KR + (size_t)MTOK * 64 * 2;
constexpr size_t WS_WOUTE = WS_WINE + (size_t)EINP * DM * 2;
constexpr size_t WS_WINO = WS_WOUTE + (size_t)DM * DM * 2;
constexpr size_t WS_WQUP = WS_WINO + (size_t)OINP * DM * 2;
constexpr size_t WS_WKVUP = WS_WQUP + (size_t)QUP * 768 * 2;
constexpr size_t WS_WOUTO = WS_WKVUP + (size_t)KVUP * 512 * 2;
constexpr size_t WS_WUP = WS_WOUTO + (size_t)DM * DM * 2;
constexpr size_t WS_WDN = WS_WUP + (size_t)FF * DM * 2;
constexpr size_t WS_CW1K = WS_WDN + (size_t)DM * FF * 2;
constexpr size_t WS_CW1V = WS_CW1K + 256 * 2048 * 2;
constexpr size_t WS_CW2K = WS_CW1V + 256 * 2048 * 2;
constexpr size_t WS_CW2V = WS_CW2K + 64 * 256 * 2;
constexpr size_t WS_XB = WS_CW2V + 64 * 256 * 2;
constexpr size_t WS_R = WS_XB + (size_t)MTOK * DM * 2;
constexpr size_t WS_P0 = WS_R, WS_OB0 = WS_R + (size_t)MTOK * EINP * 2;
constexpr size_t WS_P1 = WS_R, WS_OB1 = WS_R, WS_Q1 = WS_R + (size_t)MTOK * DM * 2, WS_KV1 = WS_Q1 + (size_t)MTOK * QUP * 2;
constexpr size_t WS_HB = WS_R;
constexpr size_t WS_END = WS_KV1 + (size_t)MTOK * KVUP * 2;
static_assert(WS_R + (size_t)MTOK * FF * 2 <= WS_END, "HB fits");

namespace pg8 {
#define PG8_LAS __attribute__((address_space(3)))
constexpr int BM = 256, BK = 64, HALF = 128, HTB = HALF * BK * 2  , STAGE_BYTES = 8 * HTB, NXCD = 8, WGM = 8;
__host__ __device__ __forceinline__ int lds_byte(int r, int c) { const int st = (r >> 4) * 2 + (c >> 5), rr = r & 15, cc = c & 31, ob = rr * 64 + cc * 2; return st * 1024 + (ob ^ (((ob >> 9) & 1) << 5)); }
__host__ __device__ __forceinline__ void stage_rc(int b, int& R, int& C) { const int st = b / 1024, sb = b % 1024, swz = sb ^ (((sb >> 9) & 1) << 5); R = (st >> 1) * 16 + swz / 64; C = (st & 1) * 32 + (swz % 64) / 2; }
__host__ __device__ __forceinline__ int perm32(int rho) { const int n = rho >> 4, i = rho & 15; return 8 * (i >> 2) + 4 * n + (i & 3); }
struct Unit { int pm, pn; };
struct Gemm { const bf16_t* A; const bf16_t* Bt; int M, N, K, lda; };
struct StaticOrder {
    int nM, nN, nwg, G, c;
    __host__ __device__ void init(int M, int N, int G_, int c_) { nM = M / BM; nN = N / BM; nwg = nM * nN; G = G_; c = c_; }
    __host__ __device__ bool next(int i, Unit& u) const {
        const long L = (long)i * G + c; if (L >= nwg) return false;
        int wgid = (int)L; { const int q = nwg / NXCD, r = nwg % NXCD, xcd = wgid % NXCD, off = wgid / NXCD; wgid = (xcd < r ? xcd * (q + 1) : r * (q + 1) + (xcd - r) * q) + off; }
        const int nig = WGM * nN, gid = wgid / nig, fm = gid * WGM, gsz = (nM - fm) < WGM ? (nM - fm) : WGM;
        u.pm = fm + ((wgid % nig) % gsz); u.pn = (wgid % nig) / gsz; return true;
    }
    __device__ __forceinline__ void a_ready(const Unit&) const {}
    __device__ __forceinline__ void done(const Unit&) const {}
};
struct TailOrder {
    int c, pn;
    __host__ __device__ bool next(int i, Unit& u) const { if (i > 0 || c >= 64) return false; u.pm = c; u.pn = pn; return true; }
    __device__ __forceinline__ void a_ready(const Unit&) const {}
    __device__ __forceinline__ void done(const Unit&) const {}
};
template <int FIRST4, int CNT4> __device__ __forceinline__ float row_rs(const float* part, int row, int fq, int lane, float inv_dim) {
    const f32x4* p = (const f32x4*)(part + (size_t)row * 32) + FIRST4; float s = 0.f;
#pragma unroll
    for (int i = 0; i < (CNT4 + 3) / 4; ++i) { const int k = fq + 4 * i; if (k < CNT4) { const f32x4 v = p[k]; s += (v[0] + v[1]) + (v[2] + v[3]); } }
    s += shflx(s, lane, 16); s += shflx(s, lane, 32);
    return __builtin_amdgcn_rsqf(s * inv_dim + EPS);
}
template <int MODE> struct EpiScale {
    static constexpr bool PERM = true, AFTER_DRAIN = false;
    bf16_t* O; int ldc; const float* part; float* part_out; bf16_t* kr; const float* cosT; const float* sinT;
    __device__ __forceinline__ void operator()(const f32x4 (&acc)[2][2][4][2], const Unit& u, int wr, int wc, int fr, int fq) const {
        const int row0 = u.pm * BM + wr * 64 + fr; const int col0 = u.pn * BM + wc * 32 + 8 * fq;
#pragma unroll
        for (int ai = 0; ai < 2; ++ai)
#pragma unroll
            for (int m = 0; m < 4; ++m) {
                const int row = row0 + ai * HALF + m * 16;
                float rs;
                if (MODE == 0 || MODE == 1 || MODE == 2) rs = row_rs<0, 8>(part, row, fq, fr + 16 * fq, 1.0f / 2048.0f);
                else if (MODE == 3) rs = row_rs<0, 3>(part, row, fq, fr + 16 * fq, 1.0f / 768.0f);
                else rs = row_rs<3, 2>(part, row, fq, fr + 16 * fq, 1.0f / 512.0f);
                bf16_t* rowp = O + (size_t)row * ldc + col0;
                float ss = 0.f;
#pragma unroll
                for (int bj = 0; bj < 2; ++bj) {
                    f32x4 v0 = acc[ai][bj][m][0] * rs, v1 = acc[ai][bj][m][1] * rs;
                    const int col = col0 + bj * HALF;
                    if (MODE == 1) {
#pragma unroll
                        for (int e = 0; e < 4; ++e) { float a = fmaxf(v0[e], 0.f), b = fmaxf(v1[e], 0.f); v0[e] = a * a; v1[e] = b * b; }
                    }
                    if (MODE == 2) {
#pragma unroll
                        for (int e = 0; e < 4; ++e) ss += v0[e] * v0[e] + v1[e] * v1[e];
                    }
                    bool rope = false; int ri = 0;
                    if (MODE == 2) { rope = (col >= 1280 && col < 1344); ri = (col - 1280) >> 1; }
                    if (MODE == 3) { const int j = col % 192; rope = j >= 128; ri = (j - 128) >> 1; }
                    if ((MODE == 2 || MODE == 3) && rope) {
                        const int s = row & (SEQ - 1);
                        const f32x4 cs = *(const f32x4*)(cosT + s * 32 + ri), sn = *(const f32x4*)(sinT + s * 32 + ri);
                        f32x4 w0, w1;
                        w0[0] = v0[0] * cs[0] - v0[1] * sn[0]; w0[1] = v0[1] * cs[0] + v0[0] * sn[0];
                        w0[2] = v0[2] * cs[1] - v0[3] * sn[1]; w0[3] = v0[3] * cs[1] + v0[2] * sn[1];
                        w1[0] = v1[0] * cs[2] - v1[1] * sn[2]; w1[1] = v1[1] * cs[2] + v1[0] * sn[2];
                        w1[2] = v1[2] * cs[3] - v1[3] * sn[3]; w1[3] = v1[3] * cs[3] + v1[2] * sn[3];
                        v0 = w0; v1 = w1;
                    }
                    u32x4 w; w.x = pk2(v0[0], v0[1]); w.y = pk2(v0[2], v0[3]); w.z = pk2(v1[0], v1[1]); w.w = pk2(v1[2], v1[3]);
                    if (MODE == 2 && rope) *(u32x4*)(kr + (size_t)row * 64 + (col - 1280)) = w;
                    *(u32x4*)(rowp + bj * HALF) = w;
                }
                if (MODE == 2) {
                    ss += shflx(ss, fr + 16 * fq, 16); ss += shflx(ss, fr + 16 * fq, 32);
                    if (fq == 0) part_out[(size_t)row * 32 + u.pn * 4 + wc] = ss;
                }
                asm volatile("" ::: "memory");
            }
    }
};
template <bool LAST> struct EpiResidual {
    static constexpr bool PERM = false, AFTER_DRAIN = false;
    const float* base; float* out; bf16_t* xb; float* part_out;
    __device__ __forceinline__ void operator()(const f32x4 (&acc)[2][2][4][2], const Unit& u, int wr, int wc, int fr, int fq) const {
        const int row0 = u.pm * BM + wr * 64 + fr; const int col0 = u.pn * BM + wc * 32 + 4 * fq;
#pragma unroll
        for (int ai = 0; ai < 2; ++ai)
#pragma unroll
            for (int m = 0; m < 4; ++m) {
                const int row = row0 + ai * HALF + m * 16; const size_t off = (size_t)row * DM + col0; float ss = 0.f;
#pragma unroll
                for (int bj = 0; bj < 2; ++bj)
#pragma unroll
                    for (int n = 0; n < 2; ++n) {
                        const size_t o = off + bj * HALF + n * 16;
                        const f32x4 v = *(const f32x4*)(base + o) + acc[ai][bj][m][n];
                        if (!LAST) *(f32x4*)(out + o) = v;
                        u32x2 w; w.x = pk2(v[0], v[1]); w.y = pk2(v[2], v[3]); *(u32x2*)(xb + o) = w;
                        ss += (v[0] * v[0] + v[1] * v[1]) + (v[2] * v[2] + v[3] * v[3]);
                    }
                ss += shflx(ss, fr + 16 * fq, 16); ss += shflx(ss, fr + 16 * fq, 32);
                if (fq == 0) part_out[(size_t)row * 32 + u.pn * 4 + wc] = ss;
                asm volatile("" ::: "memory");
            }
    }
};
template <class Epi, class Sched, bool ALIGN_EPI = false, bool SP2 = false>
__device__ __forceinline__ void gemm_phase(PG8_LAS unsigned char* lds, const Gemm g, const Sched& S, const Epi& E, const int wid_in) {
    const int lane_ = fresh_lane();
    const int wid = wid_in, lane = lane_, tid = wid * 64 + lane, wr = wid >> 2, wc = wid & 3, fr = lane & 15, fq = lane >> 4;
    const int K = g.K, nt = K / BK;
    unsigned voffA[2], voffB[2];
#pragma unroll
    for (int i = 0; i < 2; ++i) { int R, C; stage_rc(tid * 16 + i * 8192, R, C); const int Rb = Epi::PERM ? ((R & ~31) + perm32(R & 31)) : R;
        voffA[i] = (unsigned)(R * g.lda + C) * 2u; voffB[i] = (unsigned)(Rb * K + C) * 2u; }
    const size_t kstep = (size_t)(BK * 2);
    const size_t hstep = (size_t)HALF * K * 2;
    const size_t tstep = 2 * hstep; const size_t hstepA = (size_t)HALF * g.lda * 2, tstepA = 2 * hstepA;
    const unsigned ldsw = (unsigned)wid * 1024u;
    const int aoff = lds_byte(wr * 64 + fr, fq * 8), boff = lds_byte(wc * 32 + fr, fq * 8);
#define PG8_SA(b, h) (((b) * 2 + (h)) * HTB)
#define PG8_SB(b, h) ((4 + (b) * 2 + (h)) * HTB)
#define PG8_STAGE(bufoff, gbase, voff) do { _Pragma("unroll") for (int _i = 0; _i < 2; ++_i) \
        __builtin_amdgcn_global_load_lds((const unsigned*)((const char*)(gbase) + (voff)[_i]), (PG8_LAS unsigned*)(lds + (bufoff) + ldsw + _i * 8192), 16, 0, 0); } while (0)
#define PG8_LDA(dst, b, h) do { _Pragma("unroll") for (int m = 0; m < 4; ++m) _Pragma("unroll") for (int k = 0; k < 2; ++k) dst[m][k] = *(const PG8_LAS bf16x8*)(lds + PG8_SA(b, h) + aoff + m * 2048 + k * 1024); } while (0)
#define PG8_LDB(dst, b, h) do { _Pragma("unroll") for (int n = 0; n < 2; ++n) _Pragma("unroll") for (int k = 0; k < 2; ++k) dst[n][k] = *(const PG8_LAS bf16x8*)(lds + PG8_SB(b, h) + boff + n * 2048 + k * 1024); } while (0)
#define PG8_MMA(ai, bj, At, Bt) do { __builtin_amdgcn_s_setprio(1); _Pragma("unroll") for (int m = 0; m < 4; ++m) _Pragma("unroll") for (int n = 0; n < 2; ++n) _Pragma("unroll") for (int k = 0; k < 2; ++k) \
        acc[ai][bj][m][n] = __builtin_amdgcn_mfma_f32_16x16x32_bf16(Bt[n][k], At[m][k], acc[ai][bj][m][n], 0, 0, 0); __builtin_amdgcn_s_setprio(0); } while (0)
#define PG8_WAIT_V(n) asm volatile("s_waitcnt vmcnt(" #n ")" ::: "memory")
#define PG8_WAIT_L(n) asm volatile("s_waitcnt lgkmcnt(" #n ")" ::: "memory")
#define PG8_BAR __builtin_amdgcn_s_barrier()
#define PG8_SCHED __builtin_amdgcn_sched_barrier(0)
    Unit cur, nxt; int ui = 0;
    if (!S.next(0, cur)) return;
    f32x4 acc[2][2][4][2];
#pragma unroll
    for (int a = 0; a < 2; ++a)
#pragma unroll
        for (int b = 0; b < 2; ++b)
#pragma unroll
            for (int m = 0; m < 4; ++m)
#pragma unroll
                for (int n = 0; n < 2; ++n) acc[a][b][m][n] = (f32x4){0.f, 0.f, 0.f, 0.f};
    bf16x8 At[4][2], B0[2][2], B1[2][2];
    const char* cA = (const char*)g.A + (size_t)cur.pm * tstepA; const char* cB = (const char*)g.Bt + (size_t)cur.pn * tstep;
    S.a_ready(cur);
    if constexpr (SP2) {
        PG8_STAGE(PG8_SB(0, 0), cB, voffB); PG8_STAGE(PG8_SB(0, 1), cB + hstep, voffB); PG8_STAGE(PG8_SA(0, 0), cA, voffA); PG8_STAGE(PG8_SA(0, 1), cA + hstepA, voffA);
        if (wr == 1) PG8_BAR;
        PG8_WAIT_V(2); PG8_BAR;
        PG8_STAGE(PG8_SB(1, 0), cB + kstep, voffB); PG8_STAGE(PG8_SA(1, 0), cA + kstep, voffA); PG8_STAGE(PG8_SB(1, 1), cB + hstep + kstep, voffB);
        PG8_WAIT_V(6); PG8_BAR;
    } else {
        PG8_STAGE(PG8_SB(0, 0), cB, voffB); PG8_STAGE(PG8_SA(0, 0), cA, voffA); PG8_STAGE(PG8_SB(0, 1), cB + hstep, voffB); PG8_STAGE(PG8_SA(0, 1), cA + hstepA, voffA);
        if (wr == 1) PG8_BAR;
        PG8_WAIT_V(4); PG8_BAR;
        PG8_STAGE(PG8_SB(1, 0), cB + kstep, voffB); PG8_STAGE(PG8_SA(1, 0), cA + kstep, voffA); PG8_STAGE(PG8_SB(1, 1), cB + hstep + kstep, voffB);
        PG8_WAIT_V(6); PG8_BAR;
    }
    for (;;) {
        const bool has_next = S.next(ui + 1, nxt);
        const char* nA = has_next ? (const char*)g.A + (size_t)nxt.pm * tstepA : cA; const char* nB = has_next ? (const char*)g.Bt + (size_t)nxt.pn * tstep : cB;
        for (int t = 0; t < nt; t += 2) {
            const bool last = (t == nt - 2);
            const char* a1 = cA + (size_t)(t + 1) * kstep;
            const char* a2 = last ? nA : cA + (size_t)(t + 2) * kstep; const char* b2 = last ? nB : cB + (size_t)(t + 2) * kstep;
            const char* a3 = a2 + kstep; const char* b3 = b2 + kstep;
            if (last && has_next) S.a_ready(nxt);
            if constexpr (SP2) {
            PG8_LDB(B0, 0, 0); PG8_LDB(B1, 0, 1); PG8_SCHED; PG8_LDA(At, 0, 0); PG8_STAGE(PG8_SA(1, 1), a1 + hstepA, voffA);
            PG8_WAIT_V(8); PG8_WAIT_L(0); PG8_BAR; PG8_MMA(0, 0, At, B0); PG8_MMA(0, 1, At, B1); PG8_BAR; PG8_SCHED;
            PG8_LDA(At, 0, 1); PG8_STAGE(PG8_SB(0, 0), b2, voffB); PG8_STAGE(PG8_SB(0, 1), b2 + hstep, voffB); PG8_STAGE(PG8_SA(0, 0), a2, voffA);
            PG8_WAIT_V(8); PG8_WAIT_L(0); PG8_BAR; PG8_MMA(1, 0, At, B0); PG8_MMA(1, 1, At, B1); PG8_BAR; PG8_SCHED;
            PG8_LDB(B0, 1, 0); PG8_LDB(B1, 1, 1); PG8_SCHED; PG8_LDA(At, 1, 0); PG8_STAGE(PG8_SA(0, 1), a2 + hstepA, voffA);
            PG8_WAIT_V(8); PG8_WAIT_L(0); PG8_BAR; PG8_MMA(0, 0, At, B0); PG8_MMA(0, 1, At, B1); PG8_BAR; PG8_SCHED;
            PG8_LDA(At, 1, 1); PG8_STAGE(PG8_SB(1, 0), b3, voffB); PG8_STAGE(PG8_SB(1, 1), b3 + hstep, voffB); PG8_STAGE(PG8_SA(1, 0), a3, voffA);
            PG8_WAIT_V(8); PG8_WAIT_L(0); PG8_BAR; PG8_MMA(1, 0, At, B0); PG8_MMA(1, 1, At, B1); PG8_BAR; PG8_SCHED;
            } else {
            PG8_LDB(B0, 0, 0); PG8_SCHED; PG8_LDA(At, 0, 0); PG8_STAGE(PG8_SA(1, 1), a1 + hstepA, voffA);
            PG8_WAIT_L(8); PG8_BAR; PG8_WAIT_L(0); PG8_MMA(0, 0, At, B0); PG8_BAR; PG8_SCHED;
            PG8_LDB(B1, 0, 1); PG8_STAGE(PG8_SB(0, 0), b2, voffB);
            PG8_BAR; PG8_WAIT_L(0); PG8_MMA(0, 1, At, B1); PG8_BAR;
            PG8_LDA(At, 0, 1); PG8_STAGE(PG8_SA(0, 0), a2, voffA);
            PG8_BAR; PG8_WAIT_L(0); PG8_MMA(1, 0, At, B0); PG8_BAR; PG8_SCHED;
            PG8_STAGE(PG8_SB(0, 1), b2 + hstep, voffB);
            PG8_WAIT_V(6); PG8_BAR; PG8_MMA(1, 1, At, B1); PG8_BAR;
            PG8_LDB(B0, 1, 0); PG8_SCHED; PG8_LDA(At, 1, 0); PG8_STAGE(PG8_SA(0, 1), a2 + hstepA, voffA);
            PG8_WAIT_L(8); PG8_BAR; PG8_WAIT_L(0); PG8_MMA(0, 0, At, B0); PG8_BAR; PG8_SCHED;
            PG8_LDB(B1, 1, 1); PG8_STAGE(PG8_SB(1, 0), b3, voffB);
            PG8_BAR; PG8_WAIT_L(0); PG8_MMA(0, 1, At, B1); PG8_BAR;
            PG8_LDA(At, 1, 1); PG8_STAGE(PG8_SA(1, 0), a3, voffA);
            PG8_BAR; PG8_WAIT_L(0); PG8_MMA(1, 0, At, B0); PG8_BAR; PG8_SCHED;
            PG8_STAGE(PG8_SB(1, 1), b3 + hstep, voffB);
            PG8_WAIT_V(6); PG8_BAR; PG8_MMA(1, 1, At, B1); PG8_BAR;
            }
        }
        if constexpr (ALIGN_EPI) { if (wr == 0) PG8_BAR; }
        if constexpr (!Epi::AFTER_DRAIN) { E(acc, cur, wr, wc, fr, fq); S.done(cur); }
        if (!has_next) break;
#pragma unroll
        for (int a = 0; a < 2; ++a)
#pragma unroll
            for (int b = 0; b < 2; ++b)
#pragma unroll
                for (int m = 0; m < 4; ++m)
#pragma unroll
                    for (int n = 0; n < 2; ++n) acc[a][b][m][n] = (f32x4){0.f, 0.f, 0.f, 0.f};
        cur = nxt; cA = nA; cB = nB; ++ui;
        if constexpr (ALIGN_EPI) { if (wr == 1) PG8_BAR; }
    }
    PG8_WAIT_V(0);
    if constexpr (!ALIGN_EPI) { if (wr == 0) PG8_BAR; }
    PG8_BAR;
    if constexpr (Epi::AFTER_DRAIN) { E.fused(acc, cur, wr, wc, fr, fq, lds, wid, lane); S.done(cur); }
#undef PG8_SA
#undef PG8_SB
#undef PG8_STAGE
#undef PG8_LDA
#undef PG8_LDB
#undef PG8_MMA
#undef PG8_WAIT_V
#undef PG8_WAIT_L
#undef PG8_BAR
#undef PG8_SCHED
}
}

#define MFMA32(a, b, c) __builtin_amdgcn_mfma_f32_32x32x16_bf16((a), (b), (c), 0, 0, 0)
DI int crow(int reg, int h) { return (reg & 3) + 8 * (reg >> 2) + 4 * h; }
DI float fexp2(float x) { return __builtin_amdgcn_exp2f(x); }
DI bf16x8 pack8(const f32x16& x, int s) {
    u32x4 p; p.x = pk2(x[8 * s + 0], x[8 * s + 1]); p.y = pk2(x[8 * s + 2], x[8 * s + 3]); p.z = pk2(x[8 * s + 4], x[8 * s + 5]); p.w = pk2(x[8 * s + 6], x[8 * s + 7]);
    return __builtin_bit_cast(bf16x8, p);
}
DI bf16x8 tr_pair(LAS const unsigned char* p0, LAS const unsigned char* p1) {
    const s16x4 lo = __builtin_amdgcn_ds_read_tr16_b64_v4i16((LAS s16x4*)p0);
    const s16x4 hi = __builtin_amdgcn_ds_read_tr16_b64_v4i16((LAS s16x4*)p1);
    return __builtin_shufflevector(lo, hi, 0, 1, 2, 3, 4, 5, 6, 7);
}
template <int DQK, int KSTR> DI f32x16 st_block(const bf16x8 (&qf)[DQK / 16], LAS const unsigned char* Kt, int kb, int r, int h) {
    f32x16 s;
#pragma unroll
    for (int i = 0; i < 16; ++i) s[i] = 0.f;
    LAS const unsigned char* kp = Kt + (32 * kb + r) * KSTR + 16 * h;
#pragma unroll
    for (int kk = 0; kk < DQK / 16; ++kk) { const bf16x8 kf = *(LAS const bf16x8*)(kp + 32 * kk); s = MFMA32(kf, qf[kk], s); }
    return s;
}
template <int DV, int VSTR> DI void pv_block(f32x16 (&o)[DV / 32], const f32x16& p, LAS const unsigned char* Vt, int kb, int vlane) {
#pragma unroll
    for (int st = 0; st < 2; ++st) {
        const bf16x8 pf = pack8(p, st);
        LAS const unsigned char* vp = Vt + vlane + (32 * kb + 16 * st) * VSTR;
#pragma unroll
        for (int db = 0; db < DV / 32; ++db) { const bf16x8 vf = tr_pair(vp + 64 * db, vp + 8 * VSTR + 64 * db); o[db] = MFMA32(vf, pf, o[db]); }
    }
}
#define SCHED_FENCE() __builtin_amdgcn_sched_barrier(0)
#ifndef TC_CUT
#define TC_CUT 0
#endif
template <int DQK, int DV, int KSTR, int VSTR, bool PLAINB, class Fix, bool CUTOK = false>
DI void tile_compute(const bf16x8 (&qf)[DQK / 16], LAS const unsigned char* Kt, LAS const unsigned char* Vt, f32x16 (&o)[DV / 32], float& m, float& l, int r, int h, int vlane, const Fix& fix, const bool plain, const float pb) {
    constexpr int NKK = DQK / 16, KC = 2, NCH = NKK / KC, NDB = DV / 32;
    static_assert(NKK % KC == 0, "chunking");
    f32x16 s0, s1;
#pragma unroll
    for (int i = 0; i < 16; ++i) { s0[i] = 0.f; s1[i] = 0.f; }
    LAS const unsigned char* kp = Kt + r * KSTR + 16 * h;
    bf16x8 ka[2][KC], kb[2][KC];
#pragma unroll
    for (int kk = 0; kk < KC; ++kk) { ka[0][kk] = *(LAS const bf16x8*)(kp + 32 * kk); kb[0][kk] = *(LAS const bf16x8*)(kp + 32 * KSTR + 32 * kk); }
#pragma unroll
    for (int c = 0; c < NCH; ++c) {
        if (c + 1 < NCH) {
#pragma unroll
            for (int kk = 0; kk < KC; ++kk) { ka[(c + 1) & 1][kk] = *(LAS const bf16x8*)(kp + 32 * ((c + 1) * KC + kk)); kb[(c + 1) & 1][kk] = *(LAS const bf16x8*)(kp + 32 * KSTR + 32 * ((c + 1) * KC + kk)); }
        }
        SCHED_FENCE();
#pragma unroll
        for (int kk = 0; kk < KC; ++kk) { s0 = MFMA32(ka[c & 1][kk], qf[c * KC + kk], s0); s1 = MFMA32(kb[c & 1][kk], qf[c * KC + kk], s1); }
        SCHED_FENCE();
    }
    if (TC_CUT == 1 && CUTOK) { o[0] = o[0] + s0 + s1; return; }
    bf16x8 vf[2][NDB];
    LAS const unsigned char* vp = Vt + vlane;
#pragma unroll
    for (int db = 0; db < NDB; ++db) vf[0][db] = tr_pair(vp + 64 * db, vp + 8 * VSTR + 64 * db);
    if (plain) {
        if (PLAINB) {
#pragma unroll
            for (int i = 0; i < 16; ++i) { s0[i] += pb; s1[i] += pb; }
        }
    } else {
#pragma unroll
        for (int i = 0; i < 16; ++i) { s0[i] = fix(s0[i], crow(i, h)); s1[i] = fix(s1[i], 32 + crow(i, h)); }
    }
    float mx = NEGBIG;
#pragma unroll
    for (int i = 0; i < 16; ++i) mx = fmaxf(mx, fmaxf(s0[i], s1[i]));
    mx = fmaxf(mx, shflx(mx, r + 32 * h, 32));
    const float m_old = m, mn = fmaxf(m, mx), alpha = fexp2(m - mn);
    float rs = 0.f;
#pragma unroll
    for (int i = 0; i < 16; ++i) { s0[i] = fexp2(s0[i] - mn); s1[i] = fexp2(s1[i] - mn); rs += s0[i] + s1[i]; }
    rs += shflx(rs, r + 32 * h, 32);
    l = l * alpha + rs; m = mn;
    if (TC_CUT == 2 && CUTOK) { o[0] = o[0] + s0 + s1; return; }
    if (__any(mx > m_old)) {
#pragma unroll
        for (int db = 0; db < NDB; ++db) o[db] = o[db] * alpha;
    }
    SCHED_FENCE();
#pragma unroll
    for (int step = 0; step < 4; ++step) {
        if (step < 3) {
            LAS const unsigned char* vq = vp + (16 * (step + 1)) * VSTR;
#pragma unroll
            for (int db = 0; db < NDB; ++db) vf[(step + 1) & 1][db] = tr_pair(vq + 64 * db, vq + 8 * VSTR + 64 * db);
        }
        const bf16x8 pf = pack8((step >> 1) ? s1 : s0, step & 1);
        SCHED_FENCE();
#pragma unroll
        for (int db = 0; db < NDB; ++db) o[db] = MFMA32(vf[step & 1][db], pf, o[db]);
        SCHED_FENCE();
    }
}

constexpr int L0_KSTR = 144, L0_VSTR = 192, L0_KSZ = 64 * L0_KSTR, L0_BUF = L0_KSZ + 64 * L0_VSTR;
constexpr int OFIN_OFF = 2 * L0_BUF, MISC_OFF = 110592, BT_OFF = MISC_OFF, PSUM_OFF = MISC_OFF + 4096, PSLC_OFF = PSUM_OFF + 16384, SEL_OFF = PSLC_OFF + 32 * 33 * 4, SLOT_OFF = SEL_OFF + 128;
constexpr int LDS_BYTES = 139264;
static_assert(OFIN_OFF + 65536 <= MISC_OFF && SLOT_OFF + 4 <= LDS_BYTES - 16 && 8 * 16640 - 768 <= LDS_BYTES - 16, "LDS map");
struct KVSrc { const bf16_t* k; const bf16_t* v; int stride; };

template <int MODE> struct Fix0 {
    int tq, kpos0, W; LAS const float* bt; bool far, selbit; float bfar;
    DI float operator()(float s, int kl) const {
        if (MODE == 2) { const int c = kpos0 + kl, cd = tq - (16 * c + 31); const bool ok = cd >= 0 && c < 127; const int dd = cd < 0 ? 0 : (cd > 127 ? 127 : cd); return ok ? s + bt[dd] : NEGBIG; }
        const int dist = tq - (kpos0 + kl);
        const bool ok = MODE == 0 ? ((unsigned)dist < (unsigned)W) : (selbit && dist >= 0);
        float b = bfar; if (!far) { const int dd = dist < 0 ? 0 : (dist > 127 ? 127 : dist); b = bt[dd]; }
        return ok ? s + b : NEGBIG;
    }
};
struct FixPlain { float b; DI float operator()(float s, int) const { return s + b; } };
struct FixNone { DI float operator()(float s, int) const { return s; } };
DI u32x4 ldg16(const bf16_t* p) { return *(const u32x4*)p; }
template <int MODE> DI void l0_run(unsigned tiles, const KVSrc src, LAS unsigned char* lds, const bf16x8 (&qf)[4], f32x16 (&o)[2], float& m, float& l,
                                   int tq, int t0, int W, unsigned selmask, LAS const float* bt, int tid, int r, int h, int vlane) {
    if (tiles == 0u) return;
    const int lrow = tid >> 3, lch = tid & 7; const unsigned goff = (unsigned)(lrow * src.stride + lch * 8) * 2u;
#define L0_LD(base, j) (*(const u32x4*)((const char*)((base) + (size_t)(64 * (j)) * src.stride) + goff))
    int jn = __builtin_ctz(tiles); tiles &= tiles - 1;
    {
        const u32x4 kreg = L0_LD(src.k, jn), vreg = L0_LD(src.v, jn);
        *(LAS u32x4*)(lds + lrow * L0_KSTR + lch * 16) = kreg; *(LAS u32x4*)(lds + L0_KSZ + lrow * L0_VSTR + lch * 16) = vreg;
    }
    __syncthreads();
    int buf = 0;
    for (;;) {
        const int j = jn; const bool more = tiles != 0u;
        u32x4 kreg, vreg;
        if (more) { jn = __builtin_ctz(tiles); tiles &= tiles - 1;
            kreg = L0_LD(src.k, jn); vreg = L0_LD(src.v, jn); }
        Fix0<MODE> fx; fx.tq = tq; fx.kpos0 = 64 * j; fx.W = W; fx.bt = bt; fx.bfar = bt[127];
        fx.far = (MODE != 2) && (t0 - (64 * j + 63) >= 113); fx.selbit = (selmask >> j) & 1u;
        LAS unsigned char* B = lds + buf * L0_BUF;
        bool plain = false;
        if (MODE == 0) plain = fx.far && (t0 + 31 - 64 * j < W);
        if (MODE == 1) plain = fx.far && __all(fx.selbit);
        tile_compute<64, 64, L0_KSTR, L0_VSTR, true>(qf, B, B + L0_KSZ, o, m, l, r, h, vlane, fx, plain, fx.bfar);
        if (more) { LAS unsigned char* Bn = lds + (buf ^ 1) * L0_BUF; *(LAS u32x4*)(Bn + lrow * L0_KSTR + lch * 16) = kreg; *(LAS u32x4*)(Bn + L0_KSZ + lrow * L0_VSTR + lch * 16) = vreg; }
        __syncthreads();
        if (!more) break;
        buf ^= 1;
    }
#undef L0_LD
}
DI int next_item(unsigned* ctr, LAS int* slot, int wave) {
    __syncthreads();
    if (wave == 0 && fresh_lane() == 0) *slot = (int)atomicAdd(ctr, 1u);
    __syncthreads();
    return *slot;
}
DI unsigned band_mask(int t0, int W) { const int lo = (t0 - W + 1 < 0 ? 0 : t0 - W + 1) >> 6, hi = (t0 + 31) >> 6; return (hi == 31 ? 0xffffffffu : ((1u << (hi + 1)) - 1u)) & ~((1u << lo) - 1u); }
template <int NDB> DI void store_o(const f32x16 (&o)[NDB], bf16_t* orow, int h) {
#pragma unroll
    for (int db = 0; db < NDB; ++db)
#pragma unroll
        for (int g = 0; g < 4; ++g) { u32x2 w; w.x = pk2(o[db][4 * g], o[db][4 * g + 1]); w.y = pk2(o[db][4 * g + 2], o[db][4 * g + 3]); *(u32x2*)(orow + 32 * db + 8 * g + 4 * h) = w; }
}

struct Ptrs {
    const float* in[23]; float* out; unsigned char* ws;
};
DI float sigmoidf_(float x) { return 1.0f / (1.0f + __expf(-x)); }

DI void mixerA_item(int item, unsigned char* ws, const float* sinks, LAS unsigned char* lds, int tid, int wave, int lane) {
    lane = fresh_lane(); tid = wave * 64 + lane;
    const int tt = item & 63, bg = item >> 6, b = bg >> 1, g = bg & 1, t0 = 32 * tt, hq = g * 8 + wave, r = lane & 31, h = lane >> 5, tq = t0 + r;
    const bf16_t* P0 = (const bf16_t*)(ws + WS_P0); const float* biasT = (const float*)(ws + WS_BIAS);
    LAS float* bt = (LAS float*)(lds + BT_OFF) + wave * 128; bt[lane] = biasT[hq * 128 + lane]; bt[lane + 64] = biasT[hq * 128 + lane + 64];
    const int i16 = lane & 15, vlane = ((i16 >> 2) + 4 * h) * L0_VSTR + 32 * ((lane >> 4) & 1) + 8 * (i16 & 3);
    const size_t rowb = (size_t)(b * SEQ + tq);
    bf16x8 qf[4];
#pragma unroll
    for (int kk = 0; kk < 4; ++kk) qf[kk] = __builtin_bit_cast(bf16x8, ldg16(P0 + rowb * EINP + hq * 64 + 16 * kk + 8 * h));
    f32x16 o[2];
#pragma unroll
    for (int i = 0; i < 16; ++i) { o[0][i] = 0.f; o[1][i] = 0.f; }
    float m = sinks[hq] * LOG2E, l = 1.0f;
    KVSrc src; src.k = P0 + (size_t)b * SEQ * EINP + 1024 + g * 64; src.v = P0 + (size_t)b * SEQ * EINP + 1152 + g * 64; src.stride = EINP;
    l0_run<0>(band_mask(t0, 128), src, lds, qf, o, m, l, tq, t0, 128, 0u, bt, tid, r, h, vlane);
    const float inv = 1.0f / l; o[0] = o[0] * inv; o[1] = o[1] * inv;
    store_o<2>(o, (bf16_t*)(ws + WS_OB0) + rowb * DM + hq * 64, h);
}

DI void mixerB_item(int item, unsigned char* ws, LAS unsigned char* lds, int tid, int wave, int lane) {
    lane = fresh_lane(); tid = wave * 64 + lane;
    const int tt = 63 - (item >> 4), bg = item & 15, b = bg >> 1, g = bg & 1, t0 = 32 * tt, hq = g * 8 + wave, r = lane & 31, h = lane >> 5, tq = t0 + r;
    const bf16_t* P0 = (const bf16_t*)(ws + WS_P0); const float* biasT = (const float*)(ws + WS_BIAS);
    LAS float* bt = (LAS float*)(lds + BT_OFF) + wave * 128; bt[lane] = biasT[(16 + hq) * 128 + lane]; bt[lane + 64] = biasT[(16 + hq) * 128 + lane + 64];
    LAS unsigned* psum = (LAS unsigned*)(lds + PSUM_OFF); LAS unsigned* pslc = (LAS unsigned*)(lds + PSLC_OFF); LAS unsigned* sel = (LAS unsigned*)(lds + SEL_OFF);
    for (int i = tid; i < 4096; i += NTHR) psum[i] = 0u;
    const int i16 = lane & 15, vlane = ((i16 >> 2) + 4 * h) * L0_VSTR + 32 * ((lane >> 4) & 1) + 8 * (i16 & 3);
    const size_t rowb = (size_t)(b * SEQ + tq);
    bf16x8 qf[4];
#pragma unroll
    for (int kk = 0; kk < 4; ++kk) qf[kk] = __builtin_bit_cast(bf16x8, ldg16(P0 + rowb * EINP + 1280 + hq * 64 + 16 * kk + 8 * h));
    const bf16_t* gp = P0 + rowb * EINP + 3072 + hq * 3;
    f32x16 o[2];
    LAS float* OF = (LAS float*)(lds + OFIN_OFF) + tid;
    {
        const bf16_t* KC = (const bf16_t*)(ws + WS_KC); const bf16_t* VC = (const bf16_t*)(ws + WS_VC);
        const int lrow = tid >> 3, lch = tid & 7;
#pragma unroll
        for (int jt = 0; jt < 2; ++jt) {
            const size_t off = ((size_t)(b * 128 + 64 * jt + lrow) * 2 + g) * 64 + lch * 8;
            LAS unsigned char* B = lds + jt * L0_BUF;
            *(LAS u32x4*)(B + lrow * L0_KSTR + lch * 16) = ldg16(KC + off); *(LAS u32x4*)(B + L0_KSZ + lrow * L0_VSTR + lch * 16) = ldg16(VC + off);
        }
        __syncthreads();
#pragma unroll
        for (int i = 0; i < 16; ++i) { o[0][i] = 0.f; o[1][i] = 0.f; }
        float m = NEGBIG, l = 0.f;
        Fix0<2> fx; fx.tq = tq; fx.W = 0; fx.bt = bt; fx.far = false; fx.selbit = false; fx.bfar = 0.f;
        fx.kpos0 = 0;  tile_compute<64, 64, L0_KSTR, L0_VSTR, false>(qf, lds, lds + L0_KSZ, o, m, l, r, h, vlane, fx, false, 0.f);
        fx.kpos0 = 64; tile_compute<64, 64, L0_KSTR, L0_VSTR, false>(qf, lds + L0_BUF, lds + L0_BUF + L0_KSZ, o, m, l, r, h, vlane, fx, false, 0.f);
        const float inv = (tq >= 31 ? 1.0f : 0.0f) / l;
#pragma unroll 1
        for (int q = 0; q < 4; ++q) {
            f32x16 s = st_block<64, L0_KSTR>(qf, lds + (q >> 1) * L0_BUF, q & 1, r, h);
            fx.kpos0 = 64 * (q >> 1);
            LAS unsigned* pr = psum + r * 128 + 32 * q + 4 * h;
#pragma unroll
            for (int i = 0; i < 16; ++i) { const float p = fexp2(fx(s[i], 32 * (q & 1) + crow(i, h)) - m) * inv;
                __hip_atomic_fetch_add(pr + (i & 3) + 8 * (i >> 2), (unsigned)(p * 268435456.0f + 0.5f), __ATOMIC_RELAXED, __HIP_MEMORY_SCOPE_WORKGROUP); }
        }
        o[0] = o[0] * inv; o[1] = o[1] * inv;
        const float g0 = sigmoidf_(bf2f(gp[0]));
#pragma unroll
        for (int i = 0; i < 16; ++i) { OF[i * NTHR] = o[0][i] * g0; OF[(16 + i) * NTHR] = o[1][i] * g0; }
    }
    __syncthreads();
    {
        const int tok = tid >> 4, nn = tid & 15;
#pragma unroll
        for (int e = 0; e < 2; ++e) { const int n = nn + 16 * e; const int c0 = (4 * n - 1 < 0) ? 0 : 4 * n - 1, c1 = (4 * n + 3 > 126) ? 126 : 4 * n + 3; unsigned v = 0u;
            for (int c = c0; c <= c1; ++c) v += psum[tok * 128 + c];
            pslc[tok * 33 + n] = v; }
        __syncthreads();
        const int t = t0 + tok, cur = t >> 6, quota = 8 - (cur == 0 ? 1 : (cur == 1 ? 2 : 3));
        bool sb[2];
#pragma unroll
        for (int e = 0; e < 2; ++e) { const int n = nn + 16 * e;
            const bool forced = (n == 0) || (n == cur) || (n == cur - 1), cand = (n >= 1) && (n <= cur - 2);
            const unsigned v = pslc[tok * 33 + n]; int rank = 0;
            _Pragma("unroll 1") for (int n2 = 1; n2 <= cur - 2; ++n2) { const unsigned v2 = pslc[tok * 33 + n2]; rank += (v2 > v || (v2 == v && n2 < n)) ? 1 : 0; }
            sb[e] = forced || (cand && rank < quota); }
        const unsigned long long b0 = __ballot(sb[0]), b1 = __ballot(sb[1]);
        const int k = (lane >> 4);
        if (nn == 0) sel[tok] = (unsigned)((b0 >> (16 * k)) & 0xffffull) | ((unsigned)((b1 >> (16 * k)) & 0xffffull) << 16);
        __syncthreads();
    }
    const unsigned selm = sel[r];
    unsigned U = selm;
#pragma unroll
    for (int d = 1; d < 32; d <<= 1) U |= shflxu(U, lane, d);
    U = (unsigned)__builtin_amdgcn_readfirstlane((int)U);
    const size_t bbase = (size_t)b * SEQ * EINP;
    {
#pragma unroll
        for (int i = 0; i < 16; ++i) { o[0][i] = 0.f; o[1][i] = 0.f; }
        float m = NEGBIG, l = 0.f;
        KVSrc src; src.k = P0 + bbase + 2560 + g * 64; src.v = P0 + bbase + 2688 + g * 64; src.stride = EINP;
        l0_run<1>(U, src, lds, qf, o, m, l, tq, t0, 0, selm, bt, tid, r, h, vlane);
        const float sc = sigmoidf_(bf2f(gp[1])) / l;
#pragma unroll
        for (int i = 0; i < 16; ++i) { OF[i * NTHR] += o[0][i] * sc; OF[(16 + i) * NTHR] += o[1][i] * sc; }
    }
    {
#pragma unroll
        for (int i = 0; i < 16; ++i) { o[0][i] = 0.f; o[1][i] = 0.f; }
        float m = NEGBIG, l = 0.f;
        KVSrc src; src.k = P0 + bbase + 2816 + g * 64; src.v = P0 + bbase + 2944 + g * 64; src.stride = EINP;
        l0_run<0>(band_mask(t0, 512), src, lds, qf, o, m, l, tq, t0, 512, 0u, bt, tid, r, h, vlane);
        const float sc = sigmoidf_(bf2f(gp[2])) / l;
#pragma unroll
        for (int i = 0; i < 16; ++i) { o[0][i] = OF[i * NTHR] + o[0][i] * sc; o[1][i] = OF[(16 + i) * NTHR] + o[1][i] * sc; }
    }
    store_o<2>(o, (bf16_t*)(ws + WS_OB0) + rowb * DM + 1024 + hq * 64, h);
}

DI float gelu_tanh(float x) { const float u = 0.7978845608028654f * (x + 0.044715f * x * x * x); return 0.5f * x * (1.0f + tanhf(u)); }
DI void compress_item(int item, unsigned char* ws, const float* pos_k, const float* pos_v, LAS unsigned char* lds, int tid, int wave, int lane) {
    lane = fresh_lane(); tid = wave * 64 + lane;
    const int kv = item >> 6, rb = item & 63, r = lane & 31, h = lane >> 5;
    const bf16_t* P0 = (const bf16_t*)(ws + WS_P0);
    const float* pos = kv ? pos_v : pos_k;
    const bf16_t* w1t = (const bf16_t*)(ws + (kv ? WS_CW1V : WS_CW1K)); const bf16_t* w2t = (const bf16_t*)(ws + (kv ? WS_CW2V : WS_CW2K));
    bf16_t* dst = (bf16_t*)(ws + (kv ? WS_VC : WS_KC));
    int rho = 32 * rb + r; if (rho > 2031) rho = 2031;
    const int b = rho / 254, rem = rho % 254, c = rem >> 1, g = rem & 1;
    const bf16_t* src = P0 + (size_t)(b * SEQ + 16 * c) * EINP + (kv ? 2432 : 2304) + g * 64 + 8 * h;
    const bf16_t* wrow = w1t + (size_t)(32 * wave + r) * 2048 + 8 * h;
    const float* prow = pos + 8 * h;
    f32x16 acc;
#pragma unroll
    for (int i = 0; i < 16; ++i) acc[i] = 0.f;
#pragma unroll 4
    for (int kk = 0; kk < 128; ++kk) {
        const int l = kk >> 2, d = 16 * (kk & 3);
        const u32x4 a = ldg16(src + (size_t)l * EINP + d); const f32x4 p0 = *(const f32x4*)(prow + l * 64 + d), p1 = *(const f32x4*)(prow + l * 64 + d + 4);
        u32x4 aa; aa.x = pk2(bflo(a.x) + p0[0], bfhi(a.x) + p0[1]); aa.y = pk2(bflo(a.y) + p0[2], bfhi(a.y) + p0[3]);
        aa.z = pk2(bflo(a.z) + p1[0], bfhi(a.z) + p1[1]); aa.w = pk2(bflo(a.w) + p1[2], bfhi(a.w) + p1[3]);
        const bf16x8 bf = __builtin_bit_cast(bf16x8, ldg16(wrow + 16 * kk));
        acc = MFMA32(__builtin_bit_cast(bf16x8, aa), bf, acc);
    }
    LAS bf16_t* Hs = (LAS bf16_t*)lds;
#pragma unroll
    for (int i = 0; i < 16; ++i) { const float v = gelu_tanh(acc[i]); Hs[crow(i, h) * 264 + 32 * wave + r] = (bf16_t)(pk2(v, 0.f) & 0xffffu); }
    __syncthreads();
    if (wave < 2) {
        f32x16 a2;
#pragma unroll
        for (int i = 0; i < 16; ++i) a2[i] = 0.f;
#pragma unroll
        for (int kk = 0; kk < 16; ++kk) {
            const bf16x8 af = *(LAS const bf16x8*)(Hs + r * 264 + 16 * kk + 8 * h);
            const bf16x8 bf = __builtin_bit_cast(bf16x8, ldg16(w2t + (size_t)(32 * wave + r) * 256 + 16 * kk + 8 * h));
            a2 = MFMA32(af, bf, a2);
        }
#pragma unroll
        for (int i = 0; i < 16; ++i) { const int rr = 32 * rb + crow(i, h);
            if (rr < 2032) { const int b2 = rr / 254, rem2 = rr % 254; dst[((size_t)(b2 * 128 + (rem2 >> 1)) * 2 + (rem2 & 1)) * 64 + 32 * wave + r] = (bf16_t)(pk2(a2[i], 0.f) & 0xffffu); } }
    }
    __syncthreads();
}

constexpr int C_KSTR = 400, C_VSTR = 320, C_KSZ = 64 * C_KSTR, C_BUF = C_KSZ + 64 * C_VSTR;
struct FixC { int tq, kpos0; DI float operator()(float s, int kl) const { return (kpos0 + kl) <= tq ? s : NEGBIG; } };
template <int VAR> DI void mla_item(int item, unsigned char* ws, LAS unsigned char* lds, int tid, int wave, int lane) {
    lane = fresh_lane(); tid = wave * 64 + lane;
    const int qb = 7 - (item >> 7), bh = item & 127, b = bh >> 4, hh = bh & 15, r = lane & 31, h = lane >> 5, tq = qb * 256 + 32 * wave + r;
    const bf16_t* Q1 = (const bf16_t*)(ws + WS_Q1); const bf16_t* KV1 = (const bf16_t*)(ws + WS_KV1); const bf16_t* KR = (const bf16_t*)(ws + WS_KR);
    const int i16 = lane & 15, vlane = ((i16 >> 2) + 4 * h) * C_VSTR + 32 * ((lane >> 4) & 1) + 8 * (i16 & 3);
    const size_t rowb = (size_t)(b * SEQ + tq);
    bf16x8 qf[12];
#pragma unroll
    for (int kk = 0; kk < 12; ++kk) qf[kk] = __builtin_bit_cast(bf16x8, ldg16(Q1 + rowb * QUP + hh * 192 + 16 * kk + 8 * h));
    f32x16 o[4];
#pragma unroll
    for (int d = 0; d < 4; ++d)
#pragma unroll
        for (int i = 0; i < 16; ++i) o[d][i] = 0.f;
    float m = NEGBIG, l = 0.f;
    const int ntile = 4 * qb + 4;
    const bf16_t* kvb = KV1 + (size_t)b * SEQ * KVUP + hh * 256; const bf16_t* krb = KR + (size_t)b * SEQ * 64;
    const int vrow0 = tid >> 4, vch = tid & 15, rrow = tid >> 3, rch = tid & 7;
    const unsigned kvoff = (unsigned)(vrow0 * KVUP + vch * 8) * 2u, kroff = (unsigned)(rrow * 64 + rch * 8) * 2u;
    u32x4 kreg[3], vreg[2];
#define MLA_LOAD(j) do { const char* tb_ = (const char*)(kvb + (size_t)(64 * (j)) * KVUP); const char* rb_ = (const char*)(krb + (size_t)(64 * (j)) * 64); \
        kreg[0] = *(const u32x4*)(tb_ + kvoff); kreg[1] = *(const u32x4*)(tb_ + kvoff + 32u * KVUP * 2u); kreg[2] = *(const u32x4*)(rb_ + kroff); \
        vreg[0] = *(const u32x4*)(tb_ + kvoff + 256u); vreg[1] = *(const u32x4*)(tb_ + kvoff + 32u * KVUP * 2u + 256u); } while (0)
#define MLA_STORE(B) do { *(LAS u32x4*)((B) + vrow0 * C_KSTR + vch * 16) = kreg[0]; *(LAS u32x4*)((B) + (vrow0 + 32) * C_KSTR + vch * 16) = kreg[1]; *(LAS u32x4*)((B) + rrow * C_KSTR + 256 + rch * 16) = kreg[2]; \
        *(LAS u32x4*)((B) + C_KSZ + vrow0 * C_VSTR + vch * 16) = vreg[0]; *(LAS u32x4*)((B) + C_KSZ + (vrow0 + 32) * C_VSTR + vch * 16) = vreg[1]; } while (0)
    MLA_LOAD(0); MLA_STORE(lds);
    __syncthreads();
    const int tqmax = qb * 256 + 32 * wave + 31;
    for (int j = 0; j < ntile; ++j) {
        const bool more = (j + 1 < ntile);
        if (more && VAR != 2) MLA_LOAD(j + 1);
        LAS unsigned char* B = lds + (j & 1) * C_BUF;
        if (VAR != 1 && 64 * j <= tqmax) {
            FixC fx; fx.tq = tq; fx.kpos0 = 64 * j;
            tile_compute<192, 128, C_KSTR, C_VSTR, false, FixC, (VAR == 2)>(qf, B, B + C_KSZ, o, m, l, r, h, vlane, fx, 64 * j + 63 <= tqmax - 31  , 0.f);
        }
        if (more && VAR != 2) { LAS unsigned char* Bn = lds + ((j + 1) & 1) * C_BUF; MLA_STORE(Bn); }
        __syncthreads();
    }
#undef MLA_LOAD
#undef MLA_STORE
    const float inv = 1.0f / l;
#pragma unroll
    for (int d = 0; d < 4; ++d) o[d] = o[d] * inv;
    store_o<4>(o, (bf16_t*)(ws + WS_OB1) + rowb * DM + hh * 128, h);
}

DI float wave_sum(float v, int lane) {
#pragma unroll
    for (int o = 1; o < 64; o <<= 1) v += shflx(v, lane, o);
    return v;
}
DI void wt_load(const float* W, int K, int N, int nblk, const float* gk, int item, int lane, f32x4 (&v)[16]) {
    const int kb = item / nblk, nb = item % nblk, k0 = 64 * kb, n0 = 64 * nb;
    const int lr = lane >> 4, lc = 4 * (lane & 15);
    const bool cvalid = (n0 + lc) < N;
    const float* wp = W + (size_t)(k0 + lr) * N + n0 + lc;
#pragma unroll
    for (int r = 0; r < 16; ++r) v[r] = cvalid ? *(const f32x4*)(wp + (size_t)(4 * r) * N) : (f32x4){0.f, 0.f, 0.f, 0.f};
    if (gk) {
#pragma unroll
        for (int r = 0; r < 16; ++r) v[r] = v[r] * gk[k0 + 4 * r + lr];
    }
}
DI void wt_finish(int K, int nblk, bf16_t* WT, int mode, LAS float* scr, int item, int lane, const f32x4 (&v)[16]) {
    const int kb = item / nblk, nb = item % nblk, k0 = 64 * kb, n0 = 64 * nb;
    const int lr = lane >> 4, lc = 4 * (lane & 15);
#pragma unroll
    for (int r = 0; r < 16; ++r) { LAS float* q = scr + (4 * r + lr) * 65 + lc; q[0] = v[r][0]; q[1] = v[r][1]; q[2] = v[r][2]; q[3] = v[r][3]; }
    const int nl = lane >> 3, c = lane & 7;
#pragma unroll
    for (int i = 0; i < 8; ++i) {
        const int ln = 8 * i + nl, n = n0 + ln; int srcl = ln; float scale = 1.0f;
        if (mode == 1) { if (n < 1024 || (n >= 1280 && n < 2304)) scale = 0.125f * LOG2E; }
        else if (mode == 2) { if (n >= 1280 && n < 1344) srcl = (ln >> 1) + 32 * (ln & 1); }
        else if (mode == 3) { if ((n % 192) >= 128) srcl = (ln >> 1) + 32 * (ln & 1); scale = 0.07216878364870322f * LOG2E; }
        const LAS float* sp = scr + (8 * c) * 65 + srcl;
        u32x4 o; o.x = pk2(sp[0 * 65] * scale, sp[1 * 65] * scale); o.y = pk2(sp[2 * 65] * scale, sp[3 * 65] * scale);
        o.z = pk2(sp[4 * 65] * scale, sp[5 * 65] * scale); o.w = pk2(sp[6 * 65] * scale, sp[7 * 65] * scale);
        *(u32x4*)(WT + (size_t)n * K + k0 + 8 * c) = o;
    }
}
#define WT_JOB(W_, K_, N_, NPAD_, DST_, GK_, MODE_) do { const int nblk_ = (NPAD_) / 64, cnt_ = ((K_) / 64) * nblk_; int first_ = (gw - wt_base) % ngw; if (first_ < 0) first_ += ngw; \
    for (int it_ = first_; it_ < cnt_; it_ += 2 * ngw) { f32x4 va_[16], vb_[16]; const bool two_ = it_ + ngw < cnt_;   \
        wt_load((W_), (K_), (N_), nblk_, (GK_), it_, lane, va_); if (two_) wt_load((W_), (K_), (N_), nblk_, (GK_), it_ + ngw, lane, vb_); \
        wt_finish((K_), nblk_, (bf16_t*)(ws + (DST_)), (MODE_), scr, it_, lane, va_); if (two_) wt_finish((K_), nblk_, (bf16_t*)(ws + (DST_)), (MODE_), scr, it_ + ngw, lane, vb_); } \
    wt_base = (wt_base + cnt_) % ngw; } while (0)
DI int t5_bucket(int d) {
    if (d < 16) return d;
    const int v = 16 + (int)(logf((float)d / 16.0f) / 2.0794415416798357f * 16.0f);
    return v > 31 ? 31 : v;
}

#define CAS __attribute__((address_space(4)))
DI const float* inp(int i) { const CAS char* ka = (const CAS char*)__builtin_amdgcn_kernarg_segment_ptr(); asm volatile("" : "+s"(ka)); return ((const float* const CAS*)ka)[i]; }
DI unsigned xcc_id() { return (unsigned)__builtin_amdgcn_s_getreg((3 << 11) | 20) & 7u; }
#ifndef REP_P0
#define REP_P0 0
#endif
#ifndef REP_A
#define REP_A 0
#endif
#ifndef REP_B
#define REP_B 0
#endif
#ifndef REP_C
#define REP_C 0
#endif
#ifndef REP_UP
#define REP_UP 0
#endif
#ifndef EN_PRO
#define EN_PRO 1
#endif
#ifndef EN_GEMM
#define EN_GEMM 1
#endif
#ifndef EN_A
#define EN_A 1
#endif
#ifndef EN_B
#define EN_B 1
#endif
#ifndef EN_C
#define EN_C 1
#endif
#define XB_TMO      128
#define XB_XCNT(j)  (256  + 64 * (j))
#define XB_XSUB(j)  (1280 + 64 * (j))
#define XB_XGEN(j)  (2304 + 64 * (j))
#define XB_TOP      3328
#define XB_TOPGEN   3392
#define XCD_BAR_WORDS 3456
#define XB_SPIN_CAP (1u << 18)

__device__ __forceinline__ unsigned xb_ld(unsigned* p)              { return __hip_atomic_load(p, __ATOMIC_RELAXED, __HIP_MEMORY_SCOPE_AGENT); }
__device__ __forceinline__ unsigned xb_add(unsigned* p, unsigned v) { return __hip_atomic_fetch_add(p, v, __ATOMIC_RELAXED, __HIP_MEMORY_SCOPE_AGENT); }
__device__ __forceinline__ unsigned xb_xcc_id() { return (unsigned)__builtin_amdgcn_s_getreg((3 << 11) | 20) & 0xFu; }
#define XB_SPIN(cond, bar) do { unsigned _sp = 0; while (cond) { __builtin_amdgcn_s_sleep(1); \
    if ((++_sp & 255u) == 0u) { if (xb_ld(&(bar)[XB_TMO])) break; if (_sp > XB_SPIN_CAP) { atomicAdd(&(bar)[XB_TMO], 1u); break; } } } } while (0)

struct XcdBarrier {
    unsigned* bar; unsigned x;
    volatile LAS unsigned* st;
};

__device__ __forceinline__ XcdBarrier xcd_barrier_post(unsigned* bar, volatile LAS unsigned* st, int wave) {
    XcdBarrier b; b.bar = bar; b.x = xb_xcc_id(); b.st = st;
    if (wave == 0 && fresh_lane() == 0) (void)xb_add(&bar[XB_XCNT(b.x)], 1u);
    return b;
}
__device__ __forceinline__ void xcd_barrier_complete(unsigned* bar, unsigned x, unsigned& nloc, unsigned& nx) {
    const unsigned G = gridDim.x * gridDim.y * gridDim.z;
    unsigned sum, cnt, mine, sp = 0u;
    for (;;) {
        sum = 0u; cnt = 0u; mine = 0u;
#pragma unroll
        for (unsigned j = 0; j < 16; ++j) { const unsigned c = xb_ld(&bar[XB_XCNT(j)]); sum += c; cnt += (c > 0u) ? 1u : 0u; mine = (j == x) ? c : mine; }
        if (sum == G) break;
        __builtin_amdgcn_s_sleep(1);
        if ((++sp & 255u) == 0u) { if (xb_ld(&bar[XB_TMO])) break; if (sp > XB_SPIN_CAP) { atomicAdd(&bar[XB_TMO], 1u); break; } }
    }
    nloc = mine > 0u ? mine : 1u; nx = cnt > 0u ? cnt : 1u;
}

__device__ __forceinline__ void xcd_barrier(const XcdBarrier& b, int wave) {
    asm volatile("s_waitcnt vmcnt(0)" ::: "memory");
    __syncthreads();
    if (wave == 0 && fresh_lane() == 0) {
        unsigned* bar = b.bar;
        __builtin_amdgcn_s_waitcnt(0);
        unsigned nloc = b.st[0], nx = b.st[1];
        if (nloc == 0u) { xcd_barrier_complete(bar, b.x, nloc, nx); b.st[0] = nloc; b.st[1] = nx; }
        const unsigned old = xb_add(&bar[XB_XSUB(b.x)], 1u);
        const unsigned gen = old / nloc;
        if (old + 1u == (gen + 1u) * nloc) {
            __builtin_amdgcn_fence(__ATOMIC_RELEASE, "agent");
            asm volatile("s_waitcnt vmcnt(0)" ::: "memory");
            const unsigned og = xb_add(&bar[XB_TOP], 1u);
            const unsigned tg = og / nx;
            if (og + 1u == (tg + 1u) * nx) xb_add(&bar[XB_TOPGEN], 1u);
            else XB_SPIN(xb_ld(&bar[XB_TOPGEN]) == tg, bar);
            __builtin_amdgcn_fence(__ATOMIC_ACQUIRE, "agent");
            xb_add(&bar[XB_XGEN(b.x)], 1u);
            asm volatile("s_waitcnt vmcnt(0)" ::: "memory");
        } else {
            XB_SPIN(xb_ld(&bar[XB_XGEN(b.x)]) == gen, bar);
            __builtin_amdgcn_fence(__ATOMIC_ACQUIRE, "agent");
            asm volatile("s_waitcnt vmcnt(0)" ::: "memory");
        }
    }
    __syncthreads();
}

__global__ void __launch_bounds__(NTHR, 2) fwd_kernel(Ptrs P) {
    extern __shared__ __attribute__((aligned(16))) unsigned char lds_raw[];
    LAS unsigned char* lds = (LAS unsigned char*)lds_raw;
    const int wave = __builtin_amdgcn_readfirstlane((int)threadIdx.x >> 6);
    int lane, tid;
#define FRESH_TID() do { lane = fresh_lane(); tid = wave * 64 + lane; } while (0)
    FRESH_TID();
    if (tid < 4) ((volatile LAS unsigned*)(lds + LDS_BYTES - 16))[tid] = 0u;
    __syncthreads();
    const int G = gridDim.x, bx = blockIdx.x, gw = bx * 8 + wave, ngw = G * 8;
    unsigned char* ws = (unsigned char*)inp(24);
    unsigned* ctl = (unsigned*)(ws + WS_CTL);
    const XcdBarrier xbar = xcd_barrier_post((unsigned*)(ws + WS_BAR), (volatile LAS unsigned*)(lds + LDS_BYTES - 16), wave);
    float* part = (float*)(ws + WS_PART); float* part2 = (float*)(ws + WS_PART2);
    bf16_t* XB = (bf16_t*)(ws + WS_XB);
    LAS float* scr = (LAS float*)(lds + wave * 17408);
    LAS int* slot = (LAS int*)(lds + SLOT_OFF);

    for (int rep_ = 0; rep_ <= REP_P0; ++rep_) {
    if (rep_) xcd_barrier(xbar, wave);
        if (bx == 0 && tid < 64) ctl[tid] = 0u;
        int wt_base = 0;
        WT_JOB(inp(3), DM, EIN, EINP, WS_WINE, inp(2), 1); WT_JOB(inp(11), DM, DM, DM, WS_WOUTE, (const float*)nullptr, 0); WT_JOB(inp(13), DM, OIN, OINP, WS_WINO, inp(12), 2);
        WT_JOB(inp(15), 768, QUP, QUP, WS_WQUP, inp(14), 3); WT_JOB(inp(17), 512, KVUP, KVUP, WS_WKVUP, inp(16), 0); WT_JOB(inp(18), DM, DM, DM, WS_WOUTO, (const float*)nullptr, 0);
        WT_JOB(inp(20), DM, FF, FF, WS_WUP, inp(19), 0); WT_JOB(inp(21), FF, DM, DM, WS_WDN, (const float*)nullptr, 0);
        WT_JOB(inp(7), 2048, 256, 256, WS_CW1K, (const float*)nullptr, 0); WT_JOB(inp(9), 2048, 256, 256, WS_CW1V, (const float*)nullptr, 0);
        WT_JOB(inp(8), 256, 64, 64, WS_CW2K, (const float*)nullptr, 0); WT_JOB(inp(10), 256, 64, 64, WS_CW2V, (const float*)nullptr, 0);
        const float* x = inp(0);
        for (int row = gw; row < MTOK; row += ngw) {
            const f32x4* xr = (const f32x4*)(x + (size_t)row * DM) + lane; u32x2* xo = (u32x2*)(XB + (size_t)row * DM) + lane; float s = 0.f;
#pragma unroll
            for (int j = 0; j < 8; ++j) { const f32x4 v = xr[64 * j]; s += (v[0] * v[0] + v[1] * v[1]) + (v[2] * v[2] + v[3] * v[3]); u32x2 w; w.x = pk2(v[0], v[1]); w.y = pk2(v[2], v[3]); xo[64 * j] = w; }
            s = wave_sum(s, lane);
            if (lane < 32) part[(size_t)row * 32 + lane] = lane == 0 ? s : 0.f;
        }
        const int gt = bx * NTHR + tid, ngt = G * NTHR;
        float* biasT = (float*)(ws + WS_BIAS); float* cosT = (float*)(ws + WS_COS); float* sinT = (float*)(ws + WS_SIN);
        { const float* rb = inp(1); for (int i = gt; i < 32 * 128; i += ngt) { const int hd = i >> 7, d = i & 127; biasT[i] = rb[t5_bucket(d) * 32 + hd] * LOG2E; } }
        for (int i = gt; i < 2048 * 32; i += ngt) { const int s = i >> 5, ii = i & 31; const float inv = 1.0f / powf(10000.0f, (float)(2 * ii) / 64.0f); const float ang = (float)s * inv; cosT[i] = cosf(ang); sinT[i] = sinf(ang); }
        bf16_t* KC = (bf16_t*)(ws + WS_KC); bf16_t* VC = (bf16_t*)(ws + WS_VC);
        for (int i = gt; i < 8 * 128; i += ngt) { const int b = i >> 7, e = i & 127; KC[(size_t)(b * 128 + 127) * 128 + e] = 0; VC[(size_t)(b * 128 + 127) * 128 + e] = 0; }
    }
    if (gridDim.y == 0x7fffu) cg::this_grid().sync();
    xcd_barrier(xbar, wave);
    {
        pg8::Gemm g{XB, (const bf16_t*)(ws + WS_WINE), MTOK, EINP, DM, DM}; pg8::StaticOrder S; S.init(MTOK, 3072, G, bx);
        pg8::EpiScale<0> E{(bf16_t*)(ws + WS_P0), EINP, part, nullptr, nullptr, nullptr, nullptr};
        if (EN_GEMM) pg8::gemm_phase<pg8::EpiScale<0>, pg8::StaticOrder, true, true>(lds, g, S, E, wave);
    }
    xcd_barrier(xbar, wave);
    FRESH_TID();
    {
        pg8::Gemm g{XB, (const bf16_t*)(ws + WS_WINE), MTOK, EINP, DM, DM}; pg8::TailOrder T{bx, 12};
        pg8::EpiScale<0> E{(bf16_t*)(ws + WS_P0), EINP, part, nullptr, nullptr, nullptr, nullptr};
        pg8::gemm_phase<pg8::EpiScale<0>, pg8::TailOrder, true, true>(lds, g, T, E, wave);
        __syncthreads();
        FRESH_TID();
    }
    {
        if (wave >= 4) __builtin_amdgcn_s_setprio(1);
        const float* pk_ = inp(5); const float* pv_ = inp(6); const float* sk_ = inp(4);
        for (;;) { const int it = next_item(ctl + 0, slot, wave); if (it >= 128) break; compress_item(it, ws, pk_, pv_, lds, tid, wave, lane); }
        const unsigned x0 = xcc_id();
        for (int s = 0; s < 8; ++s) { const int xq = (int)((x0 + s) & 7u);
            for (;;) { const int k = next_item(ctl + 16 + xq, slot, wave); if (k >= 128) break; mixerA_item((xq + 8 * (k & 1)) * 64 + (k >> 1), ws, sk_, lds, tid, wave, lane); } }
    }
    __builtin_amdgcn_s_setprio(0);
    xcd_barrier(xbar, wave);
    FRESH_TID();
    {
        if (wave >= 4) __builtin_amdgcn_s_setprio(1);
        const unsigned x0 = xcc_id();
        for (int s = 0; s < 8; ++s) { const int xq = (int)((x0 + s) & 7u);
            for (;;) { const int k = next_item(ctl + 32 + xq, slot, wave); if (k >= 128) break; mixerB_item(((k >> 1) << 4) | (xq + 8 * (k & 1)), ws, lds, tid, wave, lane); } }
    }
    __builtin_amdgcn_s_setprio(0);
    xcd_barrier(xbar, wave);
    {
        pg8::Gemm g{(const bf16_t*)(ws + WS_OB0), (const bf16_t*)(ws + WS_WOUTE), MTOK, DM, DM, DM}; pg8::StaticOrder S; S.init(MTOK, DM, G, bx);
        pg8::EpiResidual<false> E{inp(0), (float*)inp(23), XB, part};
        if (EN_GEMM) pg8::gemm_phase<pg8::EpiResidual<false>, pg8::StaticOrder, true, true>(lds, g, S, E, wave);
    }
    xcd_barrier(xbar, wave);
    {
        for (int rep_ = 0; rep_ <= REP_UP; ++rep_) {
            if (rep_) xcd_barrier(xbar, wave);
            pg8::Gemm g{XB, (const bf16_t*)(ws + WS_WUP), MTOK, FF, DM, DM}; pg8::StaticOrder S; S.init(MTOK, FF, G, bx);
            pg8::EpiScale<1> E{(bf16_t*)(ws + WS_HB), FF, part, nullptr, nullptr, nullptr, nullptr};
            if (EN_GEMM) pg8::gemm_phase<pg8::EpiScale<1>, pg8::StaticOrder, true, true>(lds, g, S, E, wave);
        }
        xcd_barrier(xbar, wave);
        {
            pg8::Gemm g{(const bf16_t*)(ws + WS_HB), (const bf16_t*)(ws + WS_WDN), MTOK, DM, FF, FF}; pg8::StaticOrder S; S.init(MTOK, DM, G, bx);
            float* outp = (float*)inp(23); pg8::EpiResidual<false> E{outp, outp, XB, part};
            if (EN_GEMM) pg8::gemm_phase<pg8::EpiResidual<false>, pg8::StaticOrder, true, true>(lds, g, S, E, wave);
        }
        xcd_barrier(xbar, wave);
    }
    {
            FRESH_TID();
            int wt_base = 0;
            WT_JOB(inp(20) + (size_t)DM * FF, DM, FF, FF, WS_WUP, inp(19) + DM, 0); WT_JOB(inp(21) + (size_t)FF * DM, FF, DM, DM, WS_WDN, (const float*)nullptr, 0);
            __syncthreads();
            {
                pg8::Gemm g{XB, (const bf16_t*)(ws + WS_WINO), MTOK, OINP, DM, DM}; pg8::StaticOrder S; S.init(MTOK, OINP, G, bx);
                pg8::EpiScale<2> E{(bf16_t*)(ws + WS_P1), OINP, part, part2, (bf16_t*)(ws + WS_KR), (const float*)(ws + WS_COS), (const float*)(ws + WS_SIN)};
                if (EN_GEMM) pg8::gemm_phase<pg8::EpiScale<2>, pg8::StaticOrder, true, true>(lds, g, S, E, wave);
            }
            xcd_barrier(xbar, wave);
            {
                pg8::Gemm g{(const bf16_t*)(ws + WS_P1), (const bf16_t*)(ws + WS_WQUP), MTOK, QUP, 768, OINP}; pg8::StaticOrder S; S.init(MTOK, QUP, G, bx);
                pg8::EpiScale<3> E{(bf16_t*)(ws + WS_Q1), QUP, part2, nullptr, nullptr, (const float*)(ws + WS_COS), (const float*)(ws + WS_SIN)};
                if (EN_GEMM) pg8::gemm_phase<pg8::EpiScale<3>, pg8::StaticOrder, true, true>(lds, g, S, E, wave);
            }
            {
                pg8::Gemm g{(const bf16_t*)(ws + WS_P1) + 768, (const bf16_t*)(ws + WS_WKVUP), MTOK, KVUP, 512, OINP}; pg8::StaticOrder S; S.init(MTOK, KVUP, G, bx);
                pg8::EpiScale<4> E{(bf16_t*)(ws + WS_KV1), KVUP, part2, nullptr, nullptr, nullptr, nullptr};
                if (EN_GEMM) pg8::gemm_phase<pg8::EpiScale<4>, pg8::StaticOrder, true, true>(lds, g, S, E, wave);
            }
            xcd_barrier(xbar, wave);
            FRESH_TID();
#ifndef MLA_PROBE
#define MLA_PROBE 0
#endif
            if (MLA_PROBE) {
                const unsigned x0 = xcc_id();
                for (int s = 0; s < 8; ++s) { const int xq = (int)((x0 + s) & 7u);
                    for (;;) { const int k = next_item(ctl + 56 + xq, slot, wave); if (k >= 128) break;
                        const int bh = ((k >> 5) * 4 + (k & 3)) * 8 + xq, q7 = (k & 31) >> 2;
                        mla_item<MLA_PROBE>((q7 << 7) | bh, ws, lds, tid, wave, lane); } }
                xcd_barrier(xbar, wave);
            }
            {
                if (wave >= 4) __builtin_amdgcn_s_setprio(1);
                const unsigned x0 = xcc_id();
                for (int s = 0; s < 8; ++s) { const int xq = (int)((x0 + s) & 7u);
                    for (;;) { const int k = next_item(ctl + 48 + xq, slot, wave); if (k >= 128) break;
                        const int bh = ((k >> 5) * 4 + (k & 3)) * 8 + xq, q7 = (k & 31) >> 2;
                        mla_item<0>((q7 << 7) | bh, ws, lds, tid, wave, lane); } }
            }
            __builtin_amdgcn_s_setprio(0);
            xcd_barrier(xbar, wave);
            {
                pg8::Gemm g{(const bf16_t*)(ws + WS_OB1), (const bf16_t*)(ws + WS_WOUTO), MTOK, DM, DM, DM}; pg8::StaticOrder S; S.init(MTOK, DM, G, bx);
                float* outp = (float*)inp(23); pg8::EpiResidual<false> E{outp, outp, XB, part};
                if (EN_GEMM) pg8::gemm_phase<pg8::EpiResidual<false>, pg8::StaticOrder, true, true>(lds, g, S, E, wave);
            }
            xcd_barrier(xbar, wave);
    }
    {
        for (int rep_ = 0; rep_ <= REP_UP; ++rep_) {
            if (rep_) xcd_barrier(xbar, wave);
            pg8::Gemm g{XB, (const bf16_t*)(ws + WS_WUP), MTOK, FF, DM, DM}; pg8::StaticOrder S; S.init(MTOK, FF, G, bx);
            pg8::EpiScale<1> E{(bf16_t*)(ws + WS_HB), FF, part, nullptr, nullptr, nullptr, nullptr};
            if (EN_GEMM) pg8::gemm_phase<pg8::EpiScale<1>, pg8::StaticOrder, true, true>(lds, g, S, E, wave);
        }
        xcd_barrier(xbar, wave);
        {
            pg8::Gemm g{(const bf16_t*)(ws + WS_HB), (const bf16_t*)(ws + WS_WDN), MTOK, DM, FF, FF}; pg8::StaticOrder S; S.init(MTOK, DM, G, bx);
            float* outp = (float*)inp(23); pg8::EpiResidual<true> E{outp, outp, XB, part};
            if (EN_GEMM) pg8::gemm_phase<pg8::EpiResidual<true>, pg8::StaticOrder, true, true>(lds, g, S, E, wave);
        }
        xcd_barrier(xbar, wave);
    }
    FRESH_TID();
    {
        const float* gf = inp(22); float* outp = (float*)inp(23);
        for (int row = gw; row < MTOK; row += ngw) {
            const f32x4* pr = (const f32x4*)(part + (size_t)row * 32); float s = 0.f;
#pragma unroll
            for (int i = 0; i < 8; ++i) { const f32x4 v = pr[i]; s += (v[0] + v[1]) + (v[2] + v[3]); }
            const float rs = __builtin_amdgcn_rsqf(s * (1.0f / 2048.0f) + EPS);
            f32x4* xr = (f32x4*)(outp + (size_t)row * DM) + lane; const f32x4* gr = (const f32x4*)gf + lane; const u32x2* xb = (const u32x2*)(XB + (size_t)row * DM) + lane;
#pragma unroll
            for (int j = 0; j < 8; ++j) { const u32x2 w = xb[64 * j]; const f32x4 gg = gr[64 * j]; f32x4 v; v[0] = bflo(w.x); v[1] = bfhi(w.x); v[2] = bflo(w.y); v[3] = bfhi(w.y); xr[64 * j] = v * rs * gg; }
        }
    }
}

extern "C" void kernel_launch(void* const* d_in, const int* in_sizes, int n_in, void* d_out, int out_size, void* d_ws, size_t ws_size, hipStream_t stream) {
    static int grid = 0;
    if (grid == 0) {
        if (n_in != 23 || out_size != MTOK * DM || ws_size < WS_END) { fprintf(stderr, "kernel_launch: unexpected shapes (n_in %d out %d ws %zu need %zu)\n", n_in, out_size, ws_size, (size_t)WS_END); grid = -1; return; }
        int dev = 0, cus = 0, per_cu = 0;
        hipGetDevice(&dev); hipDeviceGetAttribute(&cus, hipDeviceAttributeMultiprocessorCount, dev);
        hipFuncSetAttribute((const void*)fwd_kernel, hipFuncAttributeMaxDynamicSharedMemorySize, LDS_BYTES);
        hipOccupancyMaxActiveBlocksPerMultiprocessor(&per_cu, (const void*)fwd_kernel, NTHR, LDS_BYTES);
        if (per_cu < 1) { fprintf(stderr, "kernel_launch: occupancy query returned %d\n", per_cu); per_cu = 1; }
        grid = cus;
    }
    if (grid < 0) return;
    if (hipMemsetAsync(d_ws, 0, 16384, stream) != hipSuccess) { fprintf(stderr, "kernel_launch: memset of the control words failed\n"); return; }
    Ptrs p{};
    for (int i = 0; i < 23; ++i) p.in[i] = (const float*)d_in[i];
    p.out = (float*)d_out; p.ws = (unsigned char*)d_ws;
    void* args[] = {&p};
    hipError_t e = hipLaunchCooperativeKernel((const void*)fwd_kernel, dim3(grid), dim3(NTHR), args, LDS_BYTES, stream);
    if (e != hipSuccess) fprintf(stderr, "cooperative launch failed: %s (grid %d)\n", hipGetErrorString(e), grid);
}
```

```cpp
#include <hip/hip_runtime.h>
#include <hip/hip_cooperative_groups.h>
#include <cstdio>
#include <cstdint>
namespace cg = cooperative_groups;

#define DI __device__ __forceinline__
#define LAS __attribute__((address_space(3)))
typedef unsigned short bf16_t;
typedef short bf16x8 __attribute__((ext_vector_type(8)));
typedef short s16x4 __attribute__((ext_vector_type(4)));
typedef float f32x4 __attribute__((ext_vector_type(4)));
typedef float f32x2 __attribute__((ext_vector_type(2)));
typedef float f32x16 __attribute__((ext_vector_type(16)));
typedef unsigned u32x4 __attribute__((ext_vector_type(4)));
typedef unsigned u32x2 __attribute__((ext_vector_type(2)));
typedef __bf16 bf16v2 __attribute__((ext_vector_type(2)));

DI unsigned pk2(float lo, float hi) { bf16v2 v = {(__bf16)lo, (__bf16)hi}; return __builtin_bit_cast(unsigned, v); }
DI int fresh_lane() { int l; asm volatile("v_mbcnt_lo_u32_b32 %0, -1, 0\n\tv_mbcnt_hi_u32_b32 %0, -1, %0" : "=v"(l)); return l; }
DI float shflx(float v, int lane, int k) { return __int_as_float(__builtin_amdgcn_ds_bpermute((lane ^ k) << 2, __float_as_int(v))); }
DI unsigned shflxu(unsigned v, int lane, int k) { return (unsigned)__builtin_amdgcn_ds_bpermute((lane ^ k) << 2, (int)v); }
DI float bflo(unsigned u) { return __uint_as_float(u << 16); }
DI float bfhi(unsigned u) { return __uint_as_float(u & 0xffff0000u); }
DI float bf2f(bf16_t v) { return __uint_as_float(((unsigned)v) << 16); }

constexpr int DM = 2048, SEQ = 2048, NBATCH = 8, MTOK = NBATCH * SEQ, FF = 8192;
constexpr int EIN = 3120, EINP = 3328, OIN = 1344, OINP = 1536, QUP = 3072, KVUP = 4096;
constexpr float EPS = 1e-6f, LOG2E = 1.4426950408889634f, NEGBIG = -1e30f;
constexpr int NTHR = 512;

constexpr size_t al256(size_t x) { return (x + 255) & ~(size_t)255; }
constexpr size_t WS_CTL = 0;
constexpr size_t WS_BAR = 1024;
constexpr size_t WS_PART = 16384;
constexpr size_t WS_PART2 = WS_PART + (size_t)MTOK * 32 * 4;
constexpr size_t WS_BIAS = WS_PART2 + (size_t)MTOK * 32 * 4;
constexpr size_t WS_COS = WS_BIAS + 32 * 128 * 4;
constexpr size_t WS_SIN = WS_COS + 2048 * 32 * 4;
constexpr size_t WS_KC = WS_SIN + 2048 * 32 * 4;
constexpr size_t WS_VC = WS_KC + 8 * 128 * 128 * 2;
constexpr size_t WS_KR = WS_VC + 8 * 128 * 128 * 2;
constexpr size_t WS_WINE = WS_KR + (size_t)MTOK * 64 * 2;
constexpr size_t WS_WOUTE = WS_WINE + (size_t)EINP * DM * 2;
constexpr size_t WS_WINO = WS_WOUTE + (size_t)DM * DM * 2;
constexpr size_t WS_WQUP = WS_WINO + (size_t)OINP * DM * 2;
constexpr size_t WS_WKVUP = WS_WQUP + (size_t)QUP * 768 * 2;
constexpr size_t WS_WOUTO = WS_WKVUP + (size_t)KVUP * 512 * 2;
constexpr size_t WS_WUP = WS_WOUTO + (size_t)DM * DM * 2;
constexpr size_t WS_WDN = WS_WUP + (size_t)FF * DM * 2;
constexpr size_t WS_CW1K = WS_WDN + (size_t)DM * FF * 2;
constexpr size_t WS_CW1V = WS_CW1K + 256 * 2048 * 2;
constexpr size_t WS_CW2K = WS_CW1V + 256 * 2048 * 2;
constexpr size_t WS_CW2V = WS_CW2K + 64 * 256 * 2;
constexpr size_t WS_XB = WS_CW2V + 64 * 256 * 2;
constexpr size_t WS_R = WS_XB + (size_t)MTOK * DM * 2;
constexpr size_t WS_P0 = WS_R, WS_OB0 = WS_R + (size_t)MTOK * EINP * 2;
constexpr size_t WS_P1 = WS_R, WS_OB1 = WS_R, WS_Q1 = WS_R + (size_t)MTOK * DM * 2, WS_KV1 = WS_Q1 + (size_t)MTOK * QUP * 2;
constexpr size_t WS_HB = WS_R;
constexpr size_t WS_END = WS_KV1 + (size_t)MTOK * KVUP * 2;
static_assert(WS_R + (size_t)MTOK * FF * 2 <= WS_END, "HB fits");

namespace pg8 {
#define PG8_LAS __attribute__((address_space(3)))
constexpr int BM = 256, BK = 64, HALF = 128, HTB = HALF * BK * 2  , STAGE_BYTES = 8 * HTB, NXCD = 8, WGM = 8;
__host__ __device__ __forceinline__ int lds_byte(int r, int c) { const int st = (r >> 4) * 2 + (c >> 5), rr = r & 15, cc = c & 31, ob = rr * 64 + cc * 2; return st * 1024 + (ob ^ (((ob >> 9) & 1) << 5)); }
__host__ __device__ __forceinline__ void stage_rc(int b, int& R, int& C) { const int st = b / 1024, sb = b % 1024, swz = sb ^ (((sb >> 9) & 1) << 5); R = (st >> 1) * 16 + swz / 64; C = (st & 1) * 32 + (swz % 64) / 2; }
__host__ __device__ __forceinline__ int perm32(int rho) { const int n = rho >> 4, i = rho & 15; return 8 * (i >> 2) + 4 * n + (i & 3); }
struct Unit { int pm, pn; };
struct Gemm { const bf16_t* A; const bf16_t* Bt; int M, N, K, lda; };
struct StaticOrder {
    int nM, nN, nwg, G, c;
    __host__ __device__ void init(int M, int N, int G_, int c_) { nM = M / BM; nN = N / BM; nwg = nM * nN; G = G_; c = c_; }
    __host__ __device__ bool next(int i, Unit& u) const {
        const long L = (long)i * G + c; if (L >= nwg) return false;
        int wgid = (int)L; { const int q = nwg / NXCD, r = nwg % NXCD, xcd = wgid % NXCD, off = wgid / NXCD; wgid = (xcd < r ? xcd * (q + 1) : r * (q + 1) + (xcd - r) * q) + off; }
        const int nig = WGM * nN, gid = wgid / nig, fm = gid * WGM, gsz = (nM - fm) < WGM ? (nM - fm) : WGM;
        u.pm = fm + ((wgid % nig) % gsz); u.pn = (wgid % nig) / gsz; return true;
    }
    __device__ __forceinline__ void a_ready(const Unit&) const {}
    __device__ __forceinline__ void done(const Unit&) const {}
};
struct TailOrder {
    int c, pn;
    __host__ __device__ bool next(int i, Unit& u) const { if (i > 0 || c >= 64) return false; u.pm = c; u.pn = pn; return true; }
    __device__ __forceinline__ void a_ready(const Unit&) const {}
    __device__ __forceinline__ void done(const Unit&) const {}
};
template <int FIRST4, int CNT4> __device__ __forceinline__ float row_rs(const float* part, int row, int fq, int lane, float inv_dim) {
    const f32x4* p = (const f32x4*)(part + (size_t)row * 32) + FIRST4; float s = 0.f;
#pragma unroll
    for (int i = 0; i < (CNT4 + 3) / 4; ++i) { const int k = fq + 4 * i; if (k < CNT4) { const f32x4 v = p[k]; s += (v[0] + v[1]) + (v[2] + v[3]); } }
    s += shflx(s, lane, 16); s += shflx(s, lane, 32);
    return __builtin_amdgcn_rsqf(s * inv_dim + EPS);
}
template <int MODE> struct EpiScale {
    static constexpr bool PERM = true, AFTER_DRAIN = false;
    bf16_t* O; int ldc; const float* part; float* part_out; bf16_t* kr; const float* cosT; const float* sinT;
    __device__ __forceinline__ void operator()(const f32x4 (&acc)[2][2][4][2], const Unit& u, int wr, int wc, int fr, int fq) const {
        const int row0 = u.pm * BM + wr * 64 + fr; const int col0 = u.pn * BM + wc * 32 + 8 * fq;
#pragma unroll
        for (int ai = 0; ai < 2; ++ai)
#pragma unroll
            for (int m = 0; m < 4; ++m) {
                const int row = row0 + ai * HALF + m * 16;
                float rs;
                if (MODE == 0 || MODE == 1 || MODE == 2) rs = row_rs<0, 8>(part, row, fq, fr + 16 * fq, 1.0f / 2048.0f);
                else if (MODE == 3) rs = row_rs<0, 3>(part, row, fq, fr + 16 * fq, 1.0f / 768.0f);
                else rs = row_rs<3, 2>(part, row, fq, fr + 16 * fq, 1.0f / 512.0f);
                bf16_t* rowp = O + (size_t)row * ldc + col0;
                float ss = 0.f;
#pragma unroll
                for (int bj = 0; bj < 2; ++bj) {
                    f32x4 v0 = acc[ai][bj][m][0] * rs, v1 = acc[ai][bj][m][1] * rs;
                    const int col = col0 + bj * HALF;
                    if (MODE == 1) {
#pragma unroll
                        for (int e = 0; e < 4; ++e) { float a = fmaxf(v0[e], 0.f), b = fmaxf(v1[e], 0.f); v0[e] = a * a; v1[e] = b * b; }
                    }
                    if (MODE == 2) {
#pragma unroll
                        for (int e = 0; e < 4; ++e) ss += v0[e] * v0[e] + v1[e] * v1[e];
                    }
                    bool rope = false; int ri = 0;
                    if (MODE == 2) { rope = (col >= 1280 && col < 1344); ri = (col - 1280) >> 1; }
                    if (MODE == 3) { const int j = col % 192; rope = j >= 128; ri = (j - 128) >> 1; }
                    if ((MODE == 2 || MODE == 3) && rope) {
                        const int s = row & (SEQ - 1);
                        const f32x4 cs = *(const f32x4*)(cosT + s * 32 + ri), sn = *(const f32x4*)(sinT + s * 32 + ri);
                        f32x4 w0, w1;
                        w0[0] = v0[0] * cs[0] - v0[1] * sn[0]; w0[1] = v0[1] * cs[0] + v0[0] * sn[0];
                        w0[2] = v0[2] * cs[1] - v0[3] * sn[1]; w0[3] = v0[3] * cs[1] + v0[2] * sn[1];
                        w1[0] = v1[0] * cs[2] - v1[1] * sn[2]; w1[1] = v1[1] * cs[2] + v1[0] * sn[2];
                        w1[2] = v1[2] * cs[3] - v1[3] * sn[3]; w1[3] = v1[3] * cs[3] + v1[2] * sn[3];
                        v0 = w0; v1 = w1;
                    }
                    u32x4 w; w.x = pk2(v0[0], v0[1]); w.y = pk2(v0[2], v0[3]); w.z = pk2(v1[0], v1[1]); w.w = pk2(v1[2], v1[3]);
                    if (MODE == 2 && rope) *(u32x4*)(kr + (size_t)row * 64 + (col - 1280)) = w;
                    *(u32x4*)(rowp + bj * HALF) = w;
                }
                if (MODE == 2) {
                    ss += shflx(ss, fr + 16 * fq, 16); ss += shflx(ss, fr + 16 * fq, 32);
                    if (fq == 0) part_out[(size_t)row * 32 + u.pn * 4 + wc] = ss;
                }
                asm volatile("" ::: "memory");
            }
    }
};
template <bool LAST> struct EpiResidual {
    static constexpr bool PERM = false, AFTER_DRAIN = false;
    const float* base; float* out; bf16_t* xb; float* part_out;
    __device__ __forceinline__ void operator()(const f32x4 (&acc)[2][2][4][2], const Unit& u, int wr, int wc, int fr, int fq) const {
        const int row0 = u.pm * BM + wr * 64 + fr; const int col0 = u.pn * BM + wc * 32 + 4 * fq;
#pragma unroll
        for (int ai = 0; ai < 2; ++ai)
#pragma unroll
            for (int m = 0; m < 4; ++m) {
                const int row = row0 + ai * HALF + m * 16; const size_t off = (size_t)row * DM + col0; float ss = 0.f;
#pragma unroll
                for (int bj = 0; bj < 2; ++bj)
#pragma unroll
                    for (int n = 0; n < 2; ++n) {
                        const size_t o = off + bj * HALF + n * 16;
                        const f32x4 v = *(const f32x4*)(base + o) + acc[ai][bj][m][n];
                        if (!LAST) *(f32x4*)(out + o) = v;
                        u32x2 w; w.x = pk2(v[0], v[1]); w.y = pk2(v[2], v[3]); *(u32x2*)(xb + o) = w;
                        ss += (v[0] * v[0] + v[1] * v[1]) + (v[2] * v[2] + v[3] * v[3]);
                    }
                ss += shflx(ss, fr + 16 * fq, 16); ss += shflx(ss, fr + 16 * fq, 32);
                if (fq == 0) part_out[(size_t)row * 32 + u.pn * 4 + wc] = ss;
                asm volatile("" ::: "memory");
            }
    }
};
template <class Epi, class Sched, bool ALIGN_EPI = false, bool SP2 = false>
__device__ __forceinline__ void gemm_phase(PG8_LAS unsigned char* lds, const Gemm g, const Sched& S, const Epi& E, const int wid_in) {
    const int lane_ = fresh_lane();
    const int wid = wid_in, lane = lane_, tid = wid * 64 + lane, wr = wid >> 2, wc = wid & 3, fr = lane & 15, fq = lane >> 4;
    const int K = g.K, nt = K / BK;
    unsigned voffA[2], voffB[2];
#pragma unroll
    for (int i = 0; i < 2; ++i) { int R, C; stage_rc(tid * 16 + i * 8192, R, C); const int Rb = Epi::PERM ? ((R & ~31) + perm32(R & 31)) : R;
        voffA[i] = (unsigned)(R * g.lda + C) * 2u; voffB[i] = (unsigned)(Rb * K + C) * 2u; }
    const size_t kstep = (size_t)(BK * 2);
    const size_t hstep = (size_t)HALF * K * 2;
    const size_t tstep = 2 * hstep; const size_t hstepA = (size_t)HALF * g.lda * 2, tstepA = 2 * hstepA;
    const unsigned ldsw = (unsigned)wid * 1024u;
    const int aoff = lds_byte(wr * 64 + fr, fq * 8), boff = lds_byte(wc * 32 + fr, fq * 8);
#define PG8_SA(b, h) (((b) * 2 + (h)) * HTB)
#define PG8_SB(b, h) ((4 + (b) * 2 + (h)) * HTB)
#define PG8_STAGE(bufoff, gbase, voff) do { _Pragma("unroll") for (int _i = 0; _i < 2; ++_i) \
        __builtin_amdgcn_global_load_lds((const unsigned*)((const char*)(gbase) + (voff)[_i]), (PG8_LAS unsigned*)(lds + (bufoff) + ldsw + _i * 8192), 16, 0, 0); } while (0)
#define PG8_LDA(dst, b, h) do { _Pragma("unroll") for (int m = 0; m < 4; ++m) _Pragma("unroll") for (int k = 0; k < 2; ++k) dst[m][k] = *(const PG8_LAS bf16x8*)(lds + PG8_SA(b, h) + aoff + m * 2048 + k * 1024); } while (0)
#define PG8_LDB(dst, b, h) do { _Pragma("unroll") for (int n = 0; n < 2; ++n) _Pragma("unroll") for (int k = 0; k < 2; ++k) dst[n][k] = *(const PG8_LAS bf16x8*)(lds + PG8_SB(b, h) + boff + n * 2048 + k * 1024); } while (0)
#define PG8_MMA(ai, bj, At, Bt) do { __builtin_amdgcn_s_setprio(1); _Pragma("unroll") for (int m = 0; m < 4; ++m) _Pragma("unroll") for (int n = 0; n < 2; ++n) _Pragma("unroll") for (int k = 0; k < 2; ++k) \
        acc[ai][bj][m][n] = __builtin_amdgcn_mfma_f32_16x16x32_bf16(Bt[n][k], At[m][k], acc[ai][bj][m][n], 0, 0, 0); __builtin_amdgcn_s_setprio(0); } while (0)
#define PG8_WAIT_V(n) asm volatile("s_waitcnt vmcnt(" #n ")" ::: "memory")
#define PG8_WAIT_L(n) asm volatile("s_waitcnt lgkmcnt(" #n ")" ::: "memory")
#define PG8_BAR __builtin_amdgcn_s_barrier()
#define PG8_SCHED __builtin_amdgcn_sched_barrier(0)
    Unit cur, nxt; int ui = 0;
    if (!S.next(0, cur)) return;
    f32x4 acc[2][2][4][2];
#pragma unroll
    for (int a = 0; a < 2; ++a)
#pragma unroll
        for (int b = 0; b < 2; ++b)
#pragma unroll
            for (int m = 0; m < 4; ++m)
#pragma unroll
                for (int n = 0; n < 2; ++n) acc[a][b][m][n] = (f32x4){0.f, 0.f, 0.f, 0.f};
    bf16x8 At[4][2], B0[2][2], B1[2][2];
    const char* cA = (const char*)g.A + (size_t)cur.pm * tstepA; const char* cB = (const char*)g.Bt + (size_t)cur.pn * tstep;
    S.a_ready(cur);
    if constexpr (SP2) {
        PG8_STAGE(PG8_SB(0, 0), cB, voffB); PG8_STAGE(PG8_SB(0, 1), cB + hstep, voffB); PG8_STAGE(PG8_SA(0, 0), cA, voffA); PG8_STAGE(PG8_SA(0, 1), cA + hstepA, voffA);
        if (wr == 1) PG8_BAR;
        PG8_WAIT_V(2); PG8_BAR;
        PG8_STAGE(PG8_SB(1, 0), cB + kstep, voffB); PG8_STAGE(PG8_SA(1, 0), cA + kstep, voffA); PG8_STAGE(PG8_SB(1, 1), cB + hstep + kstep, voffB);
        PG8_WAIT_V(6); PG8_BAR;
    } else {
        PG8_STAGE(PG8_SB(0, 0), cB, voffB); PG8_STAGE(PG8_SA(0, 0), cA, voffA); PG8_STAGE(PG8_SB(0, 1), cB + hstep, voffB); PG8_STAGE(PG8_SA(0, 1), cA + hstepA, voffA);
        if (wr == 1) PG8_BAR;
        PG8_WAIT_V(4); PG8_BAR;
        PG8_STAGE(PG8_SB(1, 0), cB + kstep, voffB); PG8_STAGE(PG8_SA(1, 0), cA + kstep, voffA); PG8_STAGE(PG8_SB(1, 1), cB + hstep + kstep, voffB);
        PG8_WAIT_V(6); PG8_BAR;
    }
    for (;;) {
        const bool has_next = S.next(ui + 1, nxt);
        const char* nA = has_next ? (const char*)g.A + (size_t)nxt.pm * tstepA : cA; const char* nB = has_next ? (const char*)g.Bt + (size_t)nxt.pn * tstep : cB;
        for (int t = 0; t < nt; t += 2) {
            const bool last = (t == nt - 2);
            const char* a1 = cA + (size_t)(t + 1) * kstep;
            const char* a2 = last ? nA : cA + (size_t)(t + 2) * kstep; const char* b2 = last ? nB : cB + (size_t)(t + 2) * kstep;
            const char* a3 = a2 + kstep; const char* b3 = b2 + kstep;
            if (last && has_next) S.a_ready(nxt);
            if constexpr (SP2) {
            PG8_LDB(B0, 0, 0); PG8_LDB(B1, 0, 1); PG8_SCHED; PG8_LDA(At, 0, 0); PG8_STAGE(PG8_SA(1, 1), a1 + hstepA, voffA);
            PG8_WAIT_V(8); PG8_WAIT_L(0); PG8_BAR; PG8_MMA(0, 0, At, B0); PG8_MMA(0, 1, At, B1); PG8_BAR; PG8_SCHED;
            PG8_LDA(At, 0, 1); PG8_STAGE(PG8_SB(0, 0), b2, voffB); PG8_STAGE(PG8_SB(0, 1), b2 + hstep, voffB); PG8_STAGE(PG8_SA(0, 0), a2, voffA);
            PG8_WAIT_V(8); PG8_WAIT_L(0); PG8_BAR; PG8_MMA(1, 0, At, B0); PG8_MMA(1, 1, At, B1); PG8_BAR; PG8_SCHED;
            PG8_LDB(B0, 1, 0); PG8_LDB(B1, 1, 1); PG8_SCHED; PG8_LDA(At, 1, 0); PG8_STAGE(PG8_SA(0, 1), a2 + hstepA, voffA);
            PG8_WAIT_V(8); PG8_WAIT_L(0); PG8_BAR; PG8_MMA(0, 0, At, B0); PG8_MMA(0, 1, At, B1); PG8_BAR; PG8_SCHED;
            PG8_LDA(At, 1, 1); PG8_STAGE(PG8_SB(1, 0), b3, voffB); PG8_STAGE(PG8_SB(1, 1), b3 + hstep, voffB); PG8_STAGE(PG8_SA(1, 0), a3, voffA);
            PG8_WAIT_V(8); PG8_WAIT_L(0); PG8_BAR; PG8_MMA(1, 0, At, B0); PG8_MMA(1, 1, At, B1); PG8_BAR; PG8_SCHED;
            } else {
            PG8_LDB(B0, 0, 0); PG8_SCHED; PG8_LDA(At, 0, 0); PG8_STAGE(PG8_SA(1, 1), a1 + hstepA, voffA);
            PG8_WAIT_L(8); PG8_BAR; PG8_WAIT_L(0); PG8_MMA(0, 0, At, B0); PG8_BAR; PG8_SCHED;
            PG8_LDB(B1, 0, 1); PG8_STAGE(PG8_SB(0, 0), b2, voffB);
            PG8_BAR; PG8_WAIT_L(0); PG8_MMA(0, 1, At, B1); PG8_BAR;
            PG8_LDA(At, 0, 1); PG8_STAGE(PG8_SA(0, 0), a2, voffA);
            PG8_BAR; PG8_WAIT_L(0); PG8_MMA(1, 0, At, B0); PG8_BAR; PG8_SCHED;
            PG8_STAGE(PG8_SB(0, 1), b2 + hstep, voffB);
            PG8_WAIT_V(6); PG8_BAR; PG8_MMA(1, 1, At, B1); PG8_BAR;
            PG8_LDB(B0, 1, 0); PG8_SCHED; PG8_LDA(At, 1, 0); PG8_STAGE(PG8_SA(0, 1), a2 + hstepA, voffA);
            PG8_WAIT_L(8); PG8_BAR; PG8_WAIT_L(0); PG8_MMA(0, 0, At, B0); PG8_BAR; PG8_SCHED;
            PG8_LDB(B1, 1, 1); PG8_STAGE(PG8_SB(1, 0), b3, voffB);
            PG8_BAR; PG8_WAIT_L(0); PG8_MMA(0, 1, At, B1); PG8_BAR;
            PG8_LDA(At, 1, 1); PG8_STAGE(PG8_SA(1, 0), a3, voffA);
            PG8_BAR; PG8_WAIT_L(0); PG8_MMA(1, 0, At, B0); PG8_BAR; PG8_SCHED;
            PG8_STAGE(PG8_SB(1, 1), b3 + hstep, voffB);
            PG8_WAIT_V(6); PG8_BAR; PG8_MMA(1, 1, At, B1); PG8_BAR;
            }
        }
        if constexpr (ALIGN_EPI) { if (wr == 0) PG8_BAR; }
        if constexpr (!Epi::AFTER_DRAIN) { E(acc, cur, wr, wc, fr, fq); S.done(cur); }
        if (!has_next) break;
#pragma unroll
        for (int a = 0; a < 2; ++a)
#pragma unroll
            for (int b = 0; b < 2; ++b)
#pragma unroll
                for (int m = 0; m < 4; ++m)
#pragma unroll
                    for (int n = 0; n < 2; ++n) acc[a][b][m][n] = (f32x4){0.f, 0.f, 0.f, 0.f};
        cur = nxt; cA = nA; cB = nB; ++ui;
        if constexpr (ALIGN_EPI) { if (wr == 1) PG8_BAR; }
    }
    PG8_WAIT_V(0);
    if constexpr (!ALIGN_EPI) { if (wr == 0) PG8_BAR; }
    PG8_BAR;
    if constexpr (Epi::AFTER_DRAIN) { E.fused(acc, cur, wr, wc, fr, fq, lds, wid, lane); S.done(cur); }
#undef PG8_SA
#undef PG8_SB
#undef PG8_STAGE
#undef PG8_LDA
#undef PG8_LDB
#undef PG8_MMA
#undef PG8_WAIT_V
#undef PG8_WAIT_L
#undef PG8_BAR
#undef PG8_SCHED
}
}

#define MFMA32(a, b, c) __builtin_amdgcn_mfma_f32_32x32x16_bf16((a), (b), (c), 0, 0, 0)
DI int crow(int reg, int h) { return (reg & 3) + 8 * (reg >> 2) + 4 * h; }
DI float fexp2(float x) { return __builtin_amdgcn_exp2f(x); }
DI bf16x8 pack8(const f32x16& x, int s) {
    u32x4 p; p.x = pk2(x[8 * s + 0], x[8 * s + 1]); p.y = pk2(x[8 * s + 2], x[8 * s + 3]); p.z = pk2(x[8 * s + 4], x[8 * s + 5]); p.w = pk2(x[8 * s + 6], x[8 * s + 7]);
    return __builtin_bit_cast(bf16x8, p);
}
DI bf16x8 tr_pair(LAS const unsigned char* p0, LAS const unsigned char* p1) {
    const s16x4 lo = __builtin_amdgcn_ds_read_tr16_b64_v4i16((LAS s16x4*)p0);
    const s16x4 hi = __builtin_amdgcn_ds_read_tr16_b64_v4i16((LAS s16x4*)p1);
    return __builtin_shufflevector(lo, hi, 0, 1, 2, 3, 4, 5, 6, 7);
}
template <int DQK, int KSTR> DI f32x16 st_block(const bf16x8 (&qf)[DQK / 16], LAS const unsigned char* Kt, int kb, int r, int h) {
    f32x16 s;
#pragma unroll
    for (int i = 0; i < 16; ++i) s[i] = 0.f;
    LAS const unsigned char* kp = Kt + (32 * kb + r) * KSTR + 16 * h;
#pragma unroll
    for (int kk = 0; kk < DQK / 16; ++kk) { const bf16x8 kf = *(LAS const bf16x8*)(kp + 32 * kk); s = MFMA32(kf, qf[kk], s); }
    return s;
}
template <int DV, int VSTR> DI void pv_block(f32x16 (&o)[DV / 32], const f32x16& p, LAS const unsigned char* Vt, int kb, int vlane) {
#pragma unroll
    for (int st = 0; st < 2; ++st) {
        const bf16x8 pf = pack8(p, st);
        LAS const unsigned char* vp = Vt + vlane + (32 * kb + 16 * st) * VSTR;
#pragma unroll
        for (int db = 0; db < DV / 32; ++db) { const bf16x8 vf = tr_pair(vp + 64 * db, vp + 8 * VSTR + 64 * db); o[db] = MFMA32(vf, pf, o[db]); }
    }
}
#define SCHED_FENCE() __builtin_amdgcn_sched_barrier(0)
#ifndef TC_CUT
#define TC_CUT 0
#endif
template <int DQK, int DV, int KSTR, int VSTR, bool PLAINB, class Fix, bool CUTOK = false>
DI void tile_compute(const bf16x8 (&qf)[DQK / 16], LAS const unsigned char* Kt, LAS const unsigned char* Vt, f32x16 (&o)[DV / 32], float& m, float& l, int r, int h, int vlane, const Fix& fix, const bool plain, const float pb) {
    constexpr int NKK = DQK / 16, KC = 2, NCH = NKK / KC, NDB = DV / 32;
    static_assert(NKK % KC == 0, "chunking");
    f32x16 s0, s1;
#pragma unroll
    for (int i = 0; i < 16; ++i) { s0[i] = 0.f; s1[i] = 0.f; }
    LAS const unsigned char* kp = Kt + r * KSTR + 16 * h;
    bf16x8 ka[2][KC], kb[2][KC];
#pragma unroll
    for (int kk = 0; kk < KC; ++kk) { ka[0][kk] = *(LAS const bf16x8*)(kp + 32 * kk); kb[0][kk] = *(LAS const bf16x8*)(kp + 32 * KSTR + 32 * kk); }
#pragma unroll
    for (int c = 0; c < NCH; ++c) {
        if (c + 1 < NCH) {
#pragma unroll
            for (int kk = 0; kk < KC; ++kk) { ka[(c + 1) & 1][kk] = *(LAS const bf16x8*)(kp + 32 * ((c + 1) * KC + kk)); kb[(c + 1) & 1][kk] = *(LAS const bf16x8*)(kp + 32 * KSTR + 32 * ((c + 1) * KC + kk)); }
        }
        SCHED_FENCE();
#pragma unroll
        for (int kk = 0; kk < KC; ++kk) { s0 = MFMA32(ka[c & 1][kk], qf[c * KC + kk], s0); s1 = MFMA32(kb[c & 1][kk], qf[c * KC + kk], s1); }
        SCHED_FENCE();
    }
    if (TC_CUT == 1 && CUTOK) { o[0] = o[0] + s0 + s1; return; }
    bf16x8 vf[2][NDB];
    LAS const unsigned char* vp = Vt + vlane;
#pragma unroll
    for (int db = 0; db < NDB; ++db) vf[0][db] = tr_pair(vp + 64 * db, vp + 8 * VSTR + 64 * db);
    if (plain) {
        if (PLAINB) {
#pragma unroll
            for (int i = 0; i < 16; ++i) { s0[i] += pb; s1[i] += pb; }
        }
    } else {
#pragma unroll
        for (int i = 0; i < 16; ++i) { s0[i] = fix(s0[i], crow(i, h)); s1[i] = fix(s1[i], 32 + crow(i, h)); }
    }
    float mx = NEGBIG;
#pragma unroll
    for (int i = 0; i < 16; ++i) mx = fmaxf(mx, fmaxf(s0[i], s1[i]));
    mx = fmaxf(mx, shflx(mx, r + 32 * h, 32));
    const float m_old = m, mn = fmaxf(m, mx), alpha = fexp2(m - mn);
    float rs = 0.f;
#pragma unroll
    for (int i = 0; i < 16; ++i) { s0[i] = fexp2(s0[i] - mn); s1[i] = fexp2(s1[i] - mn); rs += s0[i] + s1[i]; }
    rs += shflx(rs, r + 32 * h, 32);
    l = l * alpha + rs; m = mn;
    if (TC_CUT == 2 && CUTOK) { o[0] = o[0] + s0 + s1; return; }
    if (__any(mx > m_old)) {
#pragma unroll
        for (int db = 0; db < NDB; ++db) o[db] = o[db] * alpha;
    }
    SCHED_FENCE();
#pragma unroll
    for (int step = 0; step < 4; ++step) {
        if (step < 3) {
            LAS const unsigned char* vq = vp + (16 * (step + 1)) * VSTR;
#pragma unroll
            for (int db = 0; db < NDB; ++db) vf[(step + 1) & 1][db] = tr_pair(vq + 64 * db, vq + 8 * VSTR + 64 * db);
        }
        const bf16x8 pf = pack8((step >> 1) ? s1 : s0, step & 1);
        SCHED_FENCE();
#pragma unroll
        for (int db = 0; db < NDB; ++db) o[db] = MFMA32(vf[step & 1][db], pf, o[db]);
        SCHED_FENCE();
    }
}

constexpr int L0_KSTR = 144, L0_VSTR = 192, L0_KSZ = 64 * L0_KSTR, L0_BUF = L0_KSZ + 64 * L0_VSTR;
constexpr int OFIN_OFF = 2 * L0_BUF, MISC_OFF = 110592, BT_OFF = MISC_OFF, PSUM_OFF = MISC_OFF + 4096, PSLC_OFF = PSUM_OFF + 32 * 129 * 4 + 128  , SEL_OFF = PSLC_OFF + 32 * 33 * 4, SLOT_OFF = SEL_OFF + 128;
constexpr int LDS_BYTES = 139264;
static_assert(OFIN_OFF + 65536 <= MISC_OFF && SLOT_OFF + 4 <= LDS_BYTES - 16 && 8 * 16640 - 768 <= LDS_BYTES - 16, "LDS map");
struct KVSrc { const bf16_t* k; const bf16_t* v; int stride; };

template <int MODE> struct Fix0 {
    int tq, kpos0, W; LAS const float* bt; bool far, selbit; float bfar;
    DI float operator()(float s, int kl) const {
        if (MODE == 2) { const int c = kpos0 + kl, cd = tq - (16 * c + 31); const bool ok = cd >= 0 && c < 127; const int dd = cd < 0 ? 0 : (cd > 127 ? 127 : cd); return ok ? s + bt[dd] : NEGBIG; }
        const int dist = tq - (kpos0 + kl);
        const bool ok = MODE == 0 ? ((unsigned)dist < (unsigned)W) : (selbit && dist >= 0);
        float b = bfar; if (!far) { const int dd = dist < 0 ? 0 : (dist > 127 ? 127 : dist); b = bt[dd]; }
        return ok ? s + b : NEGBIG;
    }
};
struct FixPlain { float b; DI float operator()(float s, int) const { return s + b; } };
struct FixNone { DI float operator()(float s, int) const { return s; } };
DI u32x4 ldg16(const bf16_t* p) { return *(const u32x4*)p; }
template <int MODE> DI void l0_run(unsigned tiles, const KVSrc src, LAS unsigned char* lds, const bf16x8 (&qf)[4], f32x16 (&o)[2], float& m, float& l,
                                   int tq, int t0, int W, unsigned selmask, LAS const float* bt, int tid, int r, int h, int vlane) {
    if (tiles == 0u) return;
    const int lrow = tid >> 3, lch = tid & 7; const unsigned goff = (unsigned)(lrow * src.stride + lch * 8) * 2u;
#define L0_LD(base, j) (*(const u32x4*)((const char*)((base) + (size_t)(64 * (j)) * src.stride) + goff))
    int jn = __builtin_ctz(tiles); tiles &= tiles - 1;
    {
        const u32x4 kreg = L0_LD(src.k, jn), vreg = L0_LD(src.v, jn);
        *(LAS u32x4*)(lds + lrow * L0_KSTR + lch * 16) = kreg; *(LAS u32x4*)(lds + L0_KSZ + lrow * L0_VSTR + lch * 16) = vreg;
    }
    __syncthreads();
    int buf = 0;
    for (;;) {
        const int j = jn; const bool more = tiles != 0u;
        u32x4 kreg, vreg;
        if (more) { jn = __builtin_ctz(tiles); tiles &= tiles - 1;
            kreg = L0_LD(src.k, jn); vreg = L0_LD(src.v, jn); }
        Fix0<MODE> fx; fx.tq = tq; fx.kpos0 = 64 * j; fx.W = W; fx.bt = bt; fx.bfar = bt[127];
        fx.far = (MODE != 2) && (t0 - (64 * j + 63) >= 113); fx.selbit = (selmask >> j) & 1u;
        LAS unsigned char* B = lds + buf * L0_BUF;
        bool plain = false;
        if (MODE == 0) plain = fx.far && (t0 + 31 - 64 * j < W);
        if (MODE == 1) plain = fx.far && __all(fx.selbit);
        tile_compute<64, 64, L0_KSTR, L0_VSTR, true>(qf, B, B + L0_KSZ, o, m, l, r, h, vlane, fx, plain, fx.bfar);
        if (more) { LAS unsigned char* Bn = lds + (buf ^ 1) * L0_BUF; *(LAS u32x4*)(Bn + lrow * L0_KSTR + lch * 16) = kreg; *(LAS u32x4*)(Bn + L0_KSZ + lrow * L0_VSTR + lch * 16) = vreg; }
        __syncthreads();
        if (!more) break;
        buf ^= 1;
    }
#undef L0_LD
}
DI int next_item(unsigned* ctr, LAS int* slot, int wave) {
    __syncthreads();
    if (wave == 0 && fresh_lane() == 0) *slot = (int)atomicAdd(ctr, 1u);
    __syncthreads();
    return *slot;
}
DI unsigned band_mask(int t0, int W) { const int lo = (t0 - W + 1 < 0 ? 0 : t0 - W + 1) >> 6, hi = (t0 + 31) >> 6; return (hi == 31 ? 0xffffffffu : ((1u << (hi + 1)) - 1u)) & ~((1u << lo) - 1u); }
template <int NDB> DI void store_o(const f32x16 (&o)[NDB], bf16_t* orow, int h) {
#pragma unroll
    for (int db = 0; db < NDB; ++db)
#pragma unroll
        for (int g = 0; g < 4; ++g) { u32x2 w; w.x = pk2(o[db][4 * g], o[db][4 * g + 1]); w.y = pk2(o[db][4 * g + 2], o[db][4 * g + 3]); *(u32x2*)(orow + 32 * db + 8 * g + 4 * h) = w; }
}

struct Ptrs {
    const float* in[23]; float* out; unsigned char* ws;
};
DI float sigmoidf_(float x) { return 1.0f / (1.0f + __expf(-x)); }

DI void mixerA_item(int item, unsigned char* ws, const float* sinks, LAS unsigned char* lds, int tid, int wave, int lane) {
    lane = fresh_lane(); tid = wave * 64 + lane;
    const int tt = item & 63, bg = item >> 6, b = bg >> 1, g = bg & 1, t0 = 32 * tt, hq = g * 8 + wave, r = lane & 31, h = lane >> 5, tq = t0 + r;
    const bf16_t* P0 = (const bf16_t*)(ws + WS_P0); const float* biasT = (const float*)(ws + WS_BIAS);
    LAS float* bt = (LAS float*)(lds + BT_OFF) + wave * 128; bt[lane] = biasT[hq * 128 + lane]; bt[lane + 64] = biasT[hq * 128 + lane + 64];
    const int i16 = lane & 15, vlane = ((i16 >> 2) + 4 * h) * L0_VSTR + 32 * ((lane >> 4) & 1) + 8 * (i16 & 3);
    const size_t rowb = (size_t)(b * SEQ + tq);
    bf16x8 qf[4];
#pragma unroll
    for (int kk = 0; kk < 4; ++kk) qf[kk] = __builtin_bit_cast(bf16x8, ldg16(P0 + rowb * EINP + hq * 64 + 16 * kk + 8 * h));
    f32x16 o[2];
#pragma unroll
    for (int i = 0; i < 16; ++i) { o[0][i] = 0.f; o[1][i] = 0.f; }
    float m = sinks[hq] * LOG2E, l = 1.0f;
    KVSrc src; src.k = P0 + (size_t)b * SEQ * EINP + 1024 + g * 64; src.v = P0 + (size_t)b * SEQ * EINP + 1152 + g * 64; src.stride = EINP;
    l0_run<0>(band_mask(t0, 128), src, lds, qf, o, m, l, tq, t0, 128, 0u, bt, tid, r, h, vlane);
    const float inv = 1.0f / l; o[0] = o[0] * inv; o[1] = o[1] * inv;
    store_o<2>(o, (bf16_t*)(ws + WS_OB0) + rowb * DM + hq * 64, h);
}

DI void mixerB_item(int item, unsigned char* ws, LAS unsigned char* lds, int tid, int wave, int lane) {
    lane = fresh_lane(); tid = wave * 64 + lane;
    const int tt = 63 - (item >> 4), bg = item & 15, b = bg >> 1, g = bg & 1, t0 = 32 * tt, hq = g * 8 + wave, r = lane & 31, h = lane >> 5, tq = t0 + r;
    const bf16_t* P0 = (const bf16_t*)(ws + WS_P0); const float* biasT = (const float*)(ws + WS_BIAS);
    LAS float* bt = (LAS float*)(lds + BT_OFF) + wave * 128; bt[lane] = biasT[(16 + hq) * 128 + lane]; bt[lane + 64] = biasT[(16 + hq) * 128 + lane + 64];
    LAS unsigned* psum = (LAS unsigned*)(lds + PSUM_OFF); LAS unsigned* pslc = (LAS unsigned*)(lds + PSLC_OFF); LAS unsigned* sel = (LAS unsigned*)(lds + SEL_OFF);
    for (int i = tid; i < 32 * 129; i += NTHR) psum[i] = 0u;
    const int i16 = lane & 15, vlane = ((i16 >> 2) + 4 * h) * L0_VSTR + 32 * ((lane >> 4) & 1) + 8 * (i16 & 3);
    const size_t rowb = (size_t)(b * SEQ + tq);
    bf16x8 qf[4];
#pragma unroll
    for (int kk = 0; kk < 4; ++kk) qf[kk] = __builtin_bit_cast(bf16x8, ldg16(P0 + rowb * EINP + 1280 + hq * 64 + 16 * kk + 8 * h));
    const bf16_t* gp = P0 + rowb * EINP + 3072 + hq * 3;
    f32x16 o[2];
    LAS float* OF = (LAS float*)(lds + OFIN_OFF) + tid;
    {
        const bf16_t* KC = (const bf16_t*)(ws + WS_KC); const bf16_t* VC = (const bf16_t*)(ws + WS_VC);
        const int lrow = tid >> 3, lch = tid & 7;
#pragma unroll
        for (int jt = 0; jt < 2; ++jt) {
            const size_t off = ((size_t)(b * 128 + 64 * jt + lrow) * 2 + g) * 64 + lch * 8;
            LAS unsigned char* B = lds + jt * L0_BUF;
            *(LAS u32x4*)(B + lrow * L0_KSTR + lch * 16) = ldg16(KC + off); *(LAS u32x4*)(B + L0_KSZ + lrow * L0_VSTR + lch * 16) = ldg16(VC + off);
        }
        __syncthreads();
#pragma unroll
        for (int i = 0; i < 16; ++i) { o[0][i] = 0.f; o[1][i] = 0.f; }
        float m = NEGBIG, l = 0.f;
        Fix0<2> fx; fx.tq = tq; fx.W = 0; fx.bt = bt; fx.far = false; fx.selbit = false; fx.bfar = 0.f;
        fx.kpos0 = 0;  tile_compute<64, 64, L0_KSTR, L0_VSTR, false>(qf, lds, lds + L0_KSZ, o, m, l, r, h, vlane, fx, false, 0.f);
        fx.kpos0 = 64; tile_compute<64, 64, L0_KSTR, L0_VSTR, false>(qf, lds + L0_BUF, lds + L0_BUF + L0_KSZ, o, m, l, r, h, vlane, fx, false, 0.f);
        const float inv = (tq >= 31 ? 1.0f : 0.0f) / l;
#pragma unroll 1
        for (int q = 0; q < 4; ++q) {
            f32x16 s = st_block<64, L0_KSTR>(qf, lds + (q >> 1) * L0_BUF, q & 1, r, h);
            fx.kpos0 = 64 * (q >> 1);
            LAS unsigned* pr = psum + r * 129 + 32 * q + 4 * h;
#pragma unroll
            for (int i = 0; i < 16; ++i) { const float p = fexp2(fx(s[i], 32 * (q & 1) + crow(i, h)) - m) * inv;
                __hip_atomic_fetch_add(pr + (i & 3) + 8 * (i >> 2), (unsigned)(p * 268435456.0f + 0.5f), __ATOMIC_RELAXED, __HIP_MEMORY_SCOPE_WORKGROUP); }
        }
        o[0] = o[0] * inv; o[1] = o[1] * inv;
        const float g0 = sigmoidf_(bf2f(gp[0]));
#pragma unroll
        for (int i = 0; i < 16; ++i) { OF[i * NTHR] = o[0][i] * g0; OF[(16 + i) * NTHR] = o[1][i] * g0; }
    }
    __syncthreads();
    {
        const int tok = tid >> 4, nn = tid & 15;
#pragma unroll
        for (int e = 0; e < 2; ++e) { const int n = nn + 16 * e; const int c0 = (4 * n - 1 < 0) ? 0 : 4 * n - 1, c1 = (4 * n + 3 > 126) ? 126 : 4 * n + 3; unsigned v = 0u;
            for (int c = c0; c <= c1; ++c) v += psum[tok * 129 + c];
            pslc[tok * 33 + n] = v; }
        __syncthreads();
        const int t = t0 + tok, cur = t >> 6, quota = 8 - (cur == 0 ? 1 : (cur == 1 ? 2 : 3));
        bool sb[2];
#pragma unroll
        for (int e = 0; e < 2; ++e) { const int n = nn + 16 * e;
            const bool forced = (n == 0) || (n == cur) || (n == cur - 1), cand = (n >= 1) && (n <= cur - 2);
            const unsigned v = pslc[tok * 33 + n]; int rank = 0;
            _Pragma("unroll 1") for (int n2 = 1; n2 <= cur - 2; ++n2) { const unsigned v2 = pslc[tok * 33 + n2]; rank += (v2 > v || (v2 == v && n2 < n)) ? 1 : 0; }
            sb[e] = forced || (cand && rank < quota); }
        const unsigned long long b0 = __ballot(sb[0]), b1 = __ballot(sb[1]);
        const int k = (lane >> 4);
        if (nn == 0) sel[tok] = (unsigned)((b0 >> (16 * k)) & 0xffffull) | ((unsigned)((b1 >> (16 * k)) & 0xffffull) << 16);
        __syncthreads();
    }
    const unsigned selm = sel[r];
    unsigned U = selm;
#pragma unroll
    for (int d = 1; d < 32; d <<= 1) U |= shflxu(U, lane, d);
    U = (unsigned)__builtin_amdgcn_readfirstlane((int)U);
    const size_t bbase = (size_t)b * SEQ * EINP;
    {
#pragma unroll
        for (int i = 0; i < 16; ++i) { o[0][i] = 0.f; o[1][i] = 0.f; }
        float m = NEGBIG, l = 0.f;
        KVSrc src; src.k = P0 + bbase + 2560 + g * 64; src.v = P0 + bbase + 2688 + g * 64; src.stride = EINP;
        l0_run<1>(U, src, lds, qf, o, m, l, tq, t0, 0, selm, bt, tid, r, h, vlane);
        const float sc = sigmoidf_(bf2f(gp[1])) / l;
#pragma unroll
        for (int i = 0; i < 16; ++i) { OF[i * NTHR] += o[0][i] * sc; OF[(16 + i) * NTHR] += o[1][i] * sc; }
    }
    {
#pragma unroll
        for (int i = 0; i < 16; ++i) { o[0][i] = 0.f; o[1][i] = 0.f; }
        float m = NEGBIG, l = 0.f;
        KVSrc src; src.k = P0 + bbase + 2816 + g * 64; src.v = P0 + bbase + 2944 + g * 64; src.stride = EINP;
        l0_run<0>(band_mask(t0, 512), src, lds, qf, o, m, l, tq, t0, 512, 0u, bt, tid, r, h, vlane);
        const float sc = sigmoidf_(bf2f(gp[2])) / l;
#pragma unroll
        for (int i = 0; i < 16; ++i) { o[0][i] = OF[i * NTHR] + o[0][i] * sc; o[1][i] = OF[(16 + i) * NTHR] + o[1][i] * sc; }
    }
    store_o<2>(o, (bf16_t*)(ws + WS_OB0) + rowb * DM + 1024 + hq * 64, h);
}

DI float gelu_tanh(float x) { const float u = 0.7978845608028654f * (x + 0.044715f * x * x * x); return 0.5f * x * (1.0f + tanhf(u)); }
DI void compress_item(int item, unsigned char* ws, const float* pos_k, const float* pos_v, LAS unsigned char* lds, int tid, int wave, int lane) {
    lane = fresh_lane(); tid = wave * 64 + lane;
    const int kv = item >> 6, rb = item & 63, r = lane & 31, h = lane >> 5;
    const bf16_t* P0 = (const bf16_t*)(ws + WS_P0);
    const float* pos = kv ? pos_v : pos_k;
    const bf16_t* w1t = (const bf16_t*)(ws + (kv ? WS_CW1V : WS_CW1K)); const bf16_t* w2t = (const bf16_t*)(ws + (kv ? WS_CW2V : WS_CW2K));
    bf16_t* dst = (bf16_t*)(ws + (kv ? WS_VC : WS_KC));
    int rho = 32 * rb + r; if (rho > 2031) rho = 2031;
    const int b = rho / 254, rem = rho % 254, c = rem >> 1, g = rem & 1;
    const bf16_t* src = P0 + (size_t)(b * SEQ + 16 * c) * EINP + (kv ? 2432 : 2304) + g * 64 + 8 * h;
    const bf16_t* wrow = w1t + (size_t)(32 * wave + r) * 2048 + 8 * h;
    const float* prow = pos + 8 * h;
    f32x16 acc;
#pragma unroll
    for (int i = 0; i < 16; ++i) acc[i] = 0.f;
#pragma unroll 4
    for (int kk = 0; kk < 128; ++kk) {
        const int l = kk >> 2, d = 16 * (kk & 3);
        const u32x4 a = ldg16(src + (size_t)l * EINP + d); const f32x4 p0 = *(const f32x4*)(prow + l * 64 + d), p1 = *(const f32x4*)(prow + l * 64 + d + 4);
        u32x4 aa; aa.x = pk2(bflo(a.x) + p0[0], bfhi(a.x) + p0[1]); aa.y = pk2(bflo(a.y) + p0[2], bfhi(a.y) + p0[3]);
        aa.z = pk2(bflo(a.z) + p1[0], bfhi(a.z) + p1[1]); aa.w = pk2(bflo(a.w) + p1[2], bfhi(a.w) + p1[3]);
        const bf16x8 bf = __builtin_bit_cast(bf16x8, ldg16(wrow + 16 * kk));
        acc = MFMA32(__builtin_bit_cast(bf16x8, aa), bf, acc);
    }
    LAS bf16_t* Hs = (LAS bf16_t*)lds;
#pragma unroll
    for (int i = 0; i < 16; ++i) { const float v = gelu_tanh(acc[i]); Hs[crow(i, h) * 264 + 32 * wave + r] = (bf16_t)(pk2(v, 0.f) & 0xffffu); }
    __syncthreads();
    if (wave < 2) {
        f32x16 a2;
#pragma unroll
        for (int i = 0; i < 16; ++i) a2[i] = 0.f;
#pragma unroll
        for (int kk = 0; kk < 16; ++kk) {
            const bf16x8 af = *(LAS const bf16x8*)(Hs + r * 264 + 16 * kk + 8 * h);
            const bf16x8 bf = __builtin_bit_cast(bf16x8, ldg16(w2t + (size_t)(32 * wave + r) * 256 + 16 * kk + 8 * h));
            a2 = MFMA32(af, bf, a2);
        }
#pragma unroll
        for (int i = 0; i < 16; ++i) { const int rr = 32 * rb + crow(i, h);
            if (rr < 2032) { const int b2 = rr / 254, rem2 = rr % 254; dst[((size_t)(b2 * 128 + (rem2 >> 1)) * 2 + (rem2 & 1)) * 64 + 32 * wave + r] = (bf16_t)(pk2(a2[i], 0.f) & 0xffffu); } }
    }
    __syncthreads();
}

constexpr int C_KSTR = 400, C_VSTR = 320, C_KSZ = 64 * C_KSTR, C_BUF = C_KSZ + 64 * C_VSTR;
struct FixC { int tq, kpos0; DI float operator()(float s, int kl) const { return (kpos0 + kl) <= tq ? s : NEGBIG; } };
template <int VAR> DI void mla_item(int item, unsigned char* ws, LAS unsigned char* lds, int tid, int wave, int lane) {
    lane = fresh_lane(); tid = wave * 64 + lane;
    const int qb = 7 - (item >> 7), bh = item & 127, b = bh >> 4, hh = bh & 15, r = lane & 31, h = lane >> 5, tq = qb * 256 + 32 * wave + r;
    const bf16_t* Q1 = (const bf16_t*)(ws + WS_Q1); const bf16_t* KV1 = (const bf16_t*)(ws + WS_KV1); const bf16_t* KR = (const bf16_t*)(ws + WS_KR);
    const int i16 = lane & 15, vlane = ((i16 >> 2) + 4 * h) * C_VSTR + 32 * ((lane >> 4) & 1) + 8 * (i16 & 3);
    const size_t rowb = (size_t)(b * SEQ + tq);
    bf16x8 qf[12];
#pragma unroll
    for (int kk = 0; kk < 12; ++kk) qf[kk] = __builtin_bit_cast(bf16x8, ldg16(Q1 + rowb * QUP + hh * 192 + 16 * kk + 8 * h));
    f32x16 o[4];
#pragma unroll
    for (int d = 0; d < 4; ++d)
#pragma unroll
        for (int i = 0; i < 16; ++i) o[d][i] = 0.f;
    float m = NEGBIG, l = 0.f;
    const int ntile = 4 * qb + 4;
    const bf16_t* kvb = KV1 + (size_t)b * SEQ * KVUP + hh * 256; const bf16_t* krb = KR + (size_t)b * SEQ * 64;
    const int vrow0 = tid >> 4, vch = tid & 15, rrow = tid >> 3, rch = tid & 7;
    const unsigned kvoff = (unsigned)(vrow0 * KVUP + vch * 8) * 2u, kroff = (unsigned)(rrow * 64 + rch * 8) * 2u;
    u32x4 kreg[3], vreg[2];
#define MLA_LOAD(j) do { const char* tb_ = (const char*)(kvb + (size_t)(64 * (j)) * KVUP); const char* rb_ = (const char*)(krb + (size_t)(64 * (j)) * 64); \
        kreg[0] = *(const u32x4*)(tb_ + kvoff); kreg[1] = *(const u32x4*)(tb_ + kvoff + 32u * KVUP * 2u); kreg[2] = *(const u32x4*)(rb_ + kroff); \
        vreg[0] = *(const u32x4*)(tb_ + kvoff + 256u); vreg[1] = *(const u32x4*)(tb_ + kvoff + 32u * KVUP * 2u + 256u); } while (0)
#define MLA_STORE(B) do { *(LAS u32x4*)((B) + vrow0 * C_KSTR + vch * 16) = kreg[0]; *(LAS u32x4*)((B) + (vrow0 + 32) * C_KSTR + vch * 16) = kreg[1]; *(LAS u32x4*)((B) + rrow * C_KSTR + 256 + rch * 16) = kreg[2]; \
        *(LAS u32x4*)((B) + C_KSZ + vrow0 * C_VSTR + vch * 16) = vreg[0]; *(LAS u32x4*)((B) + C_KSZ + (vrow0 + 32) * C_VSTR + vch * 16) = vreg[1]; } while (0)
    MLA_LOAD(0); MLA_STORE(lds);
    __syncthreads();
    const int tqmax = qb * 256 + 32 * wave + 31;
    for (int j = 0; j < ntile; ++j) {
        const bool more = (j + 1 < ntile);
        if (more && VAR != 2) MLA_LOAD(j + 1);
        LAS unsigned char* B = lds + (j & 1) * C_BUF;
        if (VAR != 1 && 64 * j <= tqmax) {
            FixC fx; fx.tq = tq; fx.kpos0 = 64 * j;
            tile_compute<192, 128, C_KSTR, C_VSTR, false, FixC, (VAR == 2)>(qf, B, B + C_KSZ, o, m, l, r, h, vlane, fx, 64 * j + 63 <= tqmax - 31  , 0.f);
        }
        if (more && VAR != 2) { LAS unsigned char* Bn = lds + ((j + 1) & 1) * C_BUF; MLA_STORE(Bn); }
        __syncthreads();
    }
#undef MLA_LOAD
#undef MLA_STORE
    const float inv = 1.0f / l;
#pragma unroll
    for (int d = 0; d < 4; ++d) o[d] = o[d] * inv;
    store_o<4>(o, (bf16_t*)(ws + WS_OB1) + rowb * DM + hh * 128, h);
}

DI float wave_sum(float v, int lane) {
#pragma unroll
    for (int o = 1; o < 64; o <<= 1) v += shflx(v, lane, o);
    return v;
}
DI void wt_load(const float* W, int K, int N, int nblk, const float* gk, int item, int lane, f32x4 (&v)[16]) {
    const int kb = item / nblk, nb = item % nblk, k0 = 64 * kb, n0 = 64 * nb;
    const int lr = lane >> 4, lc = 4 * (lane & 15);
    const bool cvalid = (n0 + lc) < N;
    const float* wp = W + (size_t)(k0 + lr) * N + n0 + lc;
#pragma unroll
    for (int r = 0; r < 16; ++r) v[r] = cvalid ? *(const f32x4*)(wp + (size_t)(4 * r) * N) : (f32x4){0.f, 0.f, 0.f, 0.f};
    if (gk) {
#pragma unroll
        for (int r = 0; r < 16; ++r) v[r] = v[r] * gk[k0 + 4 * r + lr];
    }
}
DI void wt_finish(int K, int nblk, bf16_t* WT, int mode, LAS float* scr, int item, int lane, const f32x4 (&v)[16]) {
    const int kb = item / nblk, nb = item % nblk, k0 = 64 * kb, n0 = 64 * nb;
    const int lr = lane >> 4, lc = 4 * (lane & 15);
#pragma unroll
    for (int r = 0; r < 16; ++r) { LAS float* q = scr + (4 * r + lr) * 65 + lc; q[0] = v[r][0]; q[1] = v[r][1]; q[2] = v[r][2]; q[3] = v[r][3]; }
    const int nl = lane >> 3, c = lane & 7;
#pragma unroll
    for (int i = 0; i < 8; ++i) {
        const int ln = 8 * i + nl, n = n0 + ln; int srcl = ln; float scale = 1.0f;
        if (mode == 1) { if (n < 1024 || (n >= 1280 && n < 2304)) scale = 0.125f * LOG2E; }
        else if (mode == 2) { if (n >= 1280 && n < 1344) srcl = (ln >> 1) + 32 * (ln & 1); }
        else if (mode == 3) { if ((n % 192) >= 128) srcl = (ln >> 1) + 32 * (ln & 1); scale = 0.07216878364870322f * LOG2E; }
        const LAS float* sp = scr + (8 * c) * 65 + srcl;
        u32x4 o; o.x = pk2(sp[0 * 65] * scale, sp[1 * 65] * scale); o.y = pk2(sp[2 * 65] * scale, sp[3 * 65] * scale);
        o.z = pk2(sp[4 * 65] * scale, sp[5 * 65] * scale); o.w = pk2(sp[6 * 65] * scale, sp[7 * 65] * scale);
        *(u32x4*)(WT + (size_t)n * K + k0 + 8 * c) = o;
    }
}
#define WT_JOB(W_, K_, N_, NPAD_, DST_, GK_, MODE_) do { const int nblk_ = (NPAD_) / 64, cnt_ = ((K_) / 64) * nblk_; int first_ = (gw - wt_base) % ngw; if (first_ < 0) first_ += ngw; \
    for (int it_ = first_; it_ < cnt_; it_ += 2 * ngw) { f32x4 va_[16], vb_[16]; const bool two_ = it_ + ngw < cnt_;   \
        wt_load((W_), (K_), (N_), nblk_, (GK_), it_, lane, va_); if (two_) wt_load((W_), (K_), (N_), nblk_, (GK_), it_ + ngw, lane, vb_); \
        wt_finish((K_), nblk_, (bf16_t*)(ws + (DST_)), (MODE_), scr, it_, lane, va_); if (two_) wt_finish((K_), nblk_, (bf16_t*)(ws + (DST_)), (MODE_), scr, it_ + ngw, lane, vb_); } \
    wt_base = (wt_base + cnt_) % ngw; } while (0)
DI int t5_bucket(int d) {
    if (d < 16) return d;
    const int v = 16 + (int)(logf((float)d / 16.0f) / 2.0794415416798357f * 16.0f);
    return v > 31 ? 31 : v;
}

#define CAS __attribute__((address_space(4)))
DI const float* inp(int i) { const CAS char* ka = (const CAS char*)__builtin_amdgcn_kernarg_segment_ptr(); asm volatile("" : "+s"(ka)); return ((const float* const CAS*)ka)[i]; }
DI unsigned xcc_id() { return (unsigned)__builtin_amdgcn_s_getreg((3 << 11) | 20) & 7u; }
#ifndef REP_P0
#define REP_P0 0
#endif
#ifndef REP_A
#define REP_A 0
#endif
#ifndef REP_B
#define REP_B 0
#endif
#ifndef REP_C
#define REP_C 0
#endif
#ifndef REP_UP
#define REP_UP 0
#endif
#ifndef EN_PRO
#define EN_PRO 1
#endif
#ifndef EN_GEMM
#define EN_GEMM 1
#endif
#ifndef EN_A
#define EN_A 1
#endif
#ifndef EN_B
#define EN_B 1
#endif
#ifndef EN_C
#define EN_C 1
#endif
#define XB_TMO      128
#define XB_XCNT(j)  (256  + 64 * (j))
#define XB_XSUB(j)  (1280 + 64 * (j))
#define XB_XGEN(j)  (2304 + 64 * (j))
#define XB_TOP      3328
#define XB_TOPGEN   3392
#define XCD_BAR_WORDS 3456
#define XB_SPIN_CAP (1u << 18)

__device__ __forceinline__ unsigned xb_ld(unsigned* p)              { return __hip_atomic_load(p, __ATOMIC_RELAXED, __HIP_MEMORY_SCOPE_AGENT); }
__device__ __forceinline__ unsigned xb_add(unsigned* p, unsigned v) { return __hip_atomic_fetch_add(p, v, __ATOMIC_RELAXED, __HIP_MEMORY_SCOPE_AGENT); }
__device__ __forceinline__ unsigned xb_xcc_id() { return (unsigned)__builtin_amdgcn_s_getreg((3 << 11) | 20) & 0xFu; }
#define XB_SPIN(cond, bar) do { unsigned _sp = 0; while (cond) { __builtin_amdgcn_s_sleep(1); \
    if ((++_sp & 255u) == 0u) { if (xb_ld(&(bar)[XB_TMO])) break; if (_sp > XB_SPIN_CAP) { atomicAdd(&(bar)[XB_TMO], 1u); break; } } } } while (0)

struct XcdBarrier {
    unsigned* bar; unsigned x;
    volatile LAS unsigned* st;
};

__device__ __forceinline__ XcdBarrier xcd_barrier_post(unsigned* bar, volatile LAS unsigned* st, int wave) {
    XcdBarrier b; b.bar = bar; b.x = xb_xcc_id(); b.st = st;
    if (wave == 0 && fresh_lane() == 0) (void)xb_add(&bar[XB_XCNT(b.x)], 1u);
    return b;
}
__device__ __forceinline__ void xcd_barrier_complete(unsigned* bar, unsigned x, unsigned& nloc, unsigned& nx) {
    const unsigned G = gridDim.x * gridDim.y * gridDim.z;
    unsigned sum, cnt, mine, sp = 0u;
    for (;;) {
        sum = 0u; cnt = 0u; mine = 0u;
#pragma unroll
        for (unsigned j = 0; j < 16; ++j) { const unsigned c = xb_ld(&bar[XB_XCNT(j)]); sum += c; cnt += (c > 0u) ? 1u : 0u; mine = (j == x) ? c : mine; }
        if (sum == G) break;
        __builtin_amdgcn_s_sleep(1);
        if ((++sp & 255u) == 0u) { if (xb_ld(&bar[XB_TMO])) break; if (sp > XB_SPIN_CAP) { atomicAdd(&bar[XB_TMO], 1u); break; } }
    }
    nloc = mine > 0u ? mine : 1u; nx = cnt > 0u ? cnt : 1u;
}

__device__ __forceinline__ void xcd_barrier(const XcdBarrier& b, int wave) {
    asm volatile("s_waitcnt vmcnt(0)" ::: "memory");
    __syncthreads();
    if (wave == 0 && fresh_lane() == 0) {
        unsigned* bar = b.bar;
        __builtin_amdgcn_s_waitcnt(0);
        unsigned nloc = b.st[0], nx = b.st[1];
        if (nloc == 0u) { xcd_barrier_complete(bar, b.x, nloc, nx); b.st[0] = nloc; b.st[1] = nx; }
        const unsigned old = xb_add(&bar[XB_XSUB(b.x)], 1u);
        const unsigned gen = old / nloc;
        if (old + 1u == (gen + 1u) * nloc) {
            __builtin_amdgcn_fence(__ATOMIC_RELEASE, "agent");
            asm volatile("s_waitcnt vmcnt(0)" ::: "memory");
            const unsigned og = xb_add(&bar[XB_TOP], 1u);
            const unsigned tg = og / nx;
            if (og + 1u == (tg + 1u) * nx) xb_add(&bar[XB_TOPGEN], 1u);
            else XB_SPIN(xb_ld(&bar[XB_TOPGEN]) == tg, bar);
            __builtin_amdgcn_fence(__ATOMIC_ACQUIRE, "agent");
            xb_add(&bar[XB_XGEN(b.x)], 1u);
            asm volatile("s_waitcnt vmcnt(0)" ::: "memory");
        } else {
            XB_SPIN(xb_ld(&bar[XB_XGEN(b.x)]) == gen, bar);
            __builtin_amdgcn_fence(__ATOMIC_ACQUIRE, "agent");
            asm volatile("s_waitcnt vmcnt(0)" ::: "memory");
        }
    }
    __syncthreads();
}

__global__ void __launch_bounds__(NTHR, 2) fwd_kernel(Ptrs P) {
    extern __shared__ __attribute__((aligned(16))) unsigned char lds_raw[];
    LAS unsigned char* lds = (LAS unsigned char*)lds_raw;
    const int wave = __builtin_amdgcn_readfirstlane((int)threadIdx.x >> 6);
    int lane, tid;
#define FRESH_TID() do { lane = fresh_lane(); tid = wave * 64 + lane; } while (0)
    FRESH_TID();
    if (tid < 4) ((volatile LAS unsigned*)(lds + LDS_BYTES - 16))[tid] = 0u;
    __syncthreads();
    const int G = gridDim.x, bx = blockIdx.x, gw = bx * 8 + wave, ngw = G * 8;
    unsigned char* ws = (unsigned char*)inp(24);
    unsigned* ctl = (unsigned*)(ws + WS_CTL);
    const XcdBarrier xbar = xcd_barrier_post((unsigned*)(ws + WS_BAR), (volatile LAS unsigned*)(lds + LDS_BYTES - 16), wave);
    float* part = (float*)(ws + WS_PART); float* part2 = (float*)(ws + WS_PART2);
    bf16_t* XB = (bf16_t*)(ws + WS_XB);
    LAS float* scr = (LAS float*)(lds + wave * 17408);
    LAS int* slot = (LAS int*)(lds + SLOT_OFF);

    for (int rep_ = 0; rep_ <= REP_P0; ++rep_) {
    if (rep_) xcd_barrier(xbar, wave);
        if (bx == 0 && tid < 64) ctl[tid] = 0u;
        int wt_base = 0;
        WT_JOB(inp(3), DM, EIN, EINP, WS_WINE, inp(2), 1); WT_JOB(inp(11), DM, DM, DM, WS_WOUTE, (const float*)nullptr, 0); WT_JOB(inp(13), DM, OIN, OINP, WS_WINO, inp(12), 2);
        WT_JOB(inp(15), 768, QUP, QUP, WS_WQUP, inp(14), 3); WT_JOB(inp(17), 512, KVUP, KVUP, WS_WKVUP, inp(16), 0); WT_JOB(inp(18), DM, DM, DM, WS_WOUTO, (const float*)nullptr, 0);
        WT_JOB(inp(20), DM, FF, FF, WS_WUP, inp(19), 0); WT_JOB(inp(21), FF, DM, DM, WS_WDN, (const float*)nullptr, 0);
        WT_JOB(inp(7), 2048, 256, 256, WS_CW1K, (const float*)nullptr, 0); WT_JOB(inp(9), 2048, 256, 256, WS_CW1V, (const float*)nullptr, 0);
        WT_JOB(inp(8), 256, 64, 64, WS_CW2K, (const float*)nullptr, 0); WT_JOB(inp(10), 256, 64, 64, WS_CW2V, (const float*)nullptr, 0);
        const float* x = inp(0);
        for (int row = gw; row < MTOK; row += ngw) {
            const f32x4* xr = (const f32x4*)(x + (size_t)row * DM) + lane; u32x2* xo = (u32x2*)(XB + (size_t)row * DM) + lane; float s = 0.f;
#pragma unroll
            for (int j = 0; j < 8; ++j) { const f32x4 v = xr[64 * j]; s += (v[0] * v[0] + v[1] * v[1]) + (v[2] * v[2] + v[3] * v[3]); u32x2 w; w.x = pk2(v[0], v[1]); w.y = pk2(v[2], v[3]); xo[64 * j] = w; }
            s = wave_sum(s, lane);
            if (lane < 32) part[(size_t)row * 32 + lane] = lane == 0 ? s : 0.f;
        }
        const int gt = bx * NTHR + tid, ngt = G * NTHR;
        float* biasT = (float*)(ws + WS_BIAS); float* cosT = (float*)(ws + WS_COS); float* sinT = (float*)(ws + WS_SIN);
        { const float* rb = inp(1); for (int i = gt; i < 32 * 128; i += ngt) { const int hd = i >> 7, d = i & 127; biasT[i] = rb[t5_bucket(d) * 32 + hd] * LOG2E; } }
        for (int i = gt; i < 2048 * 32; i += ngt) { const int s = i >> 5, ii = i & 31; const float inv = 1.0f / powf(10000.0f, (float)(2 * ii) / 64.0f); const float ang = (float)s * inv; cosT[i] = cosf(ang); sinT[i] = sinf(ang); }
        bf16_t* KC = (bf16_t*)(ws + WS_KC); bf16_t* VC = (bf16_t*)(ws + WS_VC);
        for (int i = gt; i < 8 * 128; i += ngt) { const int b = i >> 7, e = i & 127; KC[(size_t)(b * 128 + 127) * 128 + e] = 0; VC[(size_t)(b * 128 + 127) * 128 + e] = 0; }
    }
    if (gridDim.y == 0x7fffu) cg::this_grid().sync();
    xcd_barrier(xbar, wave);
    {
        pg8::Gemm g{XB, (const bf16_t*)(ws + WS_WINE), MTOK, EINP, DM, DM}; pg8::StaticOrder S; S.init(MTOK, 3072, G, bx);
        pg8::EpiScale<0> E{(bf16_t*)(ws + WS_P0), EINP, part, nullptr, nullptr, nullptr, nullptr};
        if (EN_GEMM) pg8::gemm_phase<pg8::EpiScale<0>, pg8::StaticOrder, true, true>(lds, g, S, E, wave);
    }
    xcd_barrier(xbar, wave);
    FRESH_TID();
    {
        pg8::Gemm g{XB, (const bf16_t*)(ws + WS_WINE), MTOK, EINP, DM, DM}; pg8::TailOrder T{bx, 12};
        pg8::EpiScale<0> E{(bf16_t*)(ws + WS_P0), EINP, part, nullptr, nullptr, nullptr, nullptr};
        pg8::gemm_phase<pg8::EpiScale<0>, pg8::TailOrder, true, true>(lds, g, T, E, wave);
        __syncthreads();
        FRESH_TID();
    }
    {
        if (wave >= 4) __builtin_amdgcn_s_setprio(1);
        const float* pk_ = inp(5); const float* pv_ = inp(6); const float* sk_ = inp(4);
        for (;;) { const int it = next_item(ctl + 0, slot, wave); if (it >= 128) break; compress_item(it, ws, pk_, pv_, lds, tid, wave, lane); }
        const unsigned x0 = xcc_id();
        for (int s = 0; s < 8; ++s) { const int xq = (int)((x0 + s) & 7u);
            for (;;) { const int k = next_item(ctl + 16 + xq, slot, wave); if (k >= 128) break; mixerA_item((xq + 8 * (k & 1)) * 64 + (k >> 1), ws, sk_, lds, tid, wave, lane); } }
    }
    __builtin_amdgcn_s_setprio(0);
    xcd_barrier(xbar, wave);
    FRESH_TID();
    {
        if (wave >= 4) __builtin_amdgcn_s_setprio(1);
        const unsigned x0 = xcc_id();
        for (int s = 0; s < 8; ++s) { const int xq = (int)((x0 + s) & 7u);
            for (;;) { const int k = next_item(ctl + 32 + xq, slot, wave); if (k >= 128) break; mixerB_item(((k >> 1) << 4) | (xq + 8 * (k & 1)), ws, lds, tid, wave, lane); } }
    }
    __builtin_amdgcn_s_setprio(0);
    xcd_barrier(xbar, wave);
    {
        pg8::Gemm g{(const bf16_t*)(ws + WS_OB0), (const bf16_t*)(ws + WS_WOUTE), MTOK, DM, DM, DM}; pg8::StaticOrder S; S.init(MTOK, DM, G, bx);
        pg8::EpiResidual<false> E{inp(0), (float*)inp(23), XB, part};
        if (EN_GEMM) pg8::gemm_phase<pg8::EpiResidual<false>, pg8::StaticOrder, true, true>(lds, g, S, E, wave);
    }
    xcd_barrier(xbar, wave);
    {
        for (int rep_ = 0; rep_ <= REP_UP; ++rep_) {
            if (rep_) xcd_barrier(xbar, wave);
            pg8::Gemm g{XB, (const bf16_t*)(ws + WS_WUP), MTOK, FF, DM, DM}; pg8::StaticOrder S; S.init(MTOK, FF, G, bx);
            pg8::EpiScale<1> E{(bf16_t*)(ws + WS_HB), FF, part, nullptr, nullptr, nullptr, nullptr};
            if (EN_GEMM) pg8::gemm_phase<pg8::EpiScale<1>, pg8::StaticOrder, true, true>(lds, g, S, E, wave);
        }
        xcd_barrier(xbar, wave);
        {
            pg8::Gemm g{(const bf16_t*)(ws + WS_HB), (const bf16_t*)(ws + WS_WDN), MTOK, DM, FF, FF}; pg8::StaticOrder S; S.init(MTOK, DM, G, bx);
            float* outp = (float*)inp(23); pg8::EpiResidual<false> E{outp, outp, XB, part};
            if (EN_GEMM) pg8::gemm_phase<pg8::EpiResidual<false>, pg8::StaticOrder, true, true>(lds, g, S, E, wave);
        }
        xcd_barrier(xbar, wave);
    }
    {
            FRESH_TID();
            int wt_base = 0;
            WT_JOB(inp(20) + (size_t)DM * FF, DM, FF, FF, WS_WUP, inp(19) + DM, 0); WT_JOB(inp(21) + (size_t)FF * DM, FF, DM, DM, WS_WDN, (const float*)nullptr, 0);
            __syncthreads();
            {
                pg8::Gemm g{XB, (const bf16_t*)(ws + WS_WINO), MTOK, OINP, DM, DM}; pg8::StaticOrder S; S.init(MTOK, OINP, G, bx);
                pg8::EpiScale<2> E{(bf16_t*)(ws + WS_P1), OINP, part, part2, (bf16_t*)(ws + WS_KR), (const float*)(ws + WS_COS), (const float*)(ws + WS_SIN)};
                if (EN_GEMM) pg8::gemm_phase<pg8::EpiScale<2>, pg8::StaticOrder, true, true>(lds, g, S, E, wave);
            }
            xcd_barrier(xbar, wave);
            {
                pg8::Gemm g{(const bf16_t*)(ws + WS_P1), (const bf16_t*)(ws + WS_WQUP), MTOK, QUP, 768, OINP}; pg8::StaticOrder S; S.init(MTOK, QUP, G, bx);
                pg8::EpiScale<3> E{(bf16_t*)(ws + WS_Q1), QUP, part2, nullptr, nullptr, (const float*)(ws + WS_COS), (const float*)(ws + WS_SIN)};
                if (EN_GEMM) pg8::gemm_phase<pg8::EpiScale<3>, pg8::StaticOrder, true, true>(lds, g, S, E, wave);
            }
            {
                pg8::Gemm g{(const bf16_t*)(ws + WS_P1) + 768, (const bf16_t*)(ws + WS_WKVUP), MTOK, KVUP, 512, OINP}; pg8::StaticOrder S; S.init(MTOK, KVUP, G, bx);
                pg8::EpiScale<4> E{(bf16_t*)(ws + WS_KV1), KVUP, part2, nullptr, nullptr, nullptr, nullptr};
                if (EN_GEMM) pg8::gemm_phase<pg8::EpiScale<4>, pg8::StaticOrder, true, true>(lds, g, S, E, wave);
            }
            xcd_barrier(xbar, wave);
            FRESH_TID();
#ifndef MLA_PROBE
#define MLA_PROBE 0
#endif
            if (MLA_PROBE) {
                const unsigned x0 = xcc_id();
                for (int s = 0; s < 8; ++s) { const int xq = (int)((x0 + s) & 7u);
                    for (;;) { const int k = next_item(ctl + 56 + xq, slot, wave); if (k >= 128) break;
                        const int bh = ((k >> 5) * 4 + (k & 3)) * 8 + xq, q7 = (k & 31) >> 2;
                        mla_item<MLA_PROBE>((q7 << 7) | bh, ws, lds, tid, wave, lane); } }
                xcd_barrier(xbar, wave);
            }
            {
                if (wave >= 4) __builtin_amdgcn_s_setprio(1);
                const unsigned x0 = xcc_id();
                for (int s = 0; s < 8; ++s) { const int xq = (int)((x0 + s) & 7u);
                    for (;;) { const int k = next_item(ctl + 48 + xq, slot, wave); if (k >= 128) break;
                        const int bh = ((k >> 5) * 4 + (k & 3)) * 8 + xq, q7 = (k & 31) >> 2;
                        mla_item<0>((q7 << 7) | bh, ws, lds, tid, wave, lane); } }
            }
            __builtin_amdgcn_s_setprio(0);
            xcd_barrier(xbar, wave);
            {
                pg8::Gemm g{(const bf16_t*)(ws + WS_OB1), (const bf16_t*)(ws + WS_WOUTO), MTOK, DM, DM, DM}; pg8::StaticOrder S; S.init(MTOK, DM, G, bx);
                float* outp = (float*)inp(23); pg8::EpiResidual<false> E{outp, outp, XB, part};
                if (EN_GEMM) pg8::gemm_phase<pg8::EpiResidual<false>, pg8::StaticOrder, true, true>(lds, g, S, E, wave);
            }
            xcd_barrier(xbar, wave);
    }
    {
        for (int rep_ = 0; rep_ <= REP_UP; ++rep_) {
            if (rep_) xcd_barrier(xbar, wave);
            pg8::Gemm g{XB, (const bf16_t*)(ws + WS_WUP), MTOK, FF, DM, DM}; pg8::StaticOrder S; S.init(MTOK, FF, G, bx);
            pg8::EpiScale<1> E{(bf16_t*)(ws + WS_HB), FF, part, nullptr, nullptr, nullptr, nullptr};
            if (EN_GEMM) pg8::gemm_phase<pg8::EpiScale<1>, pg8::StaticOrder, true, true>(lds, g, S, E, wave);
        }
        xcd_barrier(xbar, wave);
        {
            pg8::Gemm g{(const bf16_t*)(ws + WS_HB), (const bf16_t*)(ws + WS_WDN), MTOK, DM, FF, FF}; pg8::StaticOrder S; S.init(MTOK, DM, G, bx);
            float* outp = (float*)inp(23); pg8::EpiResidual<true> E{outp, outp, XB, part};
            if (EN_GEMM) pg8::gemm_phase<pg8::EpiResidual<true>, pg8::StaticOrder, true, true>(lds, g, S, E, wave);
        }
        xcd_barrier(xbar, wave);
    }
    FRESH_TID();
    {
        const float* gf = inp(22); float* outp = (float*)inp(23);
        for (int row = gw; row < MTOK; row += ngw) {
            const f32x4* pr = (const f32x4*)(part + (size_t)row * 32); float s = 0.f;
#pragma unroll
            for (int i = 0; i < 8; ++i) { const f32x4 v = pr[i]; s += (v[0] + v[1]) + (v[2] + v[3]); }
            const float rs = __builtin_amdgcn_rsqf(s * (1.0f / 2048.0f) + EPS);
            f32x4* xr = (f32x4*)(outp + (size_t)row * DM) + lane; const f32x4* gr = (const f32x4*)gf + lane; const u32x2* xb = (const u32x2*)(XB + (size_t)row * DM) + lane;
#pragma unroll
            for (int j = 0; j < 8; ++j) { const u32x2 w = xb[64 * j]; const f32x4 gg = gr[64 * j]; f32x4 v; v[0] = bflo(w.x); v[1] = bfhi(w.x); v[2] = bflo(w.y); v[3] = bfhi(w.y); xr[64 * j] = v * rs * gg; }
        }
    }
}

extern "C" void kernel_launch(void* const* d_in, const int* in_sizes, int n_in, void* d_out, int out_size, void* d_ws, size_t ws_size, hipStream_t stream) {
    static int grid = 0;
    if (grid == 0) {
        if (n_in != 23 || out_size != MTOK * DM || ws_size < WS_END) { fprintf(stderr, "kernel_launch: unexpected shapes (n_in %d out %d ws %zu need %zu)\n", n_in, out_size, ws_size, (size_t)WS_END); grid = -1; return; }
        int dev = 0, cus = 0, per_cu = 0;
        hipGetDevice(&dev); hipDeviceGetAttribute(&cus, hipDeviceAttributeMultiprocessorCount, dev);
        hipFuncSetAttribute((const void*)fwd_kernel, hipFuncAttributeMaxDynamicSharedMemorySize, LDS_BYTES);
        hipOccupancyMaxActiveBlocksPerMultiprocessor(&per_cu, (const void*)fwd_kernel, NTHR, LDS_BYTES);
        if (per_cu < 1) { fprintf(stderr, "kernel_launch: occupancy query returned %d\n", per_cu); per_cu = 1; }
        grid = cus;
    }
    if (grid < 0) return;
    if (hipMemsetAsync(d_ws, 0, 16384, stream) != hipSuccess) { fprintf(stderr, "kernel_launch: memset of the control words failed\n"); return; }
    Ptrs p{};
    for (int i = 0; i < 23; ++i) p.in[i] = (const float*)d_in[i];
    p.out = (float*)d_out; p.ws = (unsigned char*)d_ws;
    void* args[] = {&p};
    hipError_t e = hipLaunchCooperativeKernel((const void*)fwd_kernel, dim3(grid), dim3(NTHR), args, LDS_BYTES, stream);
    if (e != hipSuccess) fprintf(stderr, "cooperative launch failed: %s (grid %d)\n", hipGetErrorString(e), grid);
}
```
